# Optimizing an MI355X kernel written in HIP

```python
import jax, jax.numpy as jnp
from jax import lax
import numpy as np

D_MODEL = 1024
BATCH = 2
SEQ = 8192
DEPTH = 1
DEC_BATCH = 16
DEC_SEQ = 4096
PAST_LEN = 128

GRID_W = 64
N_MEM = 256
EPS = 1e-6
POOL_GROUPS = 4
POOL_GROUP_DIM = D_MODEL // 8
POOL_WIDTH = POOL_GROUPS * POOL_GROUP_DIM
POOL_WINDOWS = (2, 4, 8, 16)
N_HEADS = 8
N_KV_HEADS = 2
HEAD_DIM = 64
ATTN_WIDTH = N_HEADS * HEAD_DIM
KV_WIDTH = N_KV_HEADS * HEAD_DIM
AXIS_DIM = HEAD_DIM // 2
ROPE_THETA = 10000.0
Q_BLOCK = 128
N_X_HEADS = 4
X_HEAD_DIM = D_MODEL // 8
X_WIDTH = N_X_HEADS * X_HEAD_DIM
N_BRANCH = 3
BRANCH_WIDTH = 512
IN_WIDTHS = (POOL_WIDTH, POOL_WIDTH, ATTN_WIDTH, KV_WIDTH, KV_WIDTH, ATTN_WIDTH, X_WIDTH, X_WIDTH, N_BRANCH * D_MODEL)
IN_DIM = 2 * POOL_WIDTH + 2 * ATTN_WIDTH + 2 * KV_WIDTH + 2 * X_WIDTH + N_BRANCH * D_MODEL

kernel_name = "hybrid_pool_gqa_xattn_gated_encoder"


def rms_norm(x, g):
    xf = x.astype(jnp.float32)
    y = xf * lax.rsqrt(jnp.mean(xf * xf, axis=-1, keepdims=True) + EPS)
    return (y * g.astype(jnp.float32)).astype(x.dtype)


def axial_rope_tables(L):
    rows = L // GRID_W
    row = jnp.repeat(jnp.arange(rows, dtype=jnp.float32), GRID_W)
    col = jnp.tile(jnp.arange(GRID_W, dtype=jnp.float32), rows)
    inv = ROPE_THETA ** (-jnp.arange(0, AXIS_DIM, 2, dtype=jnp.float32) / AXIS_DIM)
    ang = jnp.concatenate([row[:, None] * inv, col[:, None] * inv], axis=-1)
    return jnp.cos(ang), jnp.sin(ang)


def apply_rope(x, cos, sin):
    B, L, H, D = x.shape
    xf = x.astype(jnp.float32).reshape(B, L, H, D // 2, 2)
    x0, x1 = xf[..., 0], xf[..., 1]
    c = cos[None, :, None, :]
    s = sin[None, :, None, :]
    out = jnp.stack([x0 * c - x1 * s, x0 * s + x1 * c], axis=-1)
    return out.reshape(B, L, H, D).astype(x.dtype)


def multiscale_pool(u, w_pool, pool_scale):
    B, L, _ = u.shape
    uf = u.astype(jnp.float32).reshape(B, L, POOL_GROUPS, POOL_GROUP_DIM)
    cs = jnp.concatenate([jnp.zeros((B, 1, POOL_GROUPS, POOL_GROUP_DIM), jnp.float32),
                          jnp.cumsum(uf, axis=1)], axis=1)
    t = jnp.arange(L, dtype=jnp.int32)
    pooled = []
    for g, w in enumerate(POOL_WINDOWS):
        lo = jnp.clip(t - w // 2, 0, L)
        hi = jnp.clip(t + (w - 1 - w // 2) + 1, 0, L)
        csg = cs[:, :, g]
        ssum = jnp.take(csg, hi, axis=1) - jnp.take(csg, lo, axis=1)
        cnt = (hi - lo).astype(jnp.float32)
        pooled.append(ssum / cnt[None, :, None])
    pooled = jnp.stack(pooled, axis=2)
    mixed = (pooled - uf).astype(u.dtype)
    out = jnp.einsum('blgc,gcd->blgd', mixed, w_pool).reshape(B, L, POOL_WIDTH)
    return out * pool_scale


def self_attention(q, k, v):
    B, L = q.shape[:2]
    G = N_HEADS // N_KV_HEADS
    nb = L // Q_BLOCK
    qb = q.reshape(B, nb, Q_BLOCK, N_KV_HEADS, G, HEAD_DIM).transpose(1, 0, 2, 3, 4, 5)
    scale = HEAD_DIM ** -0.5

    def one_block(qblk):
        s = jnp.einsum('bqkgd,bskd->bkgqs', qblk, k).astype(jnp.float32) * scale
        p = jax.nn.softmax(s, axis=-1).astype(v.dtype)
        return jnp.einsum('bkgqs,bskd->bqkgd', p, v)

    o = lax.map(one_block, qb)
    return o.transpose(1, 0, 2, 3, 4, 5).reshape(B, L, ATTN_WIDTH)


def cross_attention(xq, mem_n, w_mem_kv):
    B, L, _ = xq.shape
    M = mem_n.shape[1]
    kv = mem_n @ w_mem_kv
    mk = kv[..., :X_WIDTH].reshape(B, M, N_X_HEADS, X_HEAD_DIM)
    mv = kv[..., X_WIDTH:].reshape(B, M, N_X_HEADS, X_HEAD_DIM)
    q = xq.reshape(B, L, N_X_HEADS, X_HEAD_DIM)
    s = jnp.einsum('blhd,bmhd->bhlm', q, mk).astype(jnp.float32) * (X_HEAD_DIM ** -0.5)
    p = jax.nn.softmax(s, axis=-1).astype(mv.dtype)
    return jnp.einsum('bhlm,bmhd->blhd', p, mv).reshape(B, L, X_WIDTH)


def encoder_layer(x, mem, ln_pre, ln_post, ln_mem, w_in, b_merge, q_norm, k_norm,
                  w_pool, pool_scale, w_mem_kv, w_branch, w_out):
    B, L, _ = x.shape
    h = rms_norm(x, ln_pre)
    z = h @ w_in
    split_at = np.cumsum(IN_WIDTHS)[:-1].tolist()
    (pool_in, pool_gate, q, k, v, attn_gate, xq, x_gate, merge_logits) = jnp.split(z, split_at, axis=-1)

    pool_out = multiscale_pool(pool_in, w_pool, pool_scale)

    cos, sin = axial_rope_tables(L)
    q = apply_rope(rms_norm(q.reshape(B, L, N_HEADS, HEAD_DIM), q_norm), cos, sin)
    k = apply_rope(rms_norm(k.reshape(B, L, N_KV_HEADS, HEAD_DIM), k_norm), cos, sin)
    attn_out = self_attention(q, k, v.reshape(B, L, N_KV_HEADS, HEAD_DIM))

    cross_out = cross_attention(xq, rms_norm(mem, ln_mem), w_mem_kv)

    branches = (pool_out * jax.nn.silu(pool_gate),
                attn_out * jax.nn.silu(attn_gate),
                cross_out * jax.nn.silu(x_gate))
    gates = jax.nn.sigmoid(merge_logits.reshape(B, L, N_BRANCH, D_MODEL) + b_merge)
    merged = jnp.zeros_like(x)
    for n in range(N_BRANCH):
        merged = merged + gates[:, :, n] * (branches[n] @ w_branch[n])

    y = rms_norm(merged @ w_out, ln_post)
    return x + y


def setup_inputs(seed: int = 0) -> dict:
    key = jax.random.key(seed)
    ks = jax.random.split(key, 20)
    f32 = jnp.float32
    nrm = lambda k, shape, s: (jax.random.normal(k, shape, f32) * s).astype(f32)
    return {
        "x_prompt": nrm(ks[0], (BATCH, SEQ, D_MODEL), 1.0),
        "x_sample": nrm(ks[1], (DEC_BATCH, DEC_SEQ, D_MODEL), 1.0),
        "mem_prompt": nrm(ks[2], (BATCH, N_MEM, D_MODEL), 1.0),
        "mem_sample": nrm(ks[3], (DEC_BATCH, N_MEM, D_MODEL), 1.0),
        "ln_pre": 1.0 + nrm(ks[4], (D_MODEL,), 0.02),
        "ln_post": 1.0 + nrm(ks[5], (D_MODEL,), 0.02),
        "ln_mem": 1.0 + nrm(ks[6], (D_MODEL,), 0.02),
        "w_in": nrm(ks[7], (D_MODEL, IN_DIM), D_MODEL ** -0.5),
        "b_merge": nrm(ks[8], (N_BRANCH, D_MODEL), 0.01),
        "q_norm": 1.0 + nrm(ks[9], (HEAD_DIM,), 0.02),
        "k_norm": 1.0 + nrm(ks[10], (HEAD_DIM,), 0.02),
        "w_pool": nrm(ks[11], (POOL_GROUPS, POOL_GROUP_DIM, POOL_GROUP_DIM), POOL_GROUP_DIM ** -0.5),
        "pool_scale": 1.0 + nrm(ks[12], (POOL_WIDTH,), 0.1),
        "w_mem_kv": nrm(ks[13], (D_MODEL, 2 * X_WIDTH), D_MODEL ** -0.5),
        "w_branch": nrm(ks[14], (N_BRANCH, BRANCH_WIDTH, D_MODEL), BRANCH_WIDTH ** -0.5),
        "w_out": nrm(ks[15], (D_MODEL, D_MODEL), D_MODEL ** -0.5),
    }


def reference(x_prompt, x_sample, mem_prompt, mem_sample, ln_pre, ln_post, ln_mem, w_in, b_merge,
              q_norm, k_norm, w_pool, pool_scale, w_mem_kv, w_branch, w_out):
    y_prompt = x_prompt
    y_sample = x_sample
    for _ in range(DEPTH):
        y_prompt = encoder_layer(y_prompt, mem_prompt, ln_pre, ln_post, ln_mem, w_in, b_merge, q_norm, k_norm,
                                 w_pool, pool_scale, w_mem_kv, w_branch, w_out)
        y_sample = encoder_layer(y_sample, mem_sample, ln_pre, ln_post, ln_mem, w_in, b_merge, q_norm, k_norm,
                                 w_pool, pool_scale, w_mem_kv, w_branch, w_out)
    return (y_prompt, y_sample)
```

```cpp
#include <hip/hip_runtime.h>
#include <hip/hip_cooperative_groups.h>
#include <cstdio>
#include <cstdint>
#include <cmath>
#include <hip/hip_bf16.h>
namespace cg = cooperative_groups;
#ifndef DUP_MASK
#define DUP_MASK 0
#endif

#define LAS __attribute__((address_space(3)))
typedef unsigned short bf16_t;
typedef short bf16x8 __attribute__((ext_vector_type(8)));
typedef short s16x4 __attribute__((ext_vector_type(4)));
typedef float f32x4 __attribute__((ext_vector_type(4)));
typedef float f32x16 __attribute__((ext_vector_type(16)));
typedef unsigned u32x4 __attribute__((ext_vector_type(4)));
typedef unsigned u32x2 __attribute__((ext_vector_type(2)));
typedef float f32x2_t __attribute__((ext_vector_type(2)));
typedef __bf16 bf16x2_t __attribute__((ext_vector_type(2)));

constexpr int DM = 1024;
constexpr int T_P = 2 * 8192, T_S = 16 * 4096, T = T_P + T_S;
constexpr int L_P = 8192, L_S = 4096;
constexpr int NMEM = 256, MEMROWS = 18 * NMEM;
constexpr int IN_DIM = 6400, ZW = 3328;
constexpr float EPS = 1e-6f;
constexpr float LOG2E = 1.4426950408889634f;
constexpr float C2_SELF = 0.125f * LOG2E;
constexpr float C2_CROSS = 0.08838834764831845f * LOG2E;

constexpr size_t MiB = 1u << 20;
constexpr size_t TB = (size_t)T * 1024 * 2;
constexpr size_t WS_SS = 0;
constexpr size_t WS_CNT = 512 * 1024;
constexpr size_t WS_BAR = 768 * 1024;
constexpr size_t WS_WIN = 1 * MiB;
constexpr size_t WS_WMKV = 14 * MiB, WS_WOUT = 16 * MiB, WS_WB01 = 18 * MiB, WS_WB2P = 20 * MiB;
constexpr size_t WS_MEMN = 22 * MiB, WS_MKV = 31 * MiB;
constexpr size_t WS_XN = 40 * MiB;
constexpr size_t WS_ZA = WS_XN + TB, WS_ZB = WS_ZA + TB, WS_ZC = WS_ZB + TB;
constexpr size_t WS_ZD = WS_ZC + TB;
constexpr size_t WS_MIX = WS_ZD + (size_t)T * 256 * 2;
constexpr size_t WS_SCR = WS_MIX + TB;
constexpr size_t SCR_PER_BLOCK = 256 * 1024;
constexpr size_t WS_END = WS_SCR + 256 * SCR_PER_BLOCK;
static_assert(WS_END <= 1024 * MiB, "workspace map");

constexpr int LDS_BYTES = 139264;
constexpr int NWAVES = 8;

__device__ __forceinline__ unsigned f2bf(float f) { unsigned u = __builtin_bit_cast(unsigned, f); return (u + 0x7fffu + ((u >> 16) & 1u)) >> 16; }
__device__ __forceinline__ unsigned pk2(float lo, float hi) { f32x2_t v = {lo, hi}; bf16x2_t b = __builtin_convertvector(v, bf16x2_t); return __builtin_bit_cast(unsigned, b); }
__device__ __forceinline__ float bflo(unsigned w) { return __builtin_bit_cast(float, w << 16); }
__device__ __forceinline__ float bfhi(unsigned w) { return __builtin_bit_cast(float, w & 0xffff0000u); }
__device__ __forceinline__ float fast_rcp(float x) { return __builtin_amdgcn_rcpf(x); }
__device__ __forceinline__ float sigmoidf_(float x) { return fast_rcp(1.0f + __builtin_amdgcn_exp2f(-x * LOG2E)); }
__device__ __forceinline__ float siluf_(float x) { return x * sigmoidf_(x); }
__device__ __forceinline__ float wave_sum(float v) {
#pragma unroll
    for (int o = 1; o < 64; o <<= 1) v += __shfl_xor(v, o);
    return v;
}
__device__ __forceinline__ int crow(int r, int hi) { return (r & 3) + 8 * (r >> 2) + 4 * hi; }

namespace pg8 {
constexpr int BM = 256, BK = 64, HALF = 128, HTB = HALF * BK * 2, STAGE_BYTES = 8 * HTB, NXCD = 8, WGM = 8;
constexpr int KP = 1024;
__device__ __forceinline__ int lds_byte(int r, int c) { const int st = (r >> 4) * 2 + (c >> 5), rr = r & 15, cc = c & 31, ob = rr * 64 + cc * 2; return st * 1024 + (ob ^ (((ob >> 9) & 1) << 5)); }
__device__ __forceinline__ void stage_rc(int b, int& R, int& C) { const int st = b / 1024, sb = b % 1024, swz = sb ^ (((sb >> 9) & 1) << 5); R = (st >> 1) * 16 + swz / 64; C = (st & 1) * 32 + (swz % 64) / 2; }
__device__ __forceinline__ int perm32(int rho) { const int n = rho >> 4, i = rho & 15; return 8 * (i >> 2) + 4 * n + (i & 3); }

struct Unit { const char* A; const char* B; int nt; int kind; int r0; int c0; int aux; char* O; int ldc; float sc; };

__device__ __forceinline__ void tile_order(int L, int nM, int nN, int& pm, int& pn) {
    const int nwg = nM * nN; int wgid = L;
    { const int q = nwg / NXCD, r = nwg % NXCD, xcd = wgid % NXCD, off = wgid / NXCD; wgid = (xcd < r ? xcd * (q + 1) : r * (q + 1) + (xcd - r) * q) + off; }
    const int nig = WGM * nN, gid = wgid / nig, fm = gid * WGM, gsz = (nM - fm) < WGM ? (nM - fm) : WGM;
    pm = fm + ((wgid % nig) % gsz); pn = (wgid % nig) / gsz;
}

template <class Epi, class Sched>
__device__ __forceinline__ void gemm_phase(LAS unsigned char* lds, const Sched& S, const Epi& E) {
    constexpr bool ALIGN_EPI = true;
    int tid = threadIdx.x; asm volatile("" : "+v"(tid));
    const int wid = __builtin_amdgcn_readfirstlane(tid >> 6), lane = tid & 63, wr = wid >> 2, wc = wid & 3, fr = lane & 15, fq = lane >> 4;
    const int K = KP;
    unsigned voffA[2], voffB[2];
#pragma unroll
    for (int i = 0; i < 2; ++i) { int R, C; stage_rc(tid * 16 + i * 8192, R, C); const int Rb = (R & ~31) + perm32(R & 31);
        voffA[i] = (unsigned)(R * K + C) * 2u; voffB[i] = (unsigned)(Rb * K + C) * 2u; }
    const size_t kstep = (size_t)(BK * 2);
    const size_t hstep = (size_t)HALF * K * 2;
    const unsigned ldsw = (unsigned)wid * 1024u;
    const int aoff = lds_byte(wr * 64 + fr, fq * 8), boff = lds_byte(wc * 32 + fr, fq * 8);
#define PG8_SA(b, h) (((b) * 2 + (h)) * HTB)
#define PG8_SB(b, h) ((4 + (b) * 2 + (h)) * HTB)
#define PG8_STAGE(bufoff, gbase, voff) do { _Pragma("unroll") for (int _i = 0; _i < 2; ++_i) \
        __builtin_amdgcn_global_load_lds((const unsigned*)((const char*)(gbase) + (voff)[_i]), (LAS unsigned*)(lds + (bufoff) + ldsw + _i * 8192), 16, 0, 0); } while (0)
#define PG8_LDA(dst, b, h) do { _Pragma("unroll") for (int m = 0; m < 4; ++m) _Pragma("unroll") for (int k = 0; k < 2; ++k) dst[m][k] = *(const LAS bf16x8*)(lds + PG8_SA(b, h) + aoff + m * 2048 + k * 1024); } while (0)
#define PG8_LDB(dst, b, h) do { _Pragma("unroll") for (int n = 0; n < 2; ++n) _Pragma("unroll") for (int k = 0; k < 2; ++k) dst[n][k] = *(const LAS bf16x8*)(lds + PG8_SB(b, h) + boff + n * 2048 + k * 1024); } while (0)
#define PG8_MMA(ai, bj, At, Bt) do { __builtin_amdgcn_s_setprio(1); _Pragma("unroll") for (int m = 0; m < 4; ++m) _Pragma("unroll") for (int n = 0; n < 2; ++n) _Pragma("unroll") for (int k = 0; k < 2; ++k) \
        acc[ai][bj][m][n] = __builtin_amdgcn_mfma_f32_16x16x32_bf16(Bt[n][k], At[m][k], acc[ai][bj][m][n], 0, 0, 0); __builtin_amdgcn_s_setprio(0); } while (0)
#define PG8_WAIT_V(n) asm volatile("s_waitcnt vmcnt(" #n ")" ::: "memory")
#define PG8_WAIT_L(n) asm volatile("s_waitcnt lgkmcnt(" #n ")" ::: "memory")
#define PG8_BAR __builtin_amdgcn_s_barrier()
#define PG8_SCHED __builtin_amdgcn_sched_barrier(0)
    Unit cur, nxt; int ui = 0;
    if (!S.next(0, cur)) return;
    f32x4 acc[2][2][4][2];
#pragma unroll
    for (int a = 0; a < 2; ++a)
#pragma unroll
        for (int b = 0; b < 2; ++b)
#pragma unroll
            for (int m = 0; m < 4; ++m)
#pragma unroll
                for (int n = 0; n < 2; ++n) acc[a][b][m][n] = (f32x4){0.f, 0.f, 0.f, 0.f};
    bf16x8 At[4][2], B0[2][2], B1[2][2];
    const char* cA = cur.A; const char* cB = cur.B;
    PG8_STAGE(PG8_SB(0, 0), cB, voffB); PG8_STAGE(PG8_SB(0, 1), cB + hstep, voffB); PG8_STAGE(PG8_SA(0, 0), cA, voffA); PG8_STAGE(PG8_SA(0, 1), cA + hstep, voffA);
    if (wr == 1) PG8_BAR;
    PG8_WAIT_V(2); PG8_BAR;
    PG8_STAGE(PG8_SB(1, 0), cB + kstep, voffB); PG8_STAGE(PG8_SA(1, 0), cA + kstep, voffA); PG8_STAGE(PG8_SB(1, 1), cB + hstep + kstep, voffB);
    PG8_WAIT_V(6); PG8_BAR;
    for (;;) {
        const bool has_next = S.next(ui + 1, nxt);
        const char* nA = has_next ? nxt.A : cA; const char* nB = has_next ? nxt.B : cB;
        const int nt = cur.nt;
        for (int t = 0; t < nt; t += 2) {
            const bool last = (t == nt - 2);
            const char* a1 = cA + (size_t)(t + 1) * kstep;
            const char* a2 = last ? nA : cA + (size_t)(t + 2) * kstep; const char* b2 = last ? nB : cB + (size_t)(t + 2) * kstep;
            const char* a3 = a2 + kstep; const char* b3 = b2 + kstep;
            PG8_LDB(B0, 0, 0); PG8_LDB(B1, 0, 1); PG8_SCHED; PG8_LDA(At, 0, 0); PG8_STAGE(PG8_SA(1, 1), a1 + hstep, voffA);
            PG8_WAIT_V(8); PG8_WAIT_L(0); PG8_BAR; PG8_MMA(0, 0, At, B0); PG8_MMA(0, 1, At, B1); PG8_BAR; PG8_SCHED;
            PG8_LDA(At, 0, 1); PG8_STAGE(PG8_SB(0, 0), b2, voffB); PG8_STAGE(PG8_SB(0, 1), b2 + hstep, voffB); PG8_STAGE(PG8_SA(0, 0), a2, voffA);
            PG8_WAIT_V(8); PG8_WAIT_L(0); PG8_BAR; PG8_MMA(1, 0, At, B0); PG8_MMA(1, 1, At, B1); PG8_BAR; PG8_SCHED;
            PG8_LDB(B0, 1, 0); PG8_LDB(B1, 1, 1); PG8_SCHED; PG8_LDA(At, 1, 0); PG8_STAGE(PG8_SA(0, 1), a2 + hstep, voffA);
            PG8_WAIT_V(8); PG8_WAIT_L(0); PG8_BAR; PG8_MMA(0, 0, At, B0); PG8_MMA(0, 1, At, B1); PG8_BAR; PG8_SCHED;
            PG8_LDA(At, 1, 1); PG8_STAGE(PG8_SB(1, 0), b3, voffB); PG8_STAGE(PG8_SB(1, 1), b3 + hstep, voffB); PG8_STAGE(PG8_SA(1, 0), a3, voffA);
            PG8_WAIT_V(8); PG8_WAIT_L(0); PG8_BAR; PG8_MMA(1, 0, At, B0); PG8_MMA(1, 1, At, B1); PG8_BAR; PG8_SCHED;
        }
        if constexpr (ALIGN_EPI) { if (wr == 0) PG8_BAR; }
        E(acc, cur, wr, wc, fr, fq);
        if (!has_next) break;
#pragma unroll
        for (int a = 0; a < 2; ++a)
#pragma unroll
            for (int b = 0; b < 2; ++b)
#pragma unroll
                for (int m = 0; m < 4; ++m)
#pragma unroll
                    for (int n = 0; n < 2; ++n) acc[a][b][m][n] = (f32x4){0.f, 0.f, 0.f, 0.f};
        cur = nxt; cA = nA; cB = nB; ++ui;
        if constexpr (ALIGN_EPI) { if (wr == 1) PG8_BAR; }
    }
    PG8_WAIT_V(0);
    if constexpr (!ALIGN_EPI) { if (wr == 0) PG8_BAR; }
    PG8_BAR;
#undef PG8_SA
#undef PG8_SB
#undef PG8_STAGE
#undef PG8_LDA
#undef PG8_LDB
#undef PG8_MMA
#undef PG8_WAIT_V
#undef PG8_WAIT_L
#undef PG8_BAR
#undef PG8_SCHED
}
}

namespace attn_body {
using bf16=__hip_bfloat16;
using bf16x8=__attribute__((ext_vector_type(8)))short;
using s16x4=__attribute__((ext_vector_type(4)))short;
using f32x16=__attribute__((ext_vector_type(16)))float;
using u32x4=__attribute__((ext_vector_type(4)))unsigned;
constexpr int D=64,QP=1024,KVP=256;
constexpr int NW=8,QBLK=32,QB=QBLK*NW,KVBLK=64;
__device__ __forceinline__ int crow(int r,int hi){return (r&3)+8*(r>>2)+4*hi;}
#define SBAR() __builtin_amdgcn_sched_barrier(0)
__device__ __forceinline__ void cmask(f32x16&p0,f32x16&p1,int jb,int qrel,int hi){
  const float NEG=-INFINITY; int kb=64*jb+4*hi;
  #pragma unroll
  for(int r=0;r<16;++r){int kv=kb+(r&3)+8*(r>>2); if(kv>qrel)p0[r]=NEG; if(kv+32>qrel)p1[r]=NEG;}
}

constexpr int NSLOT=3, SLOTB=8192;
constexpr int LDS_K=0, LDS_V=NSLOT*SLOTB, LDS_WS=2*NSLOT*SLOTB, LDS_OST=LDS_WS+NW*64*4, LDS_BYTES=LDS_OST+NW*4096;
constexpr float C2=0.125f*1.4426950408889634f;
__device__ __forceinline__ void glds16(const void*gsrc,unsigned lds_dst){unsigned keep;
  asm volatile("s_mov_b32 %0, m0\n\ts_mov_b32 m0, %2\n\ts_nop 0\n\tglobal_load_lds_dwordx4 %1, off\n\ts_mov_b32 m0, %0":"=&s"(keep):"v"(gsrc),"s"(lds_dst):"memory");}
__device__ __forceinline__ float max3f(float a,float b,float c){float r;asm("v_max3_f32 %0, %1, %2, %3":"=v"(r):"v"(a),"v"(b),"v"(c));return r;}
__device__ __forceinline__ float max2f(float a,float b){float r;asm("v_max_f32_e32 %0, %1, %2":"=v"(r):"v"(a),"v"(b));return r;}
__device__ __forceinline__ float fadd_s(float a,float b){float r;asm("v_add_f32_e32 %0, %1, %2":"=v"(r):"v"(a),"v"(b));return r;}
__device__ __forceinline__ float fsub_s(float a,float b){float r;asm("v_sub_f32_e32 %0, %1, %2":"=v"(r):"v"(a),"v"(b));return r;}
typedef float f32x2_t __attribute__((ext_vector_type(2))); typedef __bf16 bf16x2_t __attribute__((ext_vector_type(2)));
__device__ __forceinline__ unsigned cvtpk_s(float lo,float hi){f32x2_t v={lo,hi};bf16x2_t b=__builtin_convertvector(v,bf16x2_t);return __builtin_bit_cast(unsigned,b);}
#define WAIT_BAR(N) asm volatile("s_waitcnt vmcnt(" #N ") lgkmcnt(0)\n\ts_barrier":::"memory")

__device__ __forceinline__ void qkt(f32x16&p0,f32x16&p1,const char*Kslot,const bf16x8*qr,const f32x16&negm,int r32,int hi){
  const char*kb=Kslot+hi*1024+r32*16;
  #pragma unroll
  for(int d0=0;d0<4;++d0){
    const bf16x8 b0=*reinterpret_cast<const bf16x8*>(kb+d0*2048);
    const bf16x8 b1=*reinterpret_cast<const bf16x8*>(kb+d0*2048+512);
    if(d0==0){p0=__builtin_amdgcn_mfma_f32_32x32x16_bf16(b0,qr[0],negm,0,0,0);p1=__builtin_amdgcn_mfma_f32_32x32x16_bf16(b1,qr[0],negm,0,0,0);}
    else{p0=__builtin_amdgcn_mfma_f32_32x32x16_bf16(b0,qr[d0],p0,0,0,0);p1=__builtin_amdgcn_mfma_f32_32x32x16_bf16(b1,qr[d0],p1,0,0,0);}}
}
typedef __attribute__((address_space(3))) const char* lds_cptr;
typedef short v4i16_t __attribute__((ext_vector_type(4)));
__device__ __forceinline__ void kload8(bf16x8*kf,lds_cptr kp){
  kf[0]=*(const __attribute__((address_space(3))) bf16x8*)(kp);      kf[1]=*(const __attribute__((address_space(3))) bf16x8*)(kp+512);
  kf[2]=*(const __attribute__((address_space(3))) bf16x8*)(kp+2048); kf[3]=*(const __attribute__((address_space(3))) bf16x8*)(kp+2560);
  kf[4]=*(const __attribute__((address_space(3))) bf16x8*)(kp+4096); kf[5]=*(const __attribute__((address_space(3))) bf16x8*)(kp+4608);
  kf[6]=*(const __attribute__((address_space(3))) bf16x8*)(kp+6144); kf[7]=*(const __attribute__((address_space(3))) bf16x8*)(kp+6656);
}
__device__ __forceinline__ void kload2(bf16x8*kf,lds_cptr kp,int j){ kf[2*j]=*(const __attribute__((address_space(3))) bf16x8*)(kp+j*2048); kf[2*j+1]=*(const __attribute__((address_space(3))) bf16x8*)(kp+j*2048+512); }
__device__ __forceinline__ s16x4 vtr(lds_cptr p){ return __builtin_bit_cast(s16x4,__builtin_amdgcn_ds_read_tr16_b64_v4i16((__attribute__((address_space(3))) v4i16_t*)p)); }
__device__ __forceinline__ float rowmax(const f32x16&p0,const f32x16&p1){
  float a=max3f(p0[0],p0[1],p1[0]),b=max3f(p0[2],p0[3],p1[1]);a=max3f(a,p1[2],p1[3]);
  #pragma unroll
  for(int r=4;r<16;r+=4){a=max3f(a,p0[r],p0[r+1]);b=max3f(b,p0[r+2],p0[r+3]);a=max3f(a,p1[r],p1[r+1]);b=max3f(b,p1[r+2],p1[r+3]);}
  const float m=max2f(a,b);
  auto rr=__builtin_amdgcn_permlane32_swap(__float_as_uint(m),__float_as_uint(m),false,false);
  return max2f(__uint_as_float(rr[0]),__uint_as_float(rr[1]));
}
__device__ __forceinline__ void pv(f32x16*o,int vb,bf16x8 pa0,bf16x8 pa1,bf16x8 pa2,bf16x8 pa3){
  #pragma unroll
  for(int d0=0;d0<2;++d0){s16x4 lo[4],hi[4];
    #pragma unroll
    for(int ks=0;ks<4;++ks){
      asm volatile("ds_read_b64_tr_b16 %0,%1 offset:%c2":"=&v"(lo[ks]):"v"(vb),"i"(d0*4096+ks*1024):"memory");
      asm volatile("ds_read_b64_tr_b16 %0,%1 offset:%c2":"=&v"(hi[ks]):"v"(vb),"i"(d0*4096+ks*1024+512):"memory");}
    asm volatile("s_waitcnt lgkmcnt(0)":::"memory");SBAR();
    #define PK(k) (bf16x8){lo[k][0],lo[k][1],lo[k][2],lo[k][3],hi[k][0],hi[k][1],hi[k][2],hi[k][3]}
    o[d0]=__builtin_amdgcn_mfma_f32_32x32x16_bf16(pa0,PK(0),o[d0],0,0,0);
    o[d0]=__builtin_amdgcn_mfma_f32_32x32x16_bf16(pa1,PK(1),o[d0],0,0,0);
    o[d0]=__builtin_amdgcn_mfma_f32_32x32x16_bf16(pa2,PK(2),o[d0],0,0,0);
    o[d0]=__builtin_amdgcn_mfma_f32_32x32x16_bf16(pa3,PK(3),o[d0],0,0,0);
    #undef PK
  }
}

#ifndef ATTN_STORE16
#define ATTN_STORE16(p,v) (*(u32x4*)(p)=(v))
#endif
template<int THRL> __device__ __forceinline__ void attn_unit(const bf16*Qb,const bf16*__restrict__ Kh,const bf16*__restrict__ Vh,const int NT,const bf16*Gb,bf16*Ob,char*shm){
  const int tid=threadIdx.x,lane=tid&63,r32=lane&31,hi=lane>>5; const int wid=__builtin_amdgcn_readfirstlane(tid>>6);
  const bf16*Qw=Qb+(long)(wid*QBLK)*QP;
  const unsigned lds0=(unsigned)(uintptr_t)shm;
  float*wsf=(float*)(shm+LDS_WS)+wid*64;
  const bf16*ksrc=Kh+(long)lane*KVP+wid*8;
  const bf16*vsrc=Vh+(long)(16*(wid&3)+(lane>>2))*KVP+(wid>>2)*32+(lane&3)*8;
  const unsigned kdst=lds0+LDS_K+wid*1024, vdst=lds0+LDS_V+wid*1024;
  #define DMA_K(t,slot) glds16(ksrc+(long)(t)*KVBLK*KVP,(unsigned)__builtin_amdgcn_readfirstlane(kdst+(slot)))
  #define DMA_V(t,slot) glds16(vsrc+(long)(t)*KVBLK*KVP,(unsigned)__builtin_amdgcn_readfirstlane(vdst+(slot)))
  const int vb0=(int)(lds0+LDS_V)+((lane>>4)&1)*32+(lane&3)*8+(4*hi+((lane&15)>>2))*64;
  const char*Kbase=shm+LDS_K; bf16x8 kf[8];
  const lds_cptr shm3=(lds_cptr)shm; const lds_cptr kp0=shm3+LDS_K+hi*1024+r32*16; const lds_cptr vp0=shm3+LDS_V+((lane>>4)&1)*32+(lane&3)*8+(4*hi+((lane&15)>>2))*64;
  DMA_K(0,0);DMA_V(0,0);DMA_K(1,SLOTB);
  bf16x8 qr[4];
  #pragma unroll
  for(int d0=0;d0<4;++d0)qr[d0]=*reinterpret_cast<const bf16x8*>(&Qw[(long)r32*QP+d0*16+hi*8]);
  float mhat=0.f,l_reg=0.f;f32x16 o[2];o[0]=f32x16{};o[1]=f32x16{};f32x16 negm=f32x16{};asm volatile("":"+v"(negm));
  #define CMASK(P0,P1,t) do{}while(0)
  bool resc=false;
  #define START(P0,P1) do{ const float rm=rowmax(P0,P1); resc=false; \
    { const float dl=rm; mhat=fadd_s(mhat,dl); \
      _Pragma("unroll") for(int r=0;r<16;++r){P0[r]=fsub_s(P0[r],dl);P1[r]=fsub_s(P1[r],dl);} \
      _Pragma("unroll") for(int r=0;r<16;++r)negm[r]=-mhat; asm volatile("":"+v"(negm)); } \
    _Pragma("unroll") for(int r=0;r<16;++r)P0[r]=__builtin_amdgcn_exp2f(P0[r]); }while(0)
  #define RESC() do{ if(resc){ asm volatile("s_waitcnt lgkmcnt(0)":::"memory"); \
      _Pragma("unroll") for(int d_=0;d_<2;++d_) _Pragma("unroll") for(int r=0;r<16;++r)o[d_][r]*=wsf[crow(r,hi)]; } }while(0)
  f32x16 pA0,pA1,pB0,pB1;
  int sl_prev=0,sl_cur=0,sl_next=SLOTB;
  #define ROT() do{sl_prev=sl_cur;sl_cur=sl_next;sl_next=(sl_next==(NSLOT-1)*SLOTB)?0:sl_next+SLOTB;}while(0)
  DMA_K(2,2*SLOTB);
  WAIT_BAR(3);
  qkt(pA0,pA1,Kbase,qr,negm,r32,hi);asm volatile("s_nop 15\n\ts_nop 7":"+v"(pA0),"+v"(pA1));CMASK(pA0,pA1,0);
  START(pA0,pA1);
  _Pragma("unroll") for(int r=0;r<16;++r)pA1[r]=__builtin_amdgcn_exp2f(pA1[r]);
  WAIT_BAR(0);
  DMA_K(3,0);DMA_V(1,SLOTB);
  ROT();
  kload8(kf,kp0+sl_cur);
  WAIT_BAR(2);
  s16x4 vlo[8],vhi[8]; u32x4 pw0,pw1,pw2,pw3;
  #define PKW(P,B) cvtpk_s(P[B],P[B+1])
  #define PAF(k) __builtin_bit_cast(bf16x8,pw##k)
  #define VFR(i) (bf16x8){vlo[i][0],vlo[i][1],vlo[i][2],vlo[i][3],vhi[i][0],vhi[i][1],vhi[i][2],vhi[i][3]}
  #define PIN(x) asm volatile("":"+v"(x))
  #define MX3(a,b,c) __builtin_fmaxf(__builtin_fmaxf((a),(b)),(c))
  #define GAPA(MF,A0,A1,A2,A3,W0,W1,PW) do{ MF; sacc+=A0; sacc+=A1; sacc+=A2; sacc+=A3; PIN(sacc); W0; W1; PIN(PW); SBAR(); }while(0)
  #define EX(v) __builtin_amdgcn_exp2f(v)
  #define GAPB(MF,X,B) do{ MF; X[B]=EX(X[B]); X[B+1]=EX(X[B+1]); X[B+2]=EX(X[B+2]); X[B+3]=EX(X[B+3]); PIN(X); SBAR(); }while(0)
  #define VRD(i) do{ vlo[i]=vtr(vp_+(((i)>>2)*4096+((i)&3)*1024)); vhi[i]=vtr(vp_+(((i)>>2)*4096+((i)&3)*1024+512)); }while(0)
  #define KRD(G,j) do{ if(G){ kload2(kf,kp0+sl_next,j); SBAR(); } }while(0)
  #define STEP(C0,C1,P0,P1,t,GK,GV,GL) do{ SBAR(); \
    const lds_cptr vp_=vp0+sl_prev; \
    VRD(0); SBAR(); float sacc=(P0[0]+P0[1]); \
    GAPA(C0=__builtin_amdgcn_mfma_f32_32x32x16_bf16(kf[0],qr[0],negm,0,0,0), P0[2],P0[3],P0[4],P0[5],     pw0[0]=PKW(P0,0), pw0[1]=PKW(P0,2), pw0); \
    VRD(4); SBAR(); GAPA(C1=__builtin_amdgcn_mfma_f32_32x32x16_bf16(kf[1],qr[0],negm,0,0,0), P0[6],P0[7],P0[8],P0[9],     pw0[2]=PKW(P0,4), pw0[3]=PKW(P0,6), pw0); \
    VRD(1); SBAR(); GAPA(C0=__builtin_amdgcn_mfma_f32_32x32x16_bf16(kf[2],qr[1],C0,0,0,0),   P0[10],P0[11],P0[12],P0[13], pw1[0]=PKW(P0,8), pw1[1]=PKW(P0,10), pw1); \
    VRD(5); SBAR(); GAPA(C1=__builtin_amdgcn_mfma_f32_32x32x16_bf16(kf[3],qr[1],C1,0,0,0),   P0[14],P0[15],P1[0],P1[1],   pw1[2]=PKW(P0,12),pw1[3]=PKW(P0,14), pw1); \
    VRD(2); SBAR(); GAPA(C0=__builtin_amdgcn_mfma_f32_32x32x16_bf16(kf[4],qr[2],C0,0,0,0),   P1[2],P1[3],P1[4],P1[5],     pw2[0]=PKW(P1,0), pw2[1]=PKW(P1,2), pw2); \
    VRD(6); SBAR(); GAPA(C1=__builtin_amdgcn_mfma_f32_32x32x16_bf16(kf[5],qr[2],C1,0,0,0),   P1[6],P1[7],P1[8],P1[9],     pw2[2]=PKW(P1,4), pw2[3]=PKW(P1,6), pw2); \
    VRD(3); SBAR(); GAPA(C0=__builtin_amdgcn_mfma_f32_32x32x16_bf16(kf[6],qr[3],C0,0,0,0),   P1[10],P1[11],P1[12],P1[13], pw3[0]=PKW(P1,8), pw3[1]=PKW(P1,10), pw3); \
    VRD(7); SBAR(); GAPA(C1=__builtin_amdgcn_mfma_f32_32x32x16_bf16(kf[7],qr[3],C1,0,0,0),   P1[14],P1[15],0.f,0.f,       pw3[2]=PKW(P1,12),pw3[3]=PKW(P1,14), pw3); \
    l_reg+=sacc; \
    if(GK){DMA_K((t)+3,sl_cur);} if(GV){DMA_V((t)+1,sl_next);} \
    CMASK(C0,C1,t); \
    { float a=MX3(C0[0],C0[1],C1[0]),b=MX3(C0[2],C0[3],C1[1]); a=MX3(a,C1[2],C1[3]); \
      _Pragma("unroll") for(int r=4;r<16;r+=4){a=MX3(a,C0[r],C0[r+1]);b=MX3(b,C0[r+2],C0[r+3]);a=MX3(a,C1[r],C1[r+1]);b=MX3(b,C1[r+2],C1[r+3]);} \
      float rm=__builtin_fmaxf(a,b); { auto rr=__builtin_amdgcn_permlane32_swap(__float_as_uint(rm),__float_as_uint(rm),false,false); rm=__builtin_fmaxf(__uint_as_float(rr[0]),__uint_as_float(rr[1])); } \
      resc=false; \
      if(__builtin_expect(__any(rm>(float)THRL),0)){ const float dl=__builtin_fmaxf(rm,0.f); mhat+=dl; \
        _Pragma("unroll") for(int r=0;r<16;++r){C0[r]-=dl;C1[r]-=dl;} \
        _Pragma("unroll") for(int r=0;r<16;++r)negm[r]=-mhat; asm volatile("":"+v"(negm)); \
        const float f=__builtin_amdgcn_exp2f(-dl); l_reg*=f; if(hi==0)wsf[r32]=f; resc=true; } } \
    SBAR(); \
    GAPB(o[0]=__builtin_amdgcn_mfma_f32_32x32x16_bf16(PAF(0),VFR(0),o[0],0,0,0), C0,0); \
    GAPB(o[1]=__builtin_amdgcn_mfma_f32_32x32x16_bf16(PAF(0),VFR(4),o[1],0,0,0), C0,4); \
    KRD(GL,0); GAPB(o[0]=__builtin_amdgcn_mfma_f32_32x32x16_bf16(PAF(1),VFR(1),o[0],0,0,0), C0,8); \
    KRD(GL,1); GAPB(o[1]=__builtin_amdgcn_mfma_f32_32x32x16_bf16(PAF(1),VFR(5),o[1],0,0,0), C0,12); \
    KRD(GL,2); GAPB(o[0]=__builtin_amdgcn_mfma_f32_32x32x16_bf16(PAF(2),VFR(2),o[0],0,0,0), C1,0); \
    KRD(GL,3); GAPB(o[1]=__builtin_amdgcn_mfma_f32_32x32x16_bf16(PAF(2),VFR(6),o[1],0,0,0), C1,4); \
    GAPB(o[0]=__builtin_amdgcn_mfma_f32_32x32x16_bf16(PAF(3),VFR(3),o[0],0,0,0), C1,8); \
    GAPB(o[1]=__builtin_amdgcn_mfma_f32_32x32x16_bf16(PAF(3),VFR(7),o[1],0,0,0), C1,12); \
    }while(0)
  int t=1;
  #undef CMASK
  #define CMASK(P0,P1,t) do{}while(0)
  for(;t+5<NT;t+=2){
    STEP(pB0,pB1,pA0,pA1,t,true,true,true);     WAIT_BAR(2); RESC(); ROT();
    STEP(pA0,pA1,pB0,pB1,t+1,true,true,true);   WAIT_BAR(2); RESC(); ROT();
  }
  #undef CMASK
  #define CMASK(P0,P1,t) do{}while(0)
  #define ENDW(tt) do{ if((tt)+3<NT){WAIT_BAR(2);} else if((tt)+2<NT){WAIT_BAR(1);} else {WAIT_BAR(0);} }while(0)
  for(;t+1<NT;t+=2){
    STEP(pB0,pB1,pA0,pA1,t,(t+3<NT),(t+1<NT),(t+1<NT));       ENDW(t);   RESC(); ROT();
    STEP(pA0,pA1,pB0,pB1,t+1,(t+4<NT),(t+2<NT),(t+2<NT));     ENDW(t+1); RESC(); ROT();
  }
  STEP(pB0,pB1,pA0,pA1,NT-1,false,false,false); RESC();
  { float sacc=pB0[0]+pB0[1]; _Pragma("unroll") for(int r=2;r<16;++r)sacc+=pB0[r]; _Pragma("unroll") for(int r=0;r<16;++r)sacc+=pB1[r]; l_reg+=sacc;
    pw0=(u32x4){PKW(pB0,0),PKW(pB0,2),PKW(pB0,4),PKW(pB0,6)};pw1=(u32x4){PKW(pB0,8),PKW(pB0,10),PKW(pB0,12),PKW(pB0,14)};pw2=(u32x4){PKW(pB1,0),PKW(pB1,2),PKW(pB1,4),PKW(pB1,6)};pw3=(u32x4){PKW(pB1,8),PKW(pB1,10),PKW(pB1,12),PKW(pB1,14)};
    SBAR(); pv(o,vb0+sl_cur,PAF(0),PAF(1),PAF(2),PAF(3)); }
  #undef PKW
  #undef PAF
  #undef VFR
  #undef PIN
  #undef MX3
  #undef GAPA
  #undef GAPB
  #undef EX
  #undef VRD
  #undef KRD
  #undef STEP
  #undef ENDW
  u32x4 gpre[4];
  { const bf16*Gw0=Gb+(long)(wid*QBLK)*QP;
    #pragma unroll
    for(int i=0;i<4;++i)gpre[i]=*(const u32x4*)(Gw0+(long)(i*8+(lane>>3))*QP+(lane&7)*8); }
  {auto rr=__builtin_amdgcn_permlane32_swap(__float_as_uint(l_reg),__float_as_uint(l_reg),false,false);l_reg=__uint_as_float(rr[0])+__uint_as_float(rr[1]);}
  if(hi==0)wsf[32+r32]=l_reg;asm volatile("s_waitcnt lgkmcnt(0)":::"memory");
  float rli[16];
  #pragma unroll
  for(int r=0;r<16;++r)rli[r]=__builtin_amdgcn_rcpf(wsf[32+crow(r,hi)]);
  bf16*Ow=Ob+(long)(wid*QBLK)*QP; const bf16*Gw=Gb+(long)(wid*QBLK)*QP;
  { bf16*stg=(bf16*)(shm+LDS_OST)+wid*2048;
    #pragma unroll
    for(int r=0;r<16;++r){const int orow=crow(r,hi);
      #pragma unroll
      for(int d0=0;d0<2;++d0)stg[orow*64+d0*32+r32]=__float2bfloat16(o[d0][r]*rli[r]);}
    asm volatile("s_waitcnt lgkmcnt(0)":::"memory");
    #pragma unroll
    for(int i=0;i<4;++i){const int row=i*8+(lane>>3),ch=lane&7; const u32x4 v=*(const u32x4*)(stg+row*64+ch*8); const u32x4 g=gpre[i]; u32x4 w;
      #define GM(a,b) cvtpk_s(__uint_as_float((a)<<16)*__uint_as_float((b)<<16),__uint_as_float((a)&0xffff0000u)*__uint_as_float((b)&0xffff0000u))
      w.x=GM(v.x,g.x);w.y=GM(v.y,g.y);w.z=GM(v.z,g.z);w.w=GM(v.w,g.w);
      #undef GM
      ATTN_STORE16(Ow+(long)row*QP+ch*8,w);} }
  asm volatile("s_waitcnt lgkmcnt(0)\n\ts_barrier":::"memory");
  #undef DMA_K
  #undef DMA_V
  #undef CMASK
  #undef START
  #undef RESC
  #undef ROT
}
constexpr int ATTN_LDS_BYTES=LDS_BYTES;
#undef SBAR
#undef WAIT_BAR
}

__device__ __forceinline__ unsigned xb_ld(unsigned* p)              { return __hip_atomic_load(p, __ATOMIC_RELAXED, __HIP_MEMORY_SCOPE_AGENT); }
__device__ __forceinline__ unsigned xb_add(unsigned* p, unsigned v) { return __hip_atomic_fetch_add(p, v, __ATOMIC_RELAXED, __HIP_MEMORY_SCOPE_AGENT); }
#define XB_TMO      128
#define XB_XCNT(j)  (256  + 64 * (j))
#define XB_XSUB(j)  (1280 + 64 * (j))
#define XB_XGEN(j)  (2304 + 64 * (j))
#define XB_TOP      3328
#define XB_TOPGEN   3392
#define XCD_BAR_WORDS 3456
#define XB_SPIN_CAP (1u << 18)

__device__ __forceinline__ unsigned xb_xcc_id() { return (unsigned)__builtin_amdgcn_s_getreg((3 << 11) | 20) & 0xFu; }
#define XB_SPIN(cond, bar) do { unsigned _sp = 0; while (cond) { __builtin_amdgcn_s_sleep(1); \
    if ((++_sp & 255u) == 0u) { if (xb_ld(&(bar)[XB_TMO])) break; if (_sp > XB_SPIN_CAP) { atomicAdd(&(bar)[XB_TMO], 1u); break; } } } } while (0)

struct XcdBarrier {
    unsigned* bar; unsigned x;
    volatile LAS unsigned* st;
};

__device__ __forceinline__ XcdBarrier xcd_barrier_post(unsigned* bar, volatile LAS unsigned* st) {
    XcdBarrier b; b.bar = bar; b.x = xb_xcc_id(); b.st = st;
    if (threadIdx.x == 0) (void)xb_add(&bar[XB_XCNT(b.x)], 1u);
    return b;
}
__device__ __forceinline__ void xcd_barrier_complete(unsigned* bar, unsigned x, unsigned& nloc, unsigned& nx) {
    const unsigned G = gridDim.x * gridDim.y * gridDim.z;
    unsigned sum, cnt, mine, sp = 0u;
    for (;;) {
        sum = 0u; cnt = 0u; mine = 0u;
#pragma unroll
        for (unsigned j = 0; j < 16; ++j) { const unsigned c = xb_ld(&bar[XB_XCNT(j)]); sum += c; cnt += (c > 0u) ? 1u : 0u; mine = (j == x) ? c : mine; }
        if (sum == G) break;
        __builtin_amdgcn_s_sleep(1);
        if ((++sp & 255u) == 0u) { if (xb_ld(&bar[XB_TMO])) break; if (sp > XB_SPIN_CAP) { atomicAdd(&bar[XB_TMO], 1u); break; } }
    }
    nloc = mine > 0u ? mine : 1u; nx = cnt > 0u ? cnt : 1u;
}

__device__ __forceinline__ void xcd_barrier(const XcdBarrier& b) {
    asm volatile("s_waitcnt vmcnt(0)" ::: "memory");
    __syncthreads();
    if (threadIdx.x == 0) {
        unsigned* bar = b.bar;
        __builtin_amdgcn_s_waitcnt(0);
        unsigned nloc = b.st[0], nx = b.st[1];
        if (nloc == 0u) { xcd_barrier_complete(bar, b.x, nloc, nx); b.st[0] = nloc; b.st[1] = nx; }
        const unsigned old = xb_add(&bar[XB_XSUB(b.x)], 1u);
        const unsigned gen = old / nloc;
        if (old + 1u == (gen + 1u) * nloc) {
            __builtin_amdgcn_fence(__ATOMIC_RELEASE, "agent");
            asm volatile("s_waitcnt vmcnt(0)" ::: "memory");
            const unsigned og = xb_add(&bar[XB_TOP], 1u);
            const unsigned tg = og / nx;
            if (og + 1u == (tg + 1u) * nx) xb_add(&bar[XB_TOPGEN], 1u);
            else XB_SPIN(xb_ld(&bar[XB_TOPGEN]) == tg, bar);
            __builtin_amdgcn_fence(__ATOMIC_ACQUIRE, "agent");
            xb_add(&bar[XB_XGEN(b.x)], 1u);
            asm volatile("s_waitcnt vmcnt(0)" ::: "memory");
        } else {
            XB_SPIN(xb_ld(&bar[XB_XGEN(b.x)]) == gen, bar);
            __builtin_amdgcn_fence(__ATOMIC_ACQUIRE, "agent");
            asm volatile("s_waitcnt vmcnt(0)" ::: "memory");
        }
    }
    __syncthreads();
}

using pg8::Unit;
typedef f32x4 AccT[2][2][4][2];

struct EpiStore {
    const float* pscale;
    __device__ __forceinline__ void operator()(const AccT& acc, const Unit& u, int wr, int wc, int fr, int fq) const {
        asm volatile("" : "+v"(fr), "+v"(fq));
        bf16_t* base = (bf16_t*)u.O; const int ldc = u.ldc, kind = u.kind; const float sc = u.sc;
#pragma unroll
        for (int ai = 0; ai < 2; ++ai)
#pragma unroll
            for (int m = 0; m < 4; ++m) {
                bf16_t* rowp = base + (size_t)(ai * 128 + wr * 64 + m * 16 + fr) * ldc + wc * 32 + 8 * fq;
#pragma unroll
                for (int bj = 0; bj < 2; ++bj) {
                    f32x4 v0 = acc[ai][bj][m][0], v1 = acc[ai][bj][m][1];
                    if (kind == 1) {
#pragma unroll
                        for (int e = 0; e < 4; ++e) { v0[e] = siluf_(v0[e]); v1[e] = siluf_(v1[e]); }
                    } else if (kind == 2) { v0 = v0 * sc; v1 = v1 * sc; }
                    u32x4 w; w.x = pk2(v0[0], v0[1]); w.y = pk2(v0[2], v0[3]); w.z = pk2(v1[0], v1[1]); w.w = pk2(v1[2], v1[3]);
                    *(u32x4*)(rowp + bj * 128) = w;
                }
            }
    }
};
struct EpiGate {
    const float* bmerge; char* scr;
    __device__ __forceinline__ void operator()(const AccT& acc, const Unit& u, int wr, int wc, int fr, int fq) const {
        asm volatile("" : "+v"(fr), "+v"(fq));
        int tid = threadIdx.x; const int n = u.aux; asm volatile("" : "+v"(tid));
        u32x4* gst = (u32x4*)scr;
        if (u.kind == 0) {
            const float* bp = bmerge + n * 1024 + u.c0 + wc * 32 + 8 * fq;
            f32x4 bb[2][2];
#pragma unroll
            for (int bj = 0; bj < 2; ++bj) { bb[bj][0] = *(const f32x4*)(bp + bj * 128); bb[bj][1] = *(const f32x4*)(bp + bj * 128 + 4); }
#pragma unroll
            for (int bj = 0; bj < 2; ++bj) {
#pragma unroll
                for (int ai = 0; ai < 2; ++ai)
#pragma unroll
                    for (int m = 0; m < 4; ++m) {
                        const f32x4 v0 = (acc[ai][bj][m][0] + bb[bj][0]) * (-LOG2E), v1 = (acc[ai][bj][m][1] + bb[bj][1]) * (-LOG2E);
                        u32x4 w; w.x = pk2(__builtin_amdgcn_exp2f(v0[0]), __builtin_amdgcn_exp2f(v0[1])); w.y = pk2(__builtin_amdgcn_exp2f(v0[2]), __builtin_amdgcn_exp2f(v0[3]));
                        w.z = pk2(__builtin_amdgcn_exp2f(v1[0]), __builtin_amdgcn_exp2f(v1[1])); w.w = pk2(__builtin_amdgcn_exp2f(v1[2]), __builtin_amdgcn_exp2f(v1[3]));
                        gst[((ai * 2 + bj) * 4 + m) * 512 + tid] = w;
                    }
                asm volatile("" ::: "memory");
            }
        } else {
            bf16_t* base = (bf16_t*)u.O;
            u32x4* mst = (u32x4*)(scr + 131072);
#pragma unroll
            for (int ai = 0; ai < 2; ++ai) {
                u32x4 g[8], pm[8];
#pragma unroll
                for (int e = 0; e < 8; ++e) { const int si = (ai * 2 + (e & 1)) * 4 + (e >> 1); g[e] = gst[si * 512 + tid]; if (n > 0) pm[e] = mst[si * 512 + tid]; }
#pragma unroll
                for (int e = 0; e < 8; ++e) {
                    const int bj = e & 1, m = e >> 1, si = (ai * 2 + bj) * 4 + m;
                    f32x4 v0 = acc[ai][bj][m][0], v1 = acc[ai][bj][m][1];
#define GSIG(x_) fast_rcp(1.0f + (x_))
                    v0[0] *= GSIG(bflo(g[e].x)); v0[1] *= GSIG(bfhi(g[e].x)); v0[2] *= GSIG(bflo(g[e].y)); v0[3] *= GSIG(bfhi(g[e].y));
                    v1[0] *= GSIG(bflo(g[e].z)); v1[1] *= GSIG(bfhi(g[e].z)); v1[2] *= GSIG(bflo(g[e].w)); v1[3] *= GSIG(bfhi(g[e].w));
#undef GSIG
                    if (n > 0) { v0[0] += bflo(pm[e].x); v0[1] += bfhi(pm[e].x); v0[2] += bflo(pm[e].y); v0[3] += bfhi(pm[e].y);
                                 v1[0] += bflo(pm[e].z); v1[1] += bfhi(pm[e].z); v1[2] += bflo(pm[e].w); v1[3] += bfhi(pm[e].w); }
                    u32x4 w; w.x = pk2(v0[0], v0[1]); w.y = pk2(v0[2], v0[3]); w.z = pk2(v1[0], v1[1]); w.w = pk2(v1[2], v1[3]);
                    if (n < 2) mst[si * 512 + tid] = w;
                    else *(u32x4*)(base + (size_t)(ai * 128 + wr * 64 + m * 16 + fr) * 1024 + wc * 32 + 8 * fq + bj * 128) = w;
                }
                asm volatile("" ::: "memory");
            }
        }
    }
};
struct EpiOut {
    float* ss; unsigned* cnt; const float* xp; const float* xs; const float* gpost; float* out;
    __device__ __forceinline__ void operator()(const AccT& acc, const Unit& u, int wr, int wc, int fr, int fq) const {
        asm volatile("" : "+v"(fr), "+v"(fq));
        const int pm = u.r0 >> 8;
        const float* xb = (u.r0 < T_P) ? xp + (size_t)u.r0 * DM : xs + (size_t)(u.r0 - T_P) * DM;
        float* ob = out + (size_t)u.r0 * DM;
        const int colb = u.c0 + wc * 32 + 8 * fq;
        f32x4 gg[2][2], xv[4][2][2];
#pragma unroll
        for (int bj = 0; bj < 2; ++bj) { gg[bj][0] = *(const f32x4*)(gpost + colb + bj * 128); gg[bj][1] = *(const f32x4*)(gpost + colb + bj * 128 + 4); }
#pragma unroll
        for (int m = 0; m < 4; ++m) { const int row = wr * 64 + m * 16 + fr;
#pragma unroll
            for (int bj = 0; bj < 2; ++bj) { const size_t off = (size_t)row * DM + colb + bj * 128; xv[m][bj][0] = __builtin_nontemporal_load((const f32x4*)(xb + off)); xv[m][bj][1] = __builtin_nontemporal_load((const f32x4*)(xb + off + 4)); } }
#pragma unroll
        for (int ai = 0; ai < 2; ++ai)
#pragma unroll
            for (int m = 0; m < 4; ++m) {
                float s = 0.f;
#pragma unroll
                for (int bj = 0; bj < 2; ++bj) {
                    const f32x4 v0 = acc[ai][bj][m][0], v1 = acc[ai][bj][m][1];
                    s += (v0[0] * v0[0] + v0[1] * v0[1]) + (v0[2] * v0[2] + v0[3] * v0[3]) + (v1[0] * v1[0] + v1[1] * v1[1]) + (v1[2] * v1[2] + v1[3] * v1[3]);
                }
                s += __shfl_xor(s, 16); s += __shfl_xor(s, 32);
                if (fq == 0) __hip_atomic_fetch_add(ss + u.r0 + ai * 128 + wr * 64 + m * 16 + fr, s, __ATOMIC_RELAXED, __HIP_MEMORY_SCOPE_AGENT);
            }
        asm volatile("s_waitcnt vmcnt(0)" ::: "memory");
        __builtin_amdgcn_s_barrier();
        if (threadIdx.x == 0) __hip_atomic_fetch_add(cnt + pm, 1u, __ATOMIC_RELAXED, __HIP_MEMORY_SCOPE_AGENT);
        { unsigned sp = 0;
          while ((unsigned)__builtin_amdgcn_readfirstlane(__hip_atomic_load(cnt + pm, __ATOMIC_RELAXED, __HIP_MEMORY_SCOPE_AGENT)) < 4u && sp < (1u << 22)) { __builtin_amdgcn_s_sleep(2); ++sp; } }
        asm volatile("" ::: "memory");
        float sv[2][4];
#pragma unroll
        for (int ai = 0; ai < 2; ++ai)
#pragma unroll
            for (int m = 0; m < 4; ++m) sv[ai][m] = __hip_atomic_load(ss + u.r0 + ai * 128 + wr * 64 + m * 16 + fr, __ATOMIC_RELAXED, __HIP_MEMORY_SCOPE_AGENT);
#pragma unroll
        for (int ai = 0; ai < 2; ++ai) {
            if (ai == 1) {
#pragma unroll
                for (int m = 0; m < 4; ++m) { const int row = 128 + wr * 64 + m * 16 + fr;
#pragma unroll
                    for (int bj = 0; bj < 2; ++bj) { const size_t off = (size_t)row * DM + colb + bj * 128; xv[m][bj][0] = __builtin_nontemporal_load((const f32x4*)(xb + off)); xv[m][bj][1] = __builtin_nontemporal_load((const f32x4*)(xb + off + 4)); } }
            }
#pragma unroll
            for (int m = 0; m < 4; ++m) { const int row = ai * 128 + wr * 64 + m * 16 + fr;
                const float rinv = 1.0f / sqrtf(sv[ai][m] * (1.f / 1024.f) + EPS);
#pragma unroll
                for (int bj = 0; bj < 2; ++bj) { const size_t off = (size_t)row * DM + colb + bj * 128;
                    *(f32x4*)(ob + off) = xv[m][bj][0] + acc[ai][bj][m][0] * rinv * gg[bj][0];
                    *(f32x4*)(ob + off + 4) = xv[m][bj][1] + acc[ai][bj][m][1] * rinv * gg[bj][1]; } }
            asm volatile("" ::: "memory");
        }
    }
};

struct Ptrs {
    unsigned char* ws;
    __device__ __forceinline__ char* at(size_t off) const { return (char*)ws + off; }
};
struct SchedP1 {
    Ptrs P; int G, c;
    __device__ __forceinline__ bool next(int i, Unit& u) const {
        const int L = i * G + c; constexpr int N1 = 320 * 13, N2 = 18 * 4;
        if (L >= N1 + N2) return false;
        u.nt = 16; u.aux = 0; u.sc = 1.f;
        if (L < N1) {
            int pm, pn; pg8::tile_order(L, 320, 13, pm, pn);
            u.A = P.at(WS_XN) + (size_t)pm * 256 * 2048; u.B = P.at(WS_WIN) + (size_t)pn * 256 * 2048; u.r0 = pm * 256;
            size_t dst; int col, ldc = 1024, kind = 0;
            if (pn < 2) { dst = WS_ZA; col = pn * 256; }
            else if (pn < 4) { dst = WS_ZA; col = 512 + (pn - 2) * 256; kind = 1; }
            else if (pn < 6) { dst = WS_ZB; col = (pn - 4) * 256; }
            else if (pn == 6) { dst = WS_ZD; col = 0; ldc = 256; }
            else if (pn < 9) { dst = WS_ZB; col = 512 + (pn - 7) * 256; kind = 1; }
            else if (pn < 11) { dst = WS_ZC; col = (pn - 9) * 256; kind = 2; u.sc = C2_CROSS; }
            else { dst = WS_ZC; col = 512 + (pn - 11) * 256; kind = 1; }
            u.kind = kind; u.ldc = ldc; u.c0 = col; u.O = P.at(dst) + ((size_t)pm * 256 * ldc + col) * 2;
        } else {
            const int l = L - N1, pm = l >> 2, pn = l & 3;
            u.A = P.at(WS_MEMN) + (size_t)pm * 256 * 2048; u.B = P.at(WS_WMKV) + (size_t)pn * 256 * 2048; u.r0 = pm * 256; u.c0 = pn * 256;
            u.kind = 0; u.ldc = 1024; u.O = P.at(WS_MKV) + ((size_t)pm * 256 * 1024 + pn * 256) * 2;
        }
        return true;
    }
};
struct SchedMerge {
    Ptrs P; int G, c;
    __device__ __forceinline__ bool next(int i, Unit& u) const {
        const int ti = i / 6, sub = i - ti * 6; const int L = ti * G + c; if (L >= 1280) return false;
        int pm, pn; pg8::tile_order(L, 320, 4, pm, pn);
        const int n = sub >> 1; u.aux = n; u.r0 = pm * 256; u.c0 = pn * 256; u.ldc = 1024; u.sc = 1.f;
        u.O = P.at(WS_ZA) + ((size_t)pm * 256 * 1024 + pn * 256) * 2;
        if ((sub & 1) == 0) { u.kind = 0; u.nt = 16; u.A = P.at(WS_XN) + (size_t)pm * 256 * 2048; u.B = P.at(WS_WIN) + (size_t)(ZW + n * 1024 + pn * 256) * 2048; }
        else { u.kind = 1; u.nt = 8;
            u.A = P.at(n == 0 ? WS_MIX : (n == 1 ? WS_ZB : WS_ZC)) + (size_t)pm * 256 * 2048;
            u.B = P.at(n < 2 ? WS_WB01 : WS_WB2P) + ((size_t)pn * 256 * 1024 + (n == 1 ? 512 : 0)) * 2; }
        return true;
    }
};
struct SchedOut {
    Ptrs P; int G, c;
    __device__ __forceinline__ bool next(int i, Unit& u) const {
        const int L = i * G + c; if (L >= 1280) return false;
        int pm, pn; pg8::tile_order(L, 320, 4, pm, pn);
        u.A = P.at(WS_ZA) + (size_t)pm * 256 * 2048; u.B = P.at(WS_WOUT) + (size_t)pn * 256 * 2048;
        u.nt = 16; u.kind = 0; u.r0 = pm * 256; u.c0 = pn * 256; u.aux = 0; u.ldc = 1024; u.sc = 1.f;
        u.O = P.at(WS_XN) + ((size_t)pm * 256 * 1024 + pn * 256) * 2;
        return true;
    }
};

__device__ __forceinline__ void cross_attn_phase(bf16_t* ZC, const bf16_t* MKV, LAS unsigned char* lds, int vcu, int G) {
    constexpr int D = 128, KPL = 136, VPL = 260;
    const int tid = threadIdx.x, lane = tid & 63, r32 = lane & 31, hi = lane >> 5; const int wid = __builtin_amdgcn_readfirstlane(tid >> 6);
    LAS bf16_t* Ks = (LAS bf16_t*)lds;
    LAS bf16_t* Vt = (LAS bf16_t*)(lds + 256 * KPL * 2);
    LAS float* wsf = (LAS float*)(lds + 256 * KPL * 2 + D * VPL * 2) + wid * 32;
    const int i_lo = (int)((long)vcu * 1280 / G), i_hi = (int)((long)(vcu + 1) * 1280 / G);
    int loaded = -1;
    for (int I = i_lo; I < i_hi; ++I) {
        int bh, qt, row0;
        if (I < 256) { bh = I >> 5; qt = I & 31; row0 = (bh >> 2) * L_P + qt * 256; }
        else { const int J = I - 256; bh = 8 + (J >> 4); qt = J & 15; row0 = T_P + ((bh >> 2) - 2) * L_S + qt * 256; }
        const int b = bh >> 2, h = bh & 3;
        if (bh != loaded) {
            __syncthreads();
            const bf16_t* Kg = MKV + (size_t)b * NMEM * 1024 + h * 128; const bf16_t* Vg = Kg + 512;
#pragma unroll
            for (int c = 0; c < 8; ++c) { const int idx = tid + c * 512, key = idx >> 4, ch = idx & 15;
                const u32x4 kv = *(const u32x4*)(Kg + (size_t)key * 1024 + ch * 8), vv = *(const u32x4*)(Vg + (size_t)key * 1024 + ch * 8);
                *(LAS u32x4*)(Ks + key * KPL + ch * 8) = kv;
                const unsigned w[4] = {vv.x, vv.y, vv.z, vv.w};
#pragma unroll
                for (int j = 0; j < 4; ++j) { Vt[(ch * 8 + 2 * j) * VPL + key] = (bf16_t)(w[j] & 0xffffu); Vt[(ch * 8 + 2 * j + 1) * VPL + key] = (bf16_t)(w[j] >> 16); } }
            __syncthreads();
            loaded = bh;
        }
        bf16_t* Q = ZC + (size_t)(row0 + wid * 32) * 1024 + h * 128;
        bf16x8 qf[D / 16];
#pragma unroll
        for (int d0 = 0; d0 < D / 16; ++d0) qf[d0] = *(const bf16x8*)(Q + (size_t)r32 * 1024 + d0 * 16 + hi * 8);
        f32x16 o[D / 32];
#pragma unroll
        for (int dt = 0; dt < D / 32; ++dt)
#pragma unroll
            for (int r = 0; r < 16; ++r) o[dt][r] = 0.f;
        float m_run = -1e30f, l_run = 0.f;
#pragma unroll 1
        for (int kt = 0; kt < 4; ++kt) {
            f32x16 s0, s1;
#pragma unroll
            for (int r = 0; r < 16; ++r) { s0[r] = 0.f; s1[r] = 0.f; }
#pragma unroll
            for (int d0 = 0; d0 < D / 16; ++d0) {
                const bf16x8 a0 = *(const LAS bf16x8*)(Ks + (kt * 64 + r32) * KPL + d0 * 16 + hi * 8);
                const bf16x8 a1 = *(const LAS bf16x8*)(Ks + (kt * 64 + 32 + r32) * KPL + d0 * 16 + hi * 8);
                s0 = __builtin_amdgcn_mfma_f32_32x32x16_bf16(a0, qf[d0], s0, 0, 0, 0);
                s1 = __builtin_amdgcn_mfma_f32_32x32x16_bf16(a1, qf[d0], s1, 0, 0, 0);
            }
            float mx = s0[0];
#pragma unroll
            for (int r = 0; r < 16; ++r) { mx = fmaxf(mx, s0[r]); mx = fmaxf(mx, s1[r]); }
            mx = fmaxf(mx, __shfl_xor(mx, 32));
            const float m_new = fmaxf(m_run, mx);
            const float alpha = __builtin_amdgcn_exp2f(m_run - m_new);
            m_run = m_new;
            float rs = 0.f;
#pragma unroll
            for (int r = 0; r < 16; ++r) { s0[r] = __builtin_amdgcn_exp2f(s0[r] - m_new); s1[r] = __builtin_amdgcn_exp2f(s1[r] - m_new); rs += s0[r] + s1[r]; }
            l_run = l_run * alpha + rs;
            if (kt > 0) {
                __builtin_amdgcn_wave_barrier();
                if (hi == 0) wsf[r32] = alpha;
                __builtin_amdgcn_fence(__ATOMIC_RELEASE, "wavefront"); __builtin_amdgcn_wave_barrier(); __builtin_amdgcn_fence(__ATOMIC_ACQUIRE, "wavefront");
#pragma unroll
                for (int r = 0; r < 16; ++r) { const float a = wsf[crow(r, hi)];
#pragma unroll
                    for (int dt = 0; dt < D / 32; ++dt) o[dt][r] *= a; }
            }
            bf16x8 pw[4];
            { u32x4 p;
              p.x = pk2(s0[0], s0[1]); p.y = pk2(s0[2], s0[3]); p.z = pk2(s0[4], s0[5]); p.w = pk2(s0[6], s0[7]); pw[0] = __builtin_bit_cast(bf16x8, p);
              p.x = pk2(s0[8], s0[9]); p.y = pk2(s0[10], s0[11]); p.z = pk2(s0[12], s0[13]); p.w = pk2(s0[14], s0[15]); pw[1] = __builtin_bit_cast(bf16x8, p);
              p.x = pk2(s1[0], s1[1]); p.y = pk2(s1[2], s1[3]); p.z = pk2(s1[4], s1[5]); p.w = pk2(s1[6], s1[7]); pw[2] = __builtin_bit_cast(bf16x8, p);
              p.x = pk2(s1[8], s1[9]); p.y = pk2(s1[10], s1[11]); p.z = pk2(s1[12], s1[13]); p.w = pk2(s1[14], s1[15]); pw[3] = __builtin_bit_cast(bf16x8, p); }
#pragma unroll
            for (int dt = 0; dt < D / 32; ++dt)
#pragma unroll
                for (int ks = 0; ks < 4; ++ks) {
                    const LAS bf16_t* vp = Vt + (dt * 32 + r32) * VPL + kt * 64 + 16 * ks + 4 * hi;
                    const s16x4 lo = *(const LAS s16x4*)vp, hh = *(const LAS s16x4*)(vp + 8);
                    const bf16x8 bb = __builtin_shufflevector(lo, hh, 0, 1, 2, 3, 4, 5, 6, 7);
                    o[dt] = __builtin_amdgcn_mfma_f32_32x32x16_bf16(pw[ks], bb, o[dt], 0, 0, 0);
                }
        }
        l_run += __shfl_xor(l_run, 32);
        __builtin_amdgcn_wave_barrier();
        if (hi == 0) wsf[r32] = fast_rcp(l_run);
        __builtin_amdgcn_fence(__ATOMIC_RELEASE, "wavefront"); __builtin_amdgcn_wave_barrier(); __builtin_amdgcn_fence(__ATOMIC_ACQUIRE, "wavefront");
#pragma unroll
        for (int r = 0; r < 16; ++r) {
            const int row = crow(r, hi); const float inv = wsf[row];
#pragma unroll
            for (int dt = 0; dt < D / 32; ++dt) {
                const int col = dt * 32 + r32;
                const float g = __builtin_bit_cast(float, (unsigned)Q[(size_t)row * 1024 + 512 + col] << 16);
                Q[(size_t)row * 1024 + col] = (bf16_t)f2bf(o[dt][r] * inv * g);
            }
        }
        __builtin_amdgcn_wave_barrier();
    }
    __syncthreads();
}

__device__ __forceinline__ void transpose_item(const float* W, int ldw, int nblk, bf16_t* WT, LAS float* scr, int item, int lane) {
    const int kb = item / nblk, nb = item % nblk, k0 = 64 * kb, n0 = 32 * nb;
#pragma unroll 8
    for (int i = 0; i < 32; ++i) { const int kk = 2 * i + (lane >> 5); scr[kk * 33 + (lane & 31)] = W[(size_t)(k0 + kk) * ldw + n0 + (lane & 31)]; }
    asm volatile("s_waitcnt lgkmcnt(0)" ::: "memory");
    const int c = lane & 7;
#pragma unroll
    for (int j = 0; j < 4; ++j) { const int n = (lane >> 3) + 8 * j; const LAS float* s = scr + (8 * c) * 33 + n;
        u32x4 o; o.x = pk2(s[0 * 33], s[1 * 33]); o.y = pk2(s[2 * 33], s[3 * 33]); o.z = pk2(s[4 * 33], s[5 * 33]); o.w = pk2(s[6 * 33], s[7 * 33]);
        *(u32x4*)(WT + (size_t)(n0 + n) * 1024 + k0 + 8 * c) = o; }
    asm volatile("s_waitcnt lgkmcnt(0)" ::: "memory");
}
__device__ __forceinline__ void rms_row_to_bf16(const float* xrow, const float* g, bf16_t* orow, int lane) {
    const f32x4* xr = (const f32x4*)xrow + lane; const f32x4* gr = (const f32x4*)g + lane;
    f32x4 v[4]; float s = 0.f;
#pragma unroll
    for (int j = 0; j < 4; ++j) { v[j] = xr[64 * j]; s += (v[j].x * v[j].x + v[j].y * v[j].y) + (v[j].z * v[j].z + v[j].w * v[j].w); }
    const float rinv = 1.0f / sqrtf(wave_sum(s) * (1.f / 1024.f) + EPS);
    u32x2* o8 = (u32x2*)orow + lane;
#pragma unroll
    for (int j = 0; j < 4; ++j) { const f32x4 gg = gr[64 * j]; u32x2 w; w.x = pk2(v[j].x * rinv * gg.x, v[j].y * rinv * gg.y); w.y = pk2(v[j].z * rinv * gg.z, v[j].w * rinv * gg.w); o8[64 * j] = w; }
}

__device__ __forceinline__ void rms_row2_to_bf16(const float* xa, const float* xb, const float* g, bf16_t* oa, bf16_t* ob, int lane) {
    const f32x4* ra = (const f32x4*)xa + lane; const f32x4* rb = (const f32x4*)xb + lane; const f32x4* gr = (const f32x4*)g + lane;
    f32x4 va[4], vb[4]; float sa = 0.f, sb = 0.f;
#pragma unroll
    for (int j = 0; j < 4; ++j) { va[j] = ra[64 * j]; vb[j] = rb[64 * j]; }
#pragma unroll
    for (int j = 0; j < 4; ++j) { sa += (va[j].x * va[j].x + va[j].y * va[j].y) + (va[j].z * va[j].z + va[j].w * va[j].w); sb += (vb[j].x * vb[j].x + vb[j].y * vb[j].y) + (vb[j].z * vb[j].z + vb[j].w * vb[j].w); }
#pragma unroll
    for (int o = 1; o < 64; o <<= 1) { sa += __shfl_xor(sa, o); sb += __shfl_xor(sb, o); }
    const float ia = 1.0f / sqrtf(sa * (1.f / 1024.f) + EPS), ib = 1.0f / sqrtf(sb * (1.f / 1024.f) + EPS);
    u32x2* pa = (u32x2*)oa + lane; u32x2* pb = (u32x2*)ob + lane;
#pragma unroll
    for (int j = 0; j < 4; ++j) { const f32x4 gg = gr[64 * j]; u32x2 w;
        w.x = pk2(va[j].x * ia * gg.x, va[j].y * ia * gg.y); w.y = pk2(va[j].z * ia * gg.z, va[j].w * ia * gg.w); pa[64 * j] = w;
        w.x = pk2(vb[j].x * ib * gg.x, vb[j].y * ib * gg.y); w.y = pk2(vb[j].z * ib * gg.z, vb[j].w * ib * gg.w); pb[64 * j] = w; }
}

__device__ __forceinline__ void rms_row4_to_bf16(const float* x0, const float* x1, const float* x2, const float* x3, const float* g, bf16_t* o0, bf16_t* o1, bf16_t* o2, bf16_t* o3, int lane) {
    const f32x4* r[4] = {(const f32x4*)x0 + lane, (const f32x4*)x1 + lane, (const f32x4*)x2 + lane, (const f32x4*)x3 + lane}; const f32x4* gr = (const f32x4*)g + lane;
    u32x2* po[4] = {(u32x2*)o0 + lane, (u32x2*)o1 + lane, (u32x2*)o2 + lane, (u32x2*)o3 + lane};
    f32x4 v[4][4]; float sq[4] = {0.f, 0.f, 0.f, 0.f};
#pragma unroll
    for (int q = 0; q < 4; ++q)
#pragma unroll
        for (int j = 0; j < 4; ++j) v[q][j] = __builtin_nontemporal_load(r[q] + 64 * j);
#pragma unroll
    for (int q = 0; q < 4; ++q)
#pragma unroll
        for (int j = 0; j < 4; ++j) sq[q] += (v[q][j].x * v[q][j].x + v[q][j].y * v[q][j].y) + (v[q][j].z * v[q][j].z + v[q][j].w * v[q][j].w);
#pragma unroll
    for (int o = 1; o < 64; o <<= 1) { sq[0] += __shfl_xor(sq[0], o); sq[1] += __shfl_xor(sq[1], o); sq[2] += __shfl_xor(sq[2], o); sq[3] += __shfl_xor(sq[3], o); }
#pragma unroll
    for (int j = 0; j < 4; ++j) { const f32x4 gg = gr[64 * j];
#pragma unroll
        for (int q = 0; q < 4; ++q) { const float iv = 1.0f / sqrtf(sq[q] * (1.f / 1024.f) + EPS); u32x2 w;
            w.x = pk2(v[q][j].x * iv * gg.x, v[q][j].y * iv * gg.y); w.y = pk2(v[q][j].z * iv * gg.z, v[q][j].w * iv * gg.w); po[q][64 * j] = w; } }
}

struct Args { const float* in[16]; float* out; unsigned char* ws; };

__global__ void __launch_bounds__(512) fwd_megakernel(Args args) {
    extern __shared__ __attribute__((aligned(16))) unsigned char lds_raw[];
    LAS unsigned char* lds = (LAS unsigned char*)lds_raw;
    cg::grid_group grid = cg::this_grid();
    volatile LAS unsigned* xb_st = (volatile LAS unsigned*)(lds + LDS_BYTES - 16);
    if (threadIdx.x == 0) { xb_st[0] = 0u; xb_st[1] = 0u; }
    __syncthreads();
    const XcdBarrier xbar = xcd_barrier_post((unsigned*)(args.ws + WS_BAR), xb_st);
    const int tid = threadIdx.x, lane = tid & 63; const int wave = __builtin_amdgcn_readfirstlane(tid >> 6);
    const int G = gridDim.x, bx = blockIdx.x;
    const int vcu = (G % 8 == 0) ? (bx % 8) * (G / 8) + bx / 8 : bx;
    const int gw = vcu * NWAVES + wave, NGW = G * NWAVES;
    unsigned char* ws = args.ws; Ptrs P{ws};
    const float* x_prompt = args.in[0]; const float* x_sample = args.in[1]; const float* mem_prompt = args.in[2]; const float* mem_sample = args.in[3];
    const float* ln_pre = args.in[4]; const float* ln_post = args.in[5]; const float* ln_mem = args.in[6]; const float* w_in = args.in[7];
    const float* b_merge = args.in[8]; const float* q_norm = args.in[9]; const float* k_norm = args.in[10]; const float* w_pool = args.in[11];
    const float* pool_scale = args.in[12]; const float* w_mem_kv = args.in[13]; const float* w_branch = args.in[14]; const float* w_out = args.in[15];
    bf16_t* XN = (bf16_t*)(ws + WS_XN); bf16_t* ZA = (bf16_t*)(ws + WS_ZA); bf16_t* ZB = (bf16_t*)(ws + WS_ZB); bf16_t* ZC = (bf16_t*)(ws + WS_ZC);
    bf16_t* ZD = (bf16_t*)(ws + WS_ZD); bf16_t* MIX = (bf16_t*)(ws + WS_MIX); bf16_t* MEMN = (bf16_t*)(ws + WS_MEMN); bf16_t* MKV = (bf16_t*)(ws + WS_MKV);
    float* SS = (float*)(ws + WS_SS);

    {
        LAS float* scr = (LAS float*)(lds + wave * 16384);
        constexpr int I_IN = 16 * 184, I_SQ = 16 * 32, I_BR = 8 * 32;
        constexpr int NITEMS = I_IN + 2 * I_SQ + 3 * I_BR;
        for (int it = gw; it < NITEMS; it += NGW) {
            int r = it;
            if (r < I_IN) { transpose_item(w_in + 512, IN_DIM, 184, (bf16_t*)(ws + WS_WIN) + (size_t)512 * 1024, scr, r, lane); continue; } r -= I_IN;
            if (r < I_SQ) { transpose_item(w_mem_kv, 1024, 32, (bf16_t*)(ws + WS_WMKV), scr, r, lane); continue; } r -= I_SQ;
            if (r < I_SQ) { transpose_item(w_out, 1024, 32, (bf16_t*)(ws + WS_WOUT), scr, r, lane); continue; } r -= I_SQ;
            if (r < 3 * I_BR) { const int n = r / I_BR; r -= n * I_BR;
                transpose_item(w_branch + (size_t)n * 512 * 1024, 1024, 32, (bf16_t*)(ws + (n < 2 ? WS_WB01 : WS_WB2P)) + (n == 1 ? 512 : 0), scr, r, lane); continue; }
        }
        for (int it = gw; it < 128 * 4 * 2; it += NGW) {
            const int kb = it >> 3, g = (it >> 1) & 3, dh = it & 1, d = dh * 64 + lane;
            const float* wi = w_in + (size_t)(kb * 8) * IN_DIM + g * 128; const float* wp = w_pool + (size_t)g * 128 * 128 + d;
            float a8[8] = {0.f, 0.f, 0.f, 0.f, 0.f, 0.f, 0.f, 0.f};
#pragma unroll 4
            for (int c = 0; c < 128; ++c) { const float b = wp[(size_t)c * 128];
#pragma unroll
                for (int kk = 0; kk < 8; ++kk) a8[kk] += wi[(size_t)kk * IN_DIM + c] * b; }
            u32x4 o; o.x = pk2(a8[0], a8[1]); o.y = pk2(a8[2], a8[3]); o.z = pk2(a8[4], a8[5]); o.w = pk2(a8[6], a8[7]);
            *(u32x4*)((bf16_t*)(ws + WS_WIN) + (size_t)(g * 128 + d) * 1024 + kb * 8) = o;
        }
        for (int m = gw; m < T; m += 4 * NGW) {
            const float* xr[4]; int mr[4];
#pragma unroll
            for (int q = 0; q < 4; ++q) { const int mq = m + q * NGW; mr[q] = (mq < T) ? mq : m; xr[q] = (mr[q] < T_P) ? x_prompt + (size_t)mr[q] * DM : x_sample + (size_t)(mr[q] - T_P) * DM; }
            rms_row4_to_bf16(xr[0], xr[1], xr[2], xr[3], ln_pre, XN + (size_t)mr[0] * DM, XN + (size_t)mr[1] * DM, XN + (size_t)mr[2] * DM, XN + (size_t)mr[3] * DM, lane);
        }
        for (int m = gw; m < MEMROWS; m += NGW) { const float* xr = (m < 2 * NMEM) ? mem_prompt + (size_t)m * DM : mem_sample + (size_t)(m - 2 * NMEM) * DM; rms_row_to_bf16(xr, ln_mem, MEMN + (size_t)m * DM, lane); }
        for (int i = bx * 512 + tid; i < T; i += G * 512) SS[i] = 0.f;
        if (bx == 0 && tid < 320) ((unsigned*)(ws + WS_CNT))[tid] = 0u;
    }
    grid.sync();

    { SchedP1 S{P, G, bx}; EpiStore E{pool_scale}; pg8::gemm_phase(lds, S, E); }
#if DUP_MASK & 1
    __syncthreads();
    { SchedP1 S{P, G, bx}; EpiStore E{pool_scale}; pg8::gemm_phase(lds, S, E); }
#endif
    xcd_barrier(xbar);

    {
        for (int base = gw * 8; base < T * 10; base += NGW * 8 * 8) {
            u32x4 raw4[8];
#pragma unroll
            for (int uu = 0; uu < 8; ++uu) { const int it = base + uu * NGW * 8 + (lane >> 3);
                if (it < T * 10) { const int tok = it / 10, hh = it - tok * 10, sub = lane & 7;
                    const bf16_t* ptr = (hh < 8) ? ZB + (size_t)tok * 1024 + hh * 64 + sub * 8 : ZD + (size_t)tok * 256 + (hh - 8) * 64 + sub * 8;
                    raw4[uu] = *(const u32x4*)ptr; } else raw4[uu] = (u32x4){0u, 0u, 0u, 0u}; }
#pragma unroll
            for (int uu = 0; uu < 8; ++uu) {
                const int it = base + uu * NGW * 8 + (lane >> 3);
                const bool ok = it < T * 10;
                const int tok = it / 10, hh = it - tok * 10, sub = lane & 7;
                bf16_t* ptr = (hh < 8) ? ZB + (size_t)tok * 1024 + hh * 64 + sub * 8 : ZD + (size_t)tok * 256 + (hh - 8) * 64 + sub * 8;
                const u32x4 raw = raw4[uu];
                float v[8] = {bflo(raw.x), bfhi(raw.x), bflo(raw.y), bfhi(raw.y), bflo(raw.z), bfhi(raw.z), bflo(raw.w), bfhi(raw.w)};
                float ssq = 0.f;
#pragma unroll
                for (int j = 0; j < 8; ++j) ssq += v[j] * v[j];
                ssq += __shfl_xor(ssq, 1); ssq += __shfl_xor(ssq, 2); ssq += __shfl_xor(ssq, 4);
                const float rinv = 1.0f / sqrtf(ssq * (1.f / 64.f) + EPS);
                const float* gn = ((hh < 8) ? q_norm : k_norm) + sub * 8;
                const int tl = (tok < T_P) ? (tok & (L_P - 1)) : ((tok - T_P) & (L_S - 1));
                const float pos = (sub < 4) ? (float)(tl >> 6) : (float)(tl & 63);
                const float osc = (hh < 8) ? C2_SELF : 1.0f;
                float o[8];
#pragma unroll
                for (int jj = 0; jj < 4; ++jj) {
                    const int fi = (sub & 3) * 4 + jj;
                    const float inv = __builtin_amdgcn_exp2f(-(float)(2 * fi) * (13.287712379549449f / 32.0f));
                    const float rev = pos * inv * 0.15915494309189535f;
                    const float cs = __builtin_amdgcn_cosf(rev), sn = __builtin_amdgcn_sinf(rev);
                    const float y0 = v[2 * jj] * rinv * gn[2 * jj], y1 = v[2 * jj + 1] * rinv * gn[2 * jj + 1];
                    o[2 * jj] = (y0 * cs - y1 * sn) * osc; o[2 * jj + 1] = (y0 * sn + y1 * cs) * osc;
                }
                u32x4 w; w.x = pk2(o[0], o[1]); w.y = pk2(o[2], o[3]); w.z = pk2(o[4], o[5]); w.w = pk2(o[6], o[7]);
                if (ok) *(u32x4*)ptr = w;
            }
        }
        for (int it = gw; it < 4 * (T / 32); it += NGW) {
            const int g = it & 3, tok0 = ((it >> 2) * 4 + (lane >> 4)) * 8, col = g * 128 + (lane & 15) * 8;
            const int Lq = (tok0 < T_P) ? L_P : L_S; const int tl0 = (tok0 < T_P) ? (tok0 & (L_P - 1)) : ((tok0 - T_P) & (L_S - 1));
            const bf16_t* bp = ZA + (size_t)tok0 * 1024 + col;
            const f32x4 p0 = *(const f32x4*)(pool_scale + col), p1 = *(const f32x4*)(pool_scale + col + 4);
            u32x4 gt[4];
#pragma unroll
            for (int i = 0; i < 4; ++i) gt[i] = *(const u32x4*)(bp + (size_t)i * 1024 + 512);
#define UNP(V_, F_) { F_[0] = bflo((V_).x); F_[1] = bfhi((V_).x); F_[2] = bflo((V_).y); F_[3] = bfhi((V_).y); F_[4] = bflo((V_).z); F_[5] = bfhi((V_).z); F_[6] = bflo((V_).w); F_[7] = bfhi((V_).w); }
#define MK(j_) (((unsigned)(tl0 - W_ / 2 + (j_)) < (unsigned)Lq) ? 1.f : 0.f)
#define POOL_RUN(WW) { constexpr int W_ = WW; constexpr int NR = 8 + W_ - 1; u32x4 rw[NR]; \
                _Pragma("unroll") for (int j = 0; j < NR; ++j) { const bool ok = (unsigned)(tl0 - W_ / 2 + j) < (unsigned)Lq; rw[j] = *(const u32x4*)(bp + (ok ? (j - W_ / 2) : 0) * 1024); } \
                float sm[8] = {0.f, 0.f, 0.f, 0.f, 0.f, 0.f, 0.f, 0.f}; float cnt = 0.f; \
                _Pragma("unroll") for (int j = 0; j < W_; ++j) { float f[8]; UNP(rw[j], f); const float mk = MK(j); cnt += mk; _Pragma("unroll") for (int e = 0; e < 8; ++e) sm[e] += mk * f[e]; } \
                _Pragma("unroll") for (int i = 0; i < 8; ++i) { \
                    const float ic = 1.0f / cnt; float c[8], gg[8]; UNP(rw[i + W_ / 2], c); UNP(gt[i & 3], gg); \
                    if (i == 3) { _Pragma("unroll") for (int q = 0; q < 4; ++q) gt[q] = *(const u32x4*)(bp + (size_t)(4 + q) * 1024 + 512); } \
                    u32x4 wv; wv.x = pk2((sm[0] * ic - c[0]) * p0.x * gg[0], (sm[1] * ic - c[1]) * p0.y * gg[1]); \
                    wv.y = pk2((sm[2] * ic - c[2]) * p0.z * gg[2], (sm[3] * ic - c[3]) * p0.w * gg[3]); \
                    wv.z = pk2((sm[4] * ic - c[4]) * p1.x * gg[4], (sm[5] * ic - c[5]) * p1.y * gg[5]); \
                    wv.w = pk2((sm[6] * ic - c[6]) * p1.z * gg[6], (sm[7] * ic - c[7]) * p1.w * gg[7]); \
                    *(u32x4*)(MIX + (size_t)(tok0 + i) * 1024 + col) = wv; \
                    if (i < 7) { float fa[8], fs[8]; UNP(rw[i + W_], fa); UNP(rw[i], fs); const float ma = MK(i + W_), ms = MK(i); cnt += ma - ms; \
                        _Pragma("unroll") for (int e = 0; e < 8; ++e) sm[e] += ma * fa[e] - ms * fs[e]; } } }
            if (g == 0) POOL_RUN(2) else if (g == 1) POOL_RUN(4) else if (g == 2) POOL_RUN(8) else POOL_RUN(16)
#undef POOL_RUN
#undef MK
#undef UNP
        }
        cross_attn_phase(ZC, MKV, lds, vcu, G);
    }
    xcd_barrier(xbar);

    {
        for (int L = vcu; L < 2560; L += G) {
            int row0, Lq, kvh, hq, qb;
            if (L < 2048) { const int grp = L >> 6, ui = L & 63; const int seq = grp >> 1; kvh = grp & 1; hq = ui >> 4; qb = ui & 15; row0 = T_P + seq * L_S; Lq = L_S; }
            else { const int p = L - 2048, grp = p >> 7, ui = p & 127; const int seq = grp >> 1; kvh = grp & 1; hq = ui >> 5; qb = ui & 31; row0 = seq * L_P; Lq = L_P; }
            const int h = kvh * 4 + hq;
            bf16_t* Qp = ZB + (size_t)(row0 + qb * 256) * 1024 + h * 64;
            const bf16_t* Kp = ZD + (size_t)row0 * 256 + kvh * 64;
#if DUP_MASK & 2
            attn_body::attn_unit<8>((const attn_body::bf16*)Qp, (const attn_body::bf16*)Kp, (const attn_body::bf16*)(Kp + 128), Lq / 64, (const attn_body::bf16*)(Qp + 512), (attn_body::bf16*)(ws + WS_SCR + (size_t)bx * SCR_PER_BLOCK), (char*)lds_raw);
#endif
            attn_body::attn_unit<8>((const attn_body::bf16*)Qp, (const attn_body::bf16*)Kp, (const attn_body::bf16*)(Kp + 128), Lq / 64, (const attn_body::bf16*)(Qp + 512), (attn_body::bf16*)Qp, (char*)lds_raw);
        }
    }
    xcd_barrier(xbar);

    { SchedMerge S{P, G, bx}; EpiGate E{b_merge, (char*)ws + WS_SCR + (size_t)bx * SCR_PER_BLOCK}; pg8::gemm_phase(lds, S, E); }
#if DUP_MASK & 4
    __syncthreads();
    { SchedMerge S{P, G, bx}; EpiGate E{b_merge, (char*)ws + WS_SCR + (size_t)bx * SCR_PER_BLOCK}; pg8::gemm_phase(lds, S, E); }
#endif
    xcd_barrier(xbar);

    { SchedOut S{P, G, bx}; EpiOut E{SS, (unsigned*)(ws + WS_CNT), x_prompt, x_sample, ln_post, args.out}; pg8::gemm_phase(lds, S, E); }
}

extern "C" void kernel_launch(void* const* d_in, const int* in_sizes, int n_in, void* d_out, int out_size, void* d_ws, size_t ws_size, hipStream_t stream) {
    static int grid_blocks = 0;
    if (grid_blocks == 0) {
        if (n_in != 16 || out_size != T * DM || ws_size < WS_END) { fprintf(stderr, "kernel_launch: unexpected shapes (n_in %d out %d ws %zu need %zu)\n", n_in, out_size, ws_size, (size_t)WS_END); grid_blocks = -1; return; }
        int dev = 0, cus = 0, per_cu = 0;
        hipGetDevice(&dev);
        hipDeviceGetAttribute(&cus, hipDeviceAttributeMultiprocessorCount, dev);
        if (hipFuncSetAttribute((const void*)fwd_megakernel, hipFuncAttributeMaxDynamicSharedMemorySize, LDS_BYTES) != hipSuccess) { fprintf(stderr, "kernel_launch: hipFuncSetAttribute failed\n"); grid_blocks = -1; return; }
        if (hipOccupancyMaxActiveBlocksPerMultiprocessor(&per_cu, (const void*)fwd_megakernel, 512, LDS_BYTES) != hipSuccess || per_cu < 1) { fprintf(stderr, "kernel_launch: occupancy query failed (%d)\n", per_cu); (void)hipGetLastError(); per_cu = 1; }
        grid_blocks = cus * 1;
        if (grid_blocks > 256) grid_blocks = 256;
    }
    if (grid_blocks < 0) return;
    if (hipMemsetAsync((char*)d_ws + WS_BAR, 0, XCD_BAR_WORDS * 4, stream) != hipSuccess) { fprintf(stderr, "kernel_launch: hipMemsetAsync failed\n"); return; }
    Args a{};
    for (int i = 0; i < 16; ++i) a.in[i] = (const float*)d_in[i];
    a.out = (float*)d_out; a.ws = (unsigned char*)d_ws;
    void* kargs[] = {&a};
    hipError_t e = hipLaunchCooperativeKernel((const void*)fwd_megakernel, dim3(grid_blocks), dim3(512), kargs, LDS_BYTES, stream);
    if (e != hipSuccess) fprintf(stderr, "cooperative launch failed: %s (grid %d)\n", hipGetErrorString(e), grid_blocks);
}
```

```cpp
#include <hip/hip_runtime.h>
#include <hip/hip_cooperative_groups.h>
#include <cstdio>
#include <cstdint>
#include <cmath>
#include <hip/hip_bf16.h>
namespace cg = cooperative_groups;
#ifndef DUP_MASK
#define DUP_MASK 0
#endif

#define LAS __attribute__((address_space(3)))
typedef unsigned short bf16_t;
typedef short bf16x8 __attribute__((ext_vector_type(8)));
typedef short s16x4 __attribute__((ext_vector_type(4)));
typedef float f32x4 __attribute__((ext_vector_type(4)));
typedef float f32x16 __attribute__((ext_vector_type(16)));
typedef unsigned u32x4 __attribute__((ext_vector_type(4)));
typedef unsigned u32x2 __attribute__((ext_vector_type(2)));
typedef float f32x2_t __attribute__((ext_vector_type(2)));
typedef __bf16 bf16x2_t __attribute__((ext_vector_type(2)));

constexpr int DM = 1024;
constexpr int T_P = 2 * 8192, T_S = 16 * 4096, T = T_P + T_S;
constexpr int L_P = 8192, L_S = 4096;
constexpr int NMEM = 256, MEMROWS = 18 * NMEM;
constexpr int IN_DIM = 6400, ZW = 3328;
constexpr float EPS = 1e-6f;
constexpr float LOG2E = 1.4426950408889634f;
constexpr float C2_SELF = 0.125f * LOG2E;
constexpr float C2_CROSS = 0.08838834764831845f * LOG2E;

constexpr size_t MiB = 1u << 20;
constexpr size_t TB = (size_t)T * 1024 * 2;
constexpr size_t WS_SS = 0;
constexpr size_t WS_CNT = 512 * 1024;
constexpr size_t WS_BAR = 768 * 1024;
constexpr size_t WS_WIN = 1 * MiB;
constexpr size_t WS_WMKV = 14 * MiB, WS_WOUT = 16 * MiB, WS_WB01 = 18 * MiB, WS_WB2P = 20 * MiB;
constexpr size_t WS_MEMN = 22 * MiB, WS_MKV = 31 * MiB;
constexpr size_t WS_XN = 40 * MiB;
constexpr size_t WS_ZA = WS_XN + TB, WS_ZB = WS_ZA + TB, WS_ZC = WS_ZB + TB;
constexpr size_t WS_ZD = WS_ZC + TB;
constexpr size_t WS_MIX = WS_ZD + (size_t)T * 256 * 2;
constexpr size_t WS_SCR = WS_MIX + TB;
constexpr size_t SCR_PER_BLOCK = 256 * 1024;
constexpr size_t WS_END = WS_SCR + 256 * SCR_PER_BLOCK;
static_assert(WS_END <= 1024 * MiB, "workspace map");

constexpr int LDS_BYTES = 139264;
constexpr int NWAVES = 8;

__device__ __forceinline__ unsigned f2bf(float f) { unsigned u = __builtin_bit_cast(unsigned, f); return (u + 0x7fffu + ((u >> 16) & 1u)) >> 16; }
__device__ __forceinline__ unsigned pk2(float lo, float hi) { f32x2_t v = {lo, hi}; bf16x2_t b = __builtin_convertvector(v, bf16x2_t); return __builtin_bit_cast(unsigned, b); }
__device__ __forceinline__ float bflo(unsigned w) { return __builtin_bit_cast(float, w << 16); }
__device__ __forceinline__ float bfhi(unsigned w) { return __builtin_bit_cast(float, w & 0xffff0000u); }
__device__ __forceinline__ float fast_rcp(float x) { return __builtin_amdgcn_rcpf(x); }
__device__ __forceinline__ float sigmoidf_(float x) { return fast_rcp(1.0f + __builtin_amdgcn_exp2f(-x * LOG2E)); }
__device__ __forceinline__ float siluf_(float x) { return x * sigmoidf_(x); }
__device__ __forceinline__ float wave_sum(float v) {
#pragma unroll
    for (int o = 1; o < 64; o <<= 1) v += __shfl_xor(v, o);
    return v;
}
__device__ __forceinline__ int crow(int r, int hi) { return (r & 3) + 8 * (r >> 2) + 4 * hi; }

namespace pg8 {
constexpr int BM = 256, BK = 64, HALF = 128, HTB = HALF * BK * 2, STAGE_BYTES = 8 * HTB, NXCD = 8, WGM = 8;
constexpr int KP = 1024;
__device__ __forceinline__ int lds_byte(int r, int c) { const int st = (r >> 4) * 2 + (c >> 5), rr = r & 15, cc = c & 31, ob = rr * 64 + cc * 2; return st * 1024 + (ob ^ (((ob >> 9) & 1) << 5)); }
__device__ __forceinline__ void stage_rc(int b, int& R, int& C) { const int st = b / 1024, sb = b % 1024, swz = sb ^ (((sb >> 9) & 1) << 5); R = (st >> 1) * 16 + swz / 64; C = (st & 1) * 32 + (swz % 64) / 2; }
__device__ __forceinline__ int perm32(int rho) { const int n = rho >> 4, i = rho & 15; return 8 * (i >> 2) + 4 * n + (i & 3); }

struct Unit { const char* A; const char* B; int nt; int kind; int r0; int c0; int aux; char* O; int ldc; float sc; };

__device__ __forceinline__ void tile_order(int L, int nM, int nN, int& pm, int& pn) {
    const int nwg = nM * nN; int wgid = L;
    { const int q = nwg / NXCD, r = nwg % NXCD, xcd = wgid % NXCD, off = wgid / NXCD; wgid = (xcd < r ? xcd * (q + 1) : r * (q + 1) + (xcd - r) * q) + off; }
    const int nig = WGM * nN, gid = wgid / nig, fm = gid * WGM, gsz = (nM - fm) < WGM ? (nM - fm) : WGM;
    pm = fm + ((wgid % nig) % gsz); pn = (wgid % nig) / gsz;
}

template <class Epi, class Sched>
__device__ __forceinline__ void gemm_phase(LAS unsigned char* lds, const Sched& S, const Epi& E) {
    constexpr bool ALIGN_EPI = true;
    int tid = threadIdx.x; asm volatile("" : "+v"(tid));
    const int wid = __builtin_amdgcn_readfirstlane(tid >> 6), lane = tid & 63, wr = wid >> 2, wc = wid & 3, fr = lane & 15, fq = lane >> 4;
    const int K = KP;
    unsigned voffA[2], voffB[2];
#pragma unroll
    for (int i = 0; i < 2; ++i) { int R, C; stage_rc(tid * 16 + i * 8192, R, C); const int Rb = (R & ~31) + perm32(R & 31);
        voffA[i] = (unsigned)(R * K + C) * 2u; voffB[i] = (unsigned)(Rb * K + C) * 2u; }
    const size_t kstep = (size_t)(BK * 2);
    const size_t hstep = (size_t)HALF * K * 2;
    const unsigned ldsw = (unsigned)wid * 1024u;
    const int aoff = lds_byte(wr * 64 + fr, fq * 8), boff = lds_byte(wc * 32 + fr, fq * 8);
#define PG8_SA(b, h) (((b) * 2 + (h)) * HTB)
#define PG8_SB(b, h) ((4 + (b) * 2 + (h)) * HTB)
#define PG8_STAGE(bufoff, gbase, voff) do { _Pragma("unroll") for (int _i = 0; _i < 2; ++_i) \
        __builtin_amdgcn_global_load_lds((const unsigned*)((const char*)(gbase) + (voff)[_i]), (LAS unsigned*)(lds + (bufoff) + ldsw + _i * 8192), 16, 0, 0); } while (0)
#define PG8_LDA(dst, b, h) do { _Pragma("unroll") for (int m = 0; m < 4; ++m) _Pragma("unroll") for (int k = 0; k < 2; ++k) dst[m][k] = *(const LAS bf16x8*)(lds + PG8_SA(b, h) + aoff + m * 2048 + k * 1024); } while (0)
#define PG8_LDB(dst, b, h) do { _Pragma("unroll") for (int n = 0; n < 2; ++n) _Pragma("unroll") for (int k = 0; k < 2; ++k) dst[n][k] = *(const LAS bf16x8*)(lds + PG8_SB(b, h) + boff + n * 2048 + k * 1024); } while (0)
#define PG8_MMA(ai, bj, At, Bt) do { __builtin_amdgcn_s_setprio(1); _Pragma("unroll") for (int m = 0; m < 4; ++m) _Pragma("unroll") for (int n = 0; n < 2; ++n) _Pragma("unroll") for (int k = 0; k < 2; ++k) \
        acc[ai][bj][m][n] = __builtin_amdgcn_mfma_f32_16x16x32_bf16(Bt[n][k], At[m][k], acc[ai][bj][m][n], 0, 0, 0); __builtin_amdgcn_s_setprio(0); } while (0)
#define PG8_WAIT_V(n) asm volatile("s_waitcnt vmcnt(" #n ")" ::: "memory")
#define PG8_WAIT_L(n) asm volatile("s_waitcnt lgkmcnt(" #n ")" ::: "memory")
#define PG8_BAR __builtin_amdgcn_s_barrier()
#define PG8_SCHED __builtin_amdgcn_sched_barrier(0)
    Unit cur, nxt; int ui = 0;
    if (!S.next(0, cur)) return;
    f32x4 acc[2][2][4][2];
#pragma unroll
    for (int a = 0; a < 2; ++a)
#pragma unroll
        for (int b = 0; b < 2; ++b)
#pragma unroll
            for (int m = 0; m < 4; ++m)
#pragma unroll
                for (int n = 0; n < 2; ++n) acc[a][b][m][n] = (f32x4){0.f, 0.f, 0.f, 0.f};
    bf16x8 At[4][2], B0[2][2], B1[2][2];
    const char* cA = cur.A; const char* cB = cur.B;
    PG8_STAGE(PG8_SB(0, 0), cB, voffB); PG8_STAGE(PG8_SB(0, 1), cB + hstep, voffB); PG8_STAGE(PG8_SA(0, 0), cA, voffA); PG8_STAGE(PG8_SA(0, 1), cA + hstep, voffA);
    if (wr == 1) PG8_BAR;
    PG8_WAIT_V(2); PG8_BAR;
    PG8_STAGE(PG8_SB(1, 0), cB + kstep, voffB); PG8_STAGE(PG8_SA(1, 0), cA + kstep, voffA); PG8_STAGE(PG8_SB(1, 1), cB + hstep + kstep, voffB);
    PG8_WAIT_V(6); PG8_BAR;
    for (;;) {
        const bool has_next = S.next(ui + 1, nxt);
        const char* nA = has_next ? nxt.A : cA; const char* nB = has_next ? nxt.B : cB;
        const int nt = cur.nt;
        for (int t = 0; t < nt; t += 2) {
            const bool last = (t == nt - 2);
            const char* a1 = cA + (size_t)(t + 1) * kstep;
            const char* a2 = last ? nA : cA + (size_t)(t + 2) * kstep; const char* b2 = last ? nB : cB + (size_t)(t + 2) * kstep;
            const char* a3 = a2 + kstep; const char* b3 = b2 + kstep;
            PG8_LDB(B0, 0, 0); PG8_LDB(B1, 0, 1); PG8_SCHED; PG8_LDA(At, 0, 0); PG8_STAGE(PG8_SA(1, 1), a1 + hstep, voffA);
            PG8_WAIT_V(8); PG8_WAIT_L(0); PG8_BAR; PG8_MMA(0, 0, At, B0); PG8_MMA(0, 1, At, B1); PG8_BAR; PG8_SCHED;
            PG8_LDA(At, 0, 1); PG8_STAGE(PG8_SB(0, 0), b2, voffB); PG8_STAGE(PG8_SB(0, 1), b2 + hstep, voffB); PG8_STAGE(PG8_SA(0, 0), a2, voffA);
            PG8_WAIT_V(8); PG8_WAIT_L(0); PG8_BAR; PG8_MMA(1, 0, At, B0); PG8_MMA(1, 1, At, B1); PG8_BAR; PG8_SCHED;
            PG8_LDB(B0, 1, 0); PG8_LDB(B1, 1, 1); PG8_SCHED; PG8_LDA(At, 1, 0); PG8_STAGE(PG8_SA(0, 1), a2 + hstep, voffA);
            PG8_WAIT_V(8); PG8_WAIT_L(0); PG8_BAR; PG8_MMA(0, 0, At, B0); PG8_MMA(0, 1, At, B1); PG8_BAR; PG8_SCHED;
            PG8_LDA(At, 1, 1); PG8_STAGE(PG8_SB(1, 0), b3, voffB); PG8_STAGE(PG8_SB(1, 1), b3 + hstep, voffB); PG8_STAGE(PG8_SA(1, 0), a3, voffA);
            PG8_WAIT_V(8); PG8_WAIT_L(0); PG8_BAR; PG8_MMA(1, 0, At, B0); PG8_MMA(1, 1, At, B1); PG8_BAR; PG8_SCHED;
        }
        if constexpr (ALIGN_EPI) { if (wr == 0) PG8_BAR; }
        E(acc, cur, wr, wc, fr, fq);
        if (!has_next) break;
#pragma unroll
        for (int a = 0; a < 2; ++a)
#pragma unroll
            for (int b = 0; b < 2; ++b)
#pragma unroll
                for (int m = 0; m < 4; ++m)
#pragma unroll
                    for (int n = 0; n < 2; ++n) acc[a][b][m][n] = (f32x4){0.f, 0.f, 0.f, 0.f};
        cur = nxt; cA = nA; cB = nB; ++ui;
        if constexpr (ALIGN_EPI) { if (wr == 1) PG8_BAR; }
    }
    PG8_WAIT_V(0);
    if constexpr (!ALIGN_EPI) { if (wr == 0) PG8_BAR; }
    PG8_BAR;
#undef PG8_SA
#undef PG8_SB
#undef PG8_STAGE
#undef PG8_LDA
#undef PG8_LDB
#undef PG8_MMA
#undef PG8_WAIT_V
#undef PG8_WAIT_L
#undef PG8_BAR
#undef PG8_SCHED
}
}

namespace attn_body {
using bf16=__hip_bfloat16;
using bf16x8=__attribute__((ext_vector_type(8)))short;
using s16x4=__attribute__((ext_vector_type(4)))short;
using f32x16=__attribute__((ext_vector_type(16)))float;
using u32x4=__attribute__((ext_vector_type(4)))unsigned;
constexpr int D=64,QP=1024,KVP=256;
constexpr int NW=8,QBLK=32,QB=QBLK*NW,KVBLK=64;
__device__ __forceinline__ int crow(int r,int hi){return (r&3)+8*(r>>2)+4*hi;}
#define SBAR() __builtin_amdgcn_sched_barrier(0)
__device__ __forceinline__ void cmask(f32x16&p0,f32x16&p1,int jb,int qrel,int hi){
  const float NEG=-INFINITY; int kb=64*jb+4*hi;
  #pragma unroll
  for(int r=0;r<16;++r){int kv=kb+(r&3)+8*(r>>2); if(kv>qrel)p0[r]=NEG; if(kv+32>qrel)p1[r]=NEG;}
}

constexpr int NSLOT=3, SLOTB=8192;
constexpr int LDS_K=0, LDS_V=NSLOT*SLOTB, LDS_WS=2*NSLOT*SLOTB, LDS_OST=LDS_WS+NW*64*4, LDS_BYTES=LDS_OST+NW*4096;
constexpr float C2=0.125f*1.4426950408889634f;
__device__ __forceinline__ void glds16(const void*gsrc,unsigned lds_dst){unsigned keep;
  asm volatile("s_mov_b32 %0, m0\n\ts_mov_b32 m0, %2\n\ts_nop 0\n\tglobal_load_lds_dwordx4 %1, off\n\ts_mov_b32 m0, %0":"=&s"(keep):"v"(gsrc),"s"(lds_dst):"memory");}
__device__ __forceinline__ float max3f(float a,float b,float c){float r;asm("v_max3_f32 %0, %1, %2, %3":"=v"(r):"v"(a),"v"(b),"v"(c));return r;}
__device__ __forceinline__ float max2f(float a,float b){float r;asm("v_max_f32_e32 %0, %1, %2":"=v"(r):"v"(a),"v"(b));return r;}
__device__ __forceinline__ float fadd_s(float a,float b){float r;asm("v_add_f32_e32 %0, %1, %2":"=v"(r):"v"(a),"v"(b));return r;}
__device__ __forceinline__ float fsub_s(float a,float b){float r;asm("v_sub_f32_e32 %0, %1, %2":"=v"(r):"v"(a),"v"(b));return r;}
typedef float f32x2_t __attribute__((ext_vector_type(2))); typedef __bf16 bf16x2_t __attribute__((ext_vector_type(2)));
__device__ __forceinline__ unsigned cvtpk_s(float lo,float hi){f32x2_t v={lo,hi};bf16x2_t b=__builtin_convertvector(v,bf16x2_t);return __builtin_bit_cast(unsigned,b);}
#define WAIT_BAR(N) asm volatile("s_waitcnt vmcnt(" #N ") lgkmcnt(0)\n\ts_barrier":::"memory")

__device__ __forceinline__ void qkt(f32x16&p0,f32x16&p1,const char*Kslot,const bf16x8*qr,const f32x16&negm,int r32,int hi){
  const char*kb=Kslot+hi*1024+r32*16;
  #pragma unroll
  for(int d0=0;d0<4;++d0){
    const bf16x8 b0=*reinterpret_cast<const bf16x8*>(kb+d0*2048);
    const bf16x8 b1=*reinterpret_cast<const bf16x8*>(kb+d0*2048+512);
    if(d0==0){p0=__builtin_amdgcn_mfma_f32_32x32x16_bf16(b0,qr[0],negm,0,0,0);p1=__builtin_amdgcn_mfma_f32_32x32x16_bf16(b1,qr[0],negm,0,0,0);}
    else{p0=__builtin_amdgcn_mfma_f32_32x32x16_bf16(b0,qr[d0],p0,0,0,0);p1=__builtin_amdgcn_mfma_f32_32x32x16_bf16(b1,qr[d0],p1,0,0,0);}}
}
typedef __attribute__((address_space(3))) const char* lds_cptr;
typedef short v4i16_t __attribute__((ext_vector_type(4)));
__device__ __forceinline__ void kload8(bf16x8*kf,lds_cptr kp){
  kf[0]=*(const __attribute__((address_space(3))) bf16x8*)(kp);      kf[1]=*(const __attribute__((address_space(3))) bf16x8*)(kp+512);
  kf[2]=*(const __attribute__((address_space(3))) bf16x8*)(kp+2048); kf[3]=*(const __attribute__((address_space(3))) bf16x8*)(kp+2560);
  kf[4]=*(const __attribute__((address_space(3))) bf16x8*)(kp+4096); kf[5]=*(const __attribute__((address_space(3))) bf16x8*)(kp+4608);
  kf[6]=*(const __attribute__((address_space(3))) bf16x8*)(kp+6144); kf[7]=*(const __attribute__((address_space(3))) bf16x8*)(kp+6656);
}
__device__ __forceinline__ void kload2(bf16x8*kf,lds_cptr kp,int j){ kf[2*j]=*(const __attribute__((address_space(3))) bf16x8*)(kp+j*2048); kf[2*j+1]=*(const __attribute__((address_space(3))) bf16x8*)(kp+j*2048+512); }
__device__ __forceinline__ s16x4 vtr(lds_cptr p){ return __builtin_bit_cast(s16x4,__builtin_amdgcn_ds_read_tr16_b64_v4i16((__attribute__((address_space(3))) v4i16_t*)p)); }
__device__ __forceinline__ float rowmax(const f32x16&p0,const f32x16&p1){
  float a=max3f(p0[0],p0[1],p1[0]),b=max3f(p0[2],p0[3],p1[1]);a=max3f(a,p1[2],p1[3]);
  #pragma unroll
  for(int r=4;r<16;r+=4){a=max3f(a,p0[r],p0[r+1]);b=max3f(b,p0[r+2],p0[r+3]);a=max3f(a,p1[r],p1[r+1]);b=max3f(b,p1[r+2],p1[r+3]);}
  const float m=max2f(a,b);
  auto rr=__builtin_amdgcn_permlane32_swap(__float_as_uint(m),__float_as_uint(m),false,false);
  return max2f(__uint_as_float(rr[0]),__uint_as_float(rr[1]));
}
__device__ __forceinline__ void pv(f32x16*o,int vb,bf16x8 pa0,bf16x8 pa1,bf16x8 pa2,bf16x8 pa3){
  #pragma unroll
  for(int d0=0;d0<2;++d0){s16x4 lo[4],hi[4];
    #pragma unroll
    for(int ks=0;ks<4;++ks){
      asm volatile("ds_read_b64_tr_b16 %0,%1 offset:%c2":"=&v"(lo[ks]):"v"(vb),"i"(d0*4096+ks*1024):"memory");
      asm volatile("ds_read_b64_tr_b16 %0,%1 offset:%c2":"=&v"(hi[ks]):"v"(vb),"i"(d0*4096+ks*1024+512):"memory");}
    asm volatile("s_waitcnt lgkmcnt(0)":::"memory");SBAR();
    #define PK(k) (bf16x8){lo[k][0],lo[k][1],lo[k][2],lo[k][3],hi[k][0],hi[k][1],hi[k][2],hi[k][3]}
    o[d0]=__builtin_amdgcn_mfma_f32_32x32x16_bf16(pa0,PK(0),o[d0],0,0,0);
    o[d0]=__builtin_amdgcn_mfma_f32_32x32x16_bf16(pa1,PK(1),o[d0],0,0,0);
    o[d0]=__builtin_amdgcn_mfma_f32_32x32x16_bf16(pa2,PK(2),o[d0],0,0,0);
    o[d0]=__builtin_amdgcn_mfma_f32_32x32x16_bf16(pa3,PK(3),o[d0],0,0,0);
    #undef PK
  }
}

#ifndef ATTN_STORE16
#define ATTN_STORE16(p,v) (*(u32x4*)(p)=(v))
#endif
template<int THRL> __device__ __forceinline__ void attn_unit(const bf16*Qb,const bf16*__restrict__ Kh,const bf16*__restrict__ Vh,const int NT,const bf16*Gb,bf16*Ob,char*shm){
  const int tid=threadIdx.x,lane=tid&63,r32=lane&31,hi=lane>>5; const int wid=__builtin_amdgcn_readfirstlane(tid>>6);
  const bf16*Qw=Qb+(long)(wid*QBLK)*QP;
  const unsigned lds0=(unsigned)(uintptr_t)shm;
  float*wsf=(float*)(shm+LDS_WS)+wid*64;
  const bf16*ksrc=Kh+(long)lane*KVP+wid*8;
  const bf16*vsrc=Vh+(long)(16*(wid&3)+(lane>>2))*KVP+(wid>>2)*32+(lane&3)*8;
  const unsigned kdst=lds0+LDS_K+wid*1024, vdst=lds0+LDS_V+wid*1024;
  #define DMA_K(t,slot) glds16(ksrc+(long)(t)*KVBLK*KVP,(unsigned)__builtin_amdgcn_readfirstlane(kdst+(slot)))
  #define DMA_V(t,slot) glds16(vsrc+(long)(t)*KVBLK*KVP,(unsigned)__builtin_amdgcn_readfirstlane(vdst+(slot)))
  const int vb0=(int)(lds0+LDS_V)+((lane>>4)&1)*32+(lane&3)*8+(4*hi+((lane&15)>>2))*64;
  const char*Kbase=shm+LDS_K; bf16x8 kf[8];
  const lds_cptr shm3=(lds_cptr)shm; const lds_cptr kp0=shm3+LDS_K+hi*1024+r32*16; const lds_cptr vp0=shm3+LDS_V+((lane>>4)&1)*32+(lane&3)*8+(4*hi+((lane&15)>>2))*64;
  DMA_K(0,0);DMA_V(0,0);DMA_K(1,SLOTB);
  bf16x8 qr[4];
  #pragma unroll
  for(int d0=0;d0<4;++d0)qr[d0]=*reinterpret_cast<const bf16x8*>(&Qw[(long)r32*QP+d0*16+hi*8]);
  float mhat=0.f,l_reg=0.f;f32x16 o[2];o[0]=f32x16{};o[1]=f32x16{};f32x16 negm=f32x16{};asm volatile("":"+v"(negm));
  #define CMASK(P0,P1,t) do{}while(0)
  bool resc=false;
  #define START(P0,P1) do{ const float rm=rowmax(P0,P1); resc=false; \
    { const float dl=rm; mhat=fadd_s(mhat,dl); \
      _Pragma("unroll") for(int r=0;r<16;++r){P0[r]=fsub_s(P0[r],dl);P1[r]=fsub_s(P1[r],dl);} \
      _Pragma("unroll") for(int r=0;r<16;++r)negm[r]=-mhat; asm volatile("":"+v"(negm)); } \
    _Pragma("unroll") for(int r=0;r<16;++r)P0[r]=__builtin_amdgcn_exp2f(P0[r]); }while(0)
  #define RESC() do{ if(resc){ asm volatile("s_waitcnt lgkmcnt(0)":::"memory"); \
      _Pragma("unroll") for(int d_=0;d_<2;++d_) _Pragma("unroll") for(int r=0;r<16;++r)o[d_][r]*=wsf[crow(r,hi)]; } }while(0)
  f32x16 pA0,pA1,pB0,pB1;
  int sl_prev=0,sl_cur=0,sl_next=SLOTB;
  #define ROT() do{sl_prev=sl_cur;sl_cur=sl_next;sl_next=(sl_next==(NSLOT-1)*SLOTB)?0:sl_next+SLOTB;}while(0)
  DMA_K(2,2*SLOTB);
  WAIT_BAR(3);
  qkt(pA0,pA1,Kbase,qr,negm,r32,hi);asm volatile("s_nop 15\n\ts_nop 7":"+v"(pA0),"+v"(pA1));CMASK(pA0,pA1,0);
  START(pA0,pA1);
  _Pragma("unroll") for(int r=0;r<16;++r)pA1[r]=__builtin_amdgcn_exp2f(pA1[r]);
  WAIT_BAR(0);
  DMA_K(3,0);DMA_V(1,SLOTB);
  ROT();
  kload8(kf,kp0+sl_cur);
  WAIT_BAR(2);
  s16x4 vlo[8],vhi[8]; u32x4 pw0,pw1,pw2,pw3;
  #define PKW(P,B) cvtpk_s(P[B],P[B+1])
  #define PAF(k) __builtin_bit_cast(bf16x8,pw##k)
  #define VFR(i) (bf16x8){vlo[i][0],vlo[i][1],vlo[i][2],vlo[i][3],vhi[i][0],vhi[i][1],vhi[i][2],vhi[i][3]}
  #define PIN(x) asm volatile("":"+v"(x))
  #define MX3(a,b,c) __builtin_fmaxf(__builtin_fmaxf((a),(b)),(c))
  #define GAPA(MF,A0,A1,A2,A3,W0,W1,PW) do{ MF; sacc+=A0; sacc+=A1; sacc+=A2; sacc+=A3; PIN(sacc); W0; W1; PIN(PW); SBAR(); }while(0)
  #define EX(v) __builtin_amdgcn_exp2f(v)
  #define GAPB(MF,X,B) do{ MF; X[B]=EX(X[B]); X[B+1]=EX(X[B+1]); X[B+2]=EX(X[B+2]); X[B+3]=EX(X[B+3]); PIN(X); SBAR(); }while(0)
  #define VRD(i) do{ vlo[i]=vtr(vp_+(((i)>>2)*4096+((i)&3)*1024)); vhi[i]=vtr(vp_+(((i)>>2)*4096+((i)&3)*1024+512)); }while(0)
  #define KRD(G,j) do{ if(G){ kload2(kf,kp0+sl_next,j); SBAR(); } }while(0)
  #define STEP(C0,C1,P0,P1,t,GK,GV,GL) do{ SBAR(); \
    const lds_cptr vp_=vp0+sl_prev; \
    VRD(0); SBAR(); float sacc=(P0[0]+P0[1]); \
    GAPA(C0=__builtin_amdgcn_mfma_f32_32x32x16_bf16(kf[0],qr[0],negm,0,0,0), P0[2],P0[3],P0[4],P0[5],     pw0[0]=PKW(P0,0), pw0[1]=PKW(P0,2), pw0); \
    VRD(4); SBAR(); GAPA(C1=__builtin_amdgcn_mfma_f32_32x32x16_bf16(kf[1],qr[0],negm,0,0,0), P0[6],P0[7],P0[8],P0[9],     pw0[2]=PKW(P0,4), pw0[3]=PKW(P0,6), pw0); \
    VRD(1); SBAR(); GAPA(C0=__builtin_amdgcn_mfma_f32_32x32x16_bf16(kf[2],qr[1],C0,0,0,0),   P0[10],P0[11],P0[12],P0[13], pw1[0]=PKW(P0,8), pw1[1]=PKW(P0,10), pw1); \
    VRD(5); SBAR(); GAPA(C1=__builtin_amdgcn_mfma_f32_32x32x16_bf16(kf[3],qr[1],C1,0,0,0),   P0[14],P0[15],P1[0],P1[1],   pw1[2]=PKW(P0,12),pw1[3]=PKW(P0,14), pw1); \
    VRD(2); SBAR(); GAPA(C0=__builtin_amdgcn_mfma_f32_32x32x16_bf16(kf[4],qr[2],C0,0,0,0),   P1[2],P1[3],P1[4],P1[5],     pw2[0]=PKW(P1,0), pw2[1]=PKW(P1,2), pw2); \
    VRD(6); SBAR(); GAPA(C1=__builtin_amdgcn_mfma_f32_32x32x16_bf16(kf[5],qr[2],C1,0,0,0),   P1[6],P1[7],P1[8],P1[9],     pw2[2]=PKW(P1,4), pw2[3]=PKW(P1,6), pw2); \
    VRD(3); SBAR(); GAPA(C0=__builtin_amdgcn_mfma_f32_32x32x16_bf16(kf[6],qr[3],C0,0,0,0),   P1[10],P1[11],P1[12],P1[13], pw3[0]=PKW(P1,8), pw3[1]=PKW(P1,10), pw3); \
    VRD(7); SBAR(); GAPA(C1=__builtin_amdgcn_mfma_f32_32x32x16_bf16(kf[7],qr[3],C1,0,0,0),   P1[14],P1[15],0.f,0.f,       pw3[2]=PKW(P1,12),pw3[3]=PKW(P1,14), pw3); \
    l_reg+=sacc; \
    if(GK){DMA_K((t)+3,sl_cur);} if(GV){DMA_V((t)+1,sl_next);} \
    CMASK(C0,C1,t); \
    { float a=MX3(C0[0],C0[1],C1[0]),b=MX3(C0[2],C0[3],C1[1]); a=MX3(a,C1[2],C1[3]); \
      _Pragma("unroll") for(int r=4;r<16;r+=4){a=MX3(a,C0[r],C0[r+1]);b=MX3(b,C0[r+2],C0[r+3]);a=MX3(a,C1[r],C1[r+1]);b=MX3(b,C1[r+2],C1[r+3]);} \
      float rm=__builtin_fmaxf(a,b); { auto rr=__builtin_amdgcn_permlane32_swap(__float_as_uint(rm),__float_as_uint(rm),false,false); rm=__builtin_fmaxf(__uint_as_float(rr[0]),__uint_as_float(rr[1])); } \
      resc=false; \
      if(__builtin_expect(__any(rm>(float)THRL),0)){ const float dl=__builtin_fmaxf(rm,0.f); mhat+=dl; \
        _Pragma("unroll") for(int r=0;r<16;++r){C0[r]-=dl;C1[r]-=dl;} \
        _Pragma("unroll") for(int r=0;r<16;++r)negm[r]=-mhat; asm volatile("":"+v"(negm)); \
        const float f=__builtin_amdgcn_exp2f(-dl); l_reg*=f; if(hi==0)wsf[r32]=f; resc=true; } } \
    SBAR(); \
    GAPB(o[0]=__builtin_amdgcn_mfma_f32_32x32x16_bf16(PAF(0),VFR(0),o[0],0,0,0), C0,0); \
    GAPB(o[1]=__builtin_amdgcn_mfma_f32_32x32x16_bf16(PAF(0),VFR(4),o[1],0,0,0), C0,4); \
    KRD(GL,0); GAPB(o[0]=__builtin_amdgcn_mfma_f32_32x32x16_bf16(PAF(1),VFR(1),o[0],0,0,0), C0,8); \
    KRD(GL,1); GAPB(o[1]=__builtin_amdgcn_mfma_f32_32x32x16_bf16(PAF(1),VFR(5),o[1],0,0,0), C0,12); \
    KRD(GL,2); GAPB(o[0]=__builtin_amdgcn_mfma_f32_32x32x16_bf16(PAF(2),VFR(2),o[0],0,0,0), C1,0); \
    KRD(GL,3); GAPB(o[1]=__builtin_amdgcn_mfma_f32_32x32x16_bf16(PAF(2),VFR(6),o[1],0,0,0), C1,4); \
    GAPB(o[0]=__builtin_amdgcn_mfma_f32_32x32x16_bf16(PAF(3),VFR(3),o[0],0,0,0), C1,8); \
    GAPB(o[1]=__builtin_amdgcn_mfma_f32_32x32x16_bf16(PAF(3),VFR(7),o[1],0,0,0), C1,12); \
    }while(0)
  int t=1;
  #undef CMASK
  #define CMASK(P0,P1,t) do{}while(0)
  for(;t+5<NT;t+=2){
    STEP(pB0,pB1,pA0,pA1,t,true,true,true);     WAIT_BAR(2); RESC(); ROT();
    STEP(pA0,pA1,pB0,pB1,t+1,true,true,true);   WAIT_BAR(2); RESC(); ROT();
  }
  #undef CMASK
  #define CMASK(P0,P1,t) do{}while(0)
  #define ENDW(tt) do{ if((tt)+3<NT){WAIT_BAR(2);} else if((tt)+2<NT){WAIT_BAR(1);} else {WAIT_BAR(0);} }while(0)
  for(;t+1<NT;t+=2){
    STEP(pB0,pB1,pA0,pA1,t,(t+3<NT),(t+1<NT),(t+1<NT));       ENDW(t);   RESC(); ROT();
    STEP(pA0,pA1,pB0,pB1,t+1,(t+4<NT),(t+2<NT),(t+2<NT));     ENDW(t+1); RESC(); ROT();
  }
  STEP(pB0,pB1,pA0,pA1,NT-1,false,false,false); RESC();
  { float sacc=pB0[0]+pB0[1]; _Pragma("unroll") for(int r=2;r<16;++r)sacc+=pB0[r]; _Pragma("unroll") for(int r=0;r<16;++r)sacc+=pB1[r]; l_reg+=sacc;
    pw0=(u32x4){PKW(pB0,0),PKW(pB0,2),PKW(pB0,4),PKW(pB0,6)};pw1=(u32x4){PKW(pB0,8),PKW(pB0,10),PKW(pB0,12),PKW(pB0,14)};pw2=(u32x4){PKW(pB1,0),PKW(pB1,2),PKW(pB1,4),PKW(pB1,6)};pw3=(u32x4){PKW(pB1,8),PKW(pB1,10),PKW(pB1,12),PKW(pB1,14)};
    SBAR(); pv(o,vb0+sl_cur,PAF(0),PAF(1),PAF(2),PAF(3)); }
  #undef PKW
  #undef PAF
  #undef VFR
  #undef PIN
  #undef MX3
  #undef GAPA
  #undef GAPB
  #undef EX
  #undef VRD
  #undef KRD
  #undef STEP
  #undef ENDW
  u32x4 gpre[4];
  { const bf16*Gw0=Gb+(long)(wid*QBLK)*QP;
    #pragma unroll
    for(int i=0;i<4;++i)gpre[i]=*(const u32x4*)(Gw0+(long)(i*8+(lane>>3))*QP+(lane&7)*8); }
  {auto rr=__builtin_amdgcn_permlane32_swap(__float_as_uint(l_reg),__float_as_uint(l_reg),false,false);l_reg=__uint_as_float(rr[0])+__uint_as_float(rr[1]);}
  if(hi==0)wsf[32+r32]=l_reg;asm volatile("s_waitcnt lgkmcnt(0)":::"memory");
  float rli[16];
  #pragma unroll
  for(int r=0;r<16;++r)rli[r]=__builtin_amdgcn_rcpf(wsf[32+crow(r,hi)]);
  bf16*Ow=Ob+(long)(wid*QBLK)*QP; const bf16*Gw=Gb+(long)(wid*QBLK)*QP;
  { bf16*stg=(bf16*)(shm+LDS_OST)+wid*2048;
    #pragma unroll
    for(int r=0;r<16;++r){const int orow=crow(r,hi);
      #pragma unroll
      for(int d0=0;d0<2;++d0)stg[orow*64+d0*32+r32]=__float2bfloat16(o[d0][r]*rli[r]);}
    asm volatile("s_waitcnt lgkmcnt(0)":::"memory");
    #pragma unroll
    for(int i=0;i<4;++i){const int row=i*8+(lane>>3),ch=lane&7; const u32x4 v=*(const u32x4*)(stg+row*64+ch*8); const u32x4 g=gpre[i]; u32x4 w;
      #define GM(a,b) cvtpk_s(__uint_as_float((a)<<16)*__uint_as_float((b)<<16),__uint_as_float((a)&0xffff0000u)*__uint_as_float((b)&0xffff0000u))
      w.x=GM(v.x,g.x);w.y=GM(v.y,g.y);w.z=GM(v.z,g.z);w.w=GM(v.w,g.w);
      #undef GM
      ATTN_STORE16(Ow+(long)row*QP+ch*8,w);} }
  asm volatile("s_waitcnt lgkmcnt(0)\n\ts_barrier":::"memory");
  #undef DMA_K
  #undef DMA_V
  #undef CMASK
  #undef START
  #undef RESC
  #undef ROT
}
constexpr int ATTN_LDS_BYTES=LDS_BYTES;
#undef SBAR
#undef WAIT_BAR
}

__device__ __forceinline__ unsigned xb_ld(unsigned* p)              { return __hip_atomic_load(p, __ATOMIC_RELAXED, __HIP_MEMORY_SCOPE_AGENT); }
__device__ __forceinline__ unsigned xb_add(unsigned* p, unsigned v) { return __hip_atomic_fetch_add(p, v, __ATOMIC_RELAXED, __HIP_MEMORY_SCOPE_AGENT); }
#define XB_TMO      128
#define XB_XCNT(j)  (256  + 64 * (j))
#define XB_XSUB(j)  (1280 + 64 * (j))
#define XB_XGEN(j)  (2304 + 64 * (j))
#define XB_TOP      3328
#define XB_TOPGEN   3392
#define XCD_BAR_WORDS 3456
#define XB_SPIN_CAP (1u << 18)

__device__ __forceinline__ unsigned xb_xcc_id() { return (unsigned)__builtin_amdgcn_s_getreg((3 << 11) | 20) & 0xFu; }
#define XB_SPIN(cond, bar) do { unsigned _sp = 0; while (cond) { __builtin_amdgcn_s_sleep(1); \
    if ((++_sp & 255u) == 0u) { if (xb_ld(&(bar)[XB_TMO])) break; if (_sp > XB_SPIN_CAP) { atomicAdd(&(bar)[XB_TMO], 1u); break; } } } } while (0)

struct XcdBarrier {
    unsigned* bar; unsigned x;
    volatile LAS unsigned* st;
};

__device__ __forceinline__ XcdBarrier xcd_barrier_post(unsigned* bar, volatile LAS unsigned* st) {
    XcdBarrier b; b.bar = bar; b.x = xb_xcc_id(); b.st = st;
    if (threadIdx.x == 0) (void)xb_add(&bar[XB_XCNT(b.x)], 1u);
    return b;
}
__device__ __forceinline__ void xcd_barrier_complete(unsigned* bar, unsigned x, unsigned& nloc, unsigned& nx) {
    const unsigned G = gridDim.x * gridDim.y * gridDim.z;
    unsigned sum, cnt, mine, sp = 0u;
    for (;;) {
        sum = 0u; cnt = 0u; mine = 0u;
#pragma unroll
        for (unsigned j = 0; j < 16; ++j) { const unsigned c = xb_ld(&bar[XB_XCNT(j)]); sum += c; cnt += (c > 0u) ? 1u : 0u; mine = (j == x) ? c : mine; }
        if (sum == G) break;
        __builtin_amdgcn_s_sleep(1);
        if ((++sp & 255u) == 0u) { if (xb_ld(&bar[XB_TMO])) break; if (sp > XB_SPIN_CAP) { atomicAdd(&bar[XB_TMO], 1u); break; } }
    }
    nloc = mine > 0u ? mine : 1u; nx = cnt > 0u ? cnt : 1u;
}

__device__ __forceinline__ void xcd_barrier(const XcdBarrier& b) {
    asm volatile("s_waitcnt vmcnt(0)" ::: "memory");
    __syncthreads();
    if (threadIdx.x == 0) {
        unsigned* bar = b.bar;
        __builtin_amdgcn_s_waitcnt(0);
        unsigned nloc = b.st[0], nx = b.st[1];
        if (nloc == 0u) { xcd_barrier_complete(bar, b.x, nloc, nx); b.st[0] = nloc; b.st[1] = nx; }
        const unsigned old = xb_add(&bar[XB_XSUB(b.x)], 1u);
        const unsigned gen = old / nloc;
        if (old + 1u == (gen + 1u) * nloc) {
            __builtin_amdgcn_fence(__ATOMIC_RELEASE, "agent");
            asm volatile("s_waitcnt vmcnt(0)" ::: "memory");
            const unsigned og = xb_add(&bar[XB_TOP], 1u);
            const unsigned tg = og / nx;
            if (og + 1u == (tg + 1u) * nx) xb_add(&bar[XB_TOPGEN], 1u);
            else XB_SPIN(xb_ld(&bar[XB_TOPGEN]) == tg, bar);
            __builtin_amdgcn_fence(__ATOMIC_ACQUIRE, "agent");
            xb_add(&bar[XB_XGEN(b.x)], 1u);
            asm volatile("s_waitcnt vmcnt(0)" ::: "memory");
        } else {
            XB_SPIN(xb_ld(&bar[XB_XGEN(b.x)]) == gen, bar);
            __builtin_amdgcn_fence(__ATOMIC_ACQUIRE, "agent");
            asm volatile("s_waitcnt vmcnt(0)" ::: "memory");
        }
    }
    __syncthreads();
}

using pg8::Unit;
typedef f32x4 AccT[2][2][4][2];

struct EpiStore {
    const float* pscale;
    __device__ __forceinline__ void operator()(const AccT& acc, const Unit& u, int wr, int wc, int fr, int fq) const {
        asm volatile("" : "+v"(fr), "+v"(fq));
        bf16_t* base = (bf16_t*)u.O; const int ldc = u.ldc, kind = u.kind; const float sc = u.sc;
#pragma unroll
        for (int ai = 0; ai < 2; ++ai)
#pragma unroll
            for (int m = 0; m < 4; ++m) {
                bf16_t* rowp = base + (size_t)(ai * 128 + wr * 64 + m * 16 + fr) * ldc + wc * 32 + 8 * fq;
#pragma unroll
                for (int bj = 0; bj < 2; ++bj) {
                    f32x4 v0 = acc[ai][bj][m][0], v1 = acc[ai][bj][m][1];
                    if (kind == 1) {
#pragma unroll
                        for (int e = 0; e < 4; ++e) { v0[e] = siluf_(v0[e]); v1[e] = siluf_(v1[e]); }
                    } else if (kind == 2) { v0 = v0 * sc; v1 = v1 * sc; }
                    u32x4 w; w.x = pk2(v0[0], v0[1]); w.y = pk2(v0[2], v0[3]); w.z = pk2(v1[0], v1[1]); w.w = pk2(v1[2], v1[3]);
                    *(u32x4*)(rowp + bj * 128) = w;
                }
            }
    }
};
struct EpiGate {
    const float* bmerge; char* scr;
    __device__ __forceinline__ void operator()(const AccT& acc, const Unit& u, int wr, int wc, int fr, int fq) const {
        asm volatile("" : "+v"(fr), "+v"(fq));
        int tid = threadIdx.x; const int n = u.aux; asm volatile("" : "+v"(tid));
        u32x4* gst = (u32x4*)scr;
        if (u.kind == 0) {
            const float* bp = bmerge + n * 1024 + u.c0 + wc * 32 + 8 * fq;
            f32x4 bb[2][2];
#pragma unroll
            for (int bj = 0; bj < 2; ++bj) { bb[bj][0] = *(const f32x4*)(bp + bj * 128); bb[bj][1] = *(const f32x4*)(bp + bj * 128 + 4); }
#pragma unroll
            for (int bj = 0; bj < 2; ++bj) {
#pragma unroll
                for (int ai = 0; ai < 2; ++ai)
#pragma unroll
                    for (int m = 0; m < 4; ++m) {
                        const f32x4 v0 = (acc[ai][bj][m][0] + bb[bj][0]) * (-LOG2E), v1 = (acc[ai][bj][m][1] + bb[bj][1]) * (-LOG2E);
                        u32x4 w; w.x = pk2(__builtin_amdgcn_exp2f(v0[0]), __builtin_amdgcn_exp2f(v0[1])); w.y = pk2(__builtin_amdgcn_exp2f(v0[2]), __builtin_amdgcn_exp2f(v0[3]));
                        w.z = pk2(__builtin_amdgcn_exp2f(v1[0]), __builtin_amdgcn_exp2f(v1[1])); w.w = pk2(__builtin_amdgcn_exp2f(v1[2]), __builtin_amdgcn_exp2f(v1[3]));
                        gst[((ai * 2 + bj) * 4 + m) * 512 + tid] = w;
                    }
                asm volatile("" ::: "memory");
            }
        } else {
            bf16_t* base = (bf16_t*)u.O;
            u32x4* mst = (u32x4*)(scr + 131072);
#pragma unroll
            for (int ai = 0; ai < 2; ++ai) {
                u32x4 g[8], pm[8];
#pragma unroll
                for (int e = 0; e < 8; ++e) { const int si = (ai * 2 + (e & 1)) * 4 + (e >> 1); g[e] = gst[si * 512 + tid]; if (n > 0) pm[e] = mst[si * 512 + tid]; }
#pragma unroll
                for (int e = 0; e < 8; ++e) {
                    const int bj = e & 1, m = e >> 1, si = (ai * 2 + bj) * 4 + m;
                    f32x4 v0 = acc[ai][bj][m][0], v1 = acc[ai][bj][m][1];
#define GSIG(x_) fast_rcp(1.0f + (x_))
                    v0[0] *= GSIG(bflo(g[e].x)); v0[1] *= GSIG(bfhi(g[e].x)); v0[2] *= GSIG(bflo(g[e].y)); v0[3] *= GSIG(bfhi(g[e].y));
                    v1[0] *= GSIG(bflo(g[e].z)); v1[1] *= GSIG(bfhi(g[e].z)); v1[2] *= GSIG(bflo(g[e].w)); v1[3] *= GSIG(bfhi(g[e].w));
#undef GSIG
                    if (n > 0) { v0[0] += bflo(pm[e].x); v0[1] += bfhi(pm[e].x); v0[2] += bflo(pm[e].y); v0[3] += bfhi(pm[e].y);
                                 v1[0] += bflo(pm[e].z); v1[1] += bfhi(pm[e].z); v1[2] += bflo(pm[e].w); v1[3] += bfhi(pm[e].w); }
                    u32x4 w; w.x = pk2(v0[0], v0[1]); w.y = pk2(v0[2], v0[3]); w.z = pk2(v1[0], v1[1]); w.w = pk2(v1[2], v1[3]);
                    if (n < 2) mst[si * 512 + tid] = w;
                    else *(u32x4*)(base + (size_t)(ai * 128 + wr * 64 + m * 16 + fr) * 1024 + wc * 32 + 8 * fq + bj * 128) = w;
                }
                asm volatile("" ::: "memory");
            }
        }
    }
};
struct EpiOut {
    float* ss; unsigned* cnt; const float* xp; const float* xs; const float* gpost; float* out;
    __device__ __forceinline__ void operator()(const AccT& acc, const Unit& u, int wr, int wc, int fr, int fq) const {
        asm volatile("" : "+v"(fr), "+v"(fq));
        const int pm = u.r0 >> 8;
        const float* xb = (u.r0 < T_P) ? xp + (size_t)u.r0 * DM : xs + (size_t)(u.r0 - T_P) * DM;
        float* ob = out + (size_t)u.r0 * DM;
        const int colb = u.c0 + wc * 32 + 8 * fq;
        f32x4 gg[2][2], xv[4][2][2];
#pragma unroll
        for (int bj = 0; bj < 2; ++bj) { gg[bj][0] = *(const f32x4*)(gpost + colb + bj * 128); gg[bj][1] = *(const f32x4*)(gpost + colb + bj * 128 + 4); }
#pragma unroll
        for (int m = 0; m < 4; ++m) { const int row = wr * 64 + m * 16 + fr;
#pragma unroll
            for (int bj = 0; bj < 2; ++bj) { const size_t off = (size_t)row * DM + colb + bj * 128; xv[m][bj][0] = *(const f32x4*)(xb + off); xv[m][bj][1] = *(const f32x4*)(xb + off + 4); } }
#pragma unroll
        for (int ai = 0; ai < 2; ++ai)
#pragma unroll
            for (int m = 0; m < 4; ++m) {
                float s = 0.f;
#pragma unroll
                for (int bj = 0; bj < 2; ++bj) {
                    const f32x4 v0 = acc[ai][bj][m][0], v1 = acc[ai][bj][m][1];
                    s += (v0[0] * v0[0] + v0[1] * v0[1]) + (v0[2] * v0[2] + v0[3] * v0[3]) + (v1[0] * v1[0] + v1[1] * v1[1]) + (v1[2] * v1[2] + v1[3] * v1[3]);
                }
                s += __shfl_xor(s, 16); s += __shfl_xor(s, 32);
                if (fq == 0) __hip_atomic_fetch_add(ss + u.r0 + ai * 128 + wr * 64 + m * 16 + fr, s, __ATOMIC_RELAXED, __HIP_MEMORY_SCOPE_AGENT);
            }
        asm volatile("s_waitcnt vmcnt(0)" ::: "memory");
        __builtin_amdgcn_s_barrier();
        if (threadIdx.x == 0) __hip_atomic_fetch_add(cnt + pm, 1u, __ATOMIC_RELAXED, __HIP_MEMORY_SCOPE_AGENT);
        { unsigned sp = 0;
          while ((unsigned)__builtin_amdgcn_readfirstlane(__hip_atomic_load(cnt + pm, __ATOMIC_RELAXED, __HIP_MEMORY_SCOPE_AGENT)) < 4u && sp < (1u << 22)) { __builtin_amdgcn_s_sleep(2); ++sp; } }
        asm volatile("" ::: "memory");
        float sv[2][4];
#pragma unroll
        for (int ai = 0; ai < 2; ++ai)
#pragma unroll
            for (int m = 0; m < 4; ++m) sv[ai][m] = __hip_atomic_load(ss + u.r0 + ai * 128 + wr * 64 + m * 16 + fr, __ATOMIC_RELAXED, __HIP_MEMORY_SCOPE_AGENT);
#pragma unroll
        for (int ai = 0; ai < 2; ++ai) {
            if (ai == 1) {
#pragma unroll
                for (int m = 0; m < 4; ++m) { const int row = 128 + wr * 64 + m * 16 + fr;
#pragma unroll
                    for (int bj = 0; bj < 2; ++bj) { const size_t off = (size_t)row * DM + colb + bj * 128; xv[m][bj][0] = *(const f32x4*)(xb + off); xv[m][bj][1] = *(const f32x4*)(xb + off + 4); } }
            }
#pragma unroll
            for (int m = 0; m < 4; ++m) { const int row = ai * 128 + wr * 64 + m * 16 + fr;
                const float rinv = 1.0f / sqrtf(sv[ai][m] * (1.f / 1024.f) + EPS);
#pragma unroll
                for (int bj = 0; bj < 2; ++bj) { const size_t off = (size_t)row * DM + colb + bj * 128;
                    *(f32x4*)(ob + off) = xv[m][bj][0] + acc[ai][bj][m][0] * rinv * gg[bj][0];
                    *(f32x4*)(ob + off + 4) = xv[m][bj][1] + acc[ai][bj][m][1] * rinv * gg[bj][1]; } }
            asm volatile("" ::: "memory");
        }
    }
};

struct Ptrs {
    unsigned char* ws;
    __device__ __forceinline__ char* at(size_t off) const { return (char*)ws + off; }
};
struct SchedP1 {
    Ptrs P; int G, c;
    __device__ __forceinline__ bool next(int i, Unit& u) const {
        const int L = i * G + c; constexpr int N1 = 320 * 13, N2 = 18 * 4;
        if (L >= N1 + N2) return false;
        u.nt = 16; u.aux = 0; u.sc = 1.f;
        if (L < N1) {
            int pm, pn; pg8::tile_order(L, 320, 13, pm, pn);
            u.A = P.at(WS_XN) + (size_t)pm * 256 * 2048; u.B = P.at(WS_WIN) + (size_t)pn * 256 * 2048; u.r0 = pm * 256;
            size_t dst; int col, ldc = 1024, kind = 0;
            if (pn < 2) { dst = WS_ZA; col = pn * 256; }
            else if (pn < 4) { dst = WS_ZA; col = 512 + (pn - 2) * 256; kind = 1; }
            else if (pn < 6) { dst = WS_ZB; col = (pn - 4) * 256; }
            else if (pn == 6) { dst = WS_ZD; col = 0; ldc = 256; }
            else if (pn < 9) { dst = WS_ZB; col = 512 + (pn - 7) * 256; kind = 1; }
            else if (pn < 11) { dst = WS_ZC; col = (pn - 9) * 256; kind = 2; u.sc = C2_CROSS; }
            else { dst = WS_ZC; col = 512 + (pn - 11) * 256; kind = 1; }
            u.kind = kind; u.ldc = ldc; u.c0 = col; u.O = P.at(dst) + ((size_t)pm * 256 * ldc + col) * 2;
        } else {
            const int l = L - N1, pm = l >> 2, pn = l & 3;
            u.A = P.at(WS_MEMN) + (size_t)pm * 256 * 2048; u.B = P.at(WS_WMKV) + (size_t)pn * 256 * 2048; u.r0 = pm * 256; u.c0 = pn * 256;
            u.kind = 0; u.ldc = 1024; u.O = P.at(WS_MKV) + ((size_t)pm * 256 * 1024 + pn * 256) * 2;
        }
        return true;
    }
};
struct SchedMerge {
    Ptrs P; int G, c;
    __device__ __forceinline__ bool next(int i, Unit& u) const {
        const int ti = i / 6, sub = i - ti * 6; const int L = ti * G + c; if (L >= 1280) return false;
        int pm, pn; pg8::tile_order(L, 320, 4, pm, pn);
        const int n = sub >> 1; u.aux = n; u.r0 = pm * 256; u.c0 = pn * 256; u.ldc = 1024; u.sc = 1.f;
        u.O = P.at(WS_ZA) + ((size_t)pm * 256 * 1024 + pn * 256) * 2;
        if ((sub & 1) == 0) { u.kind = 0; u.nt = 16; u.A = P.at(WS_XN) + (size_t)pm * 256 * 2048; u.B = P.at(WS_WIN) + (size_t)(ZW + n * 1024 + pn * 256) * 2048; }
        else { u.kind = 1; u.nt = 8;
            u.A = P.at(n == 0 ? WS_MIX : (n == 1 ? WS_ZB : WS_ZC)) + (size_t)pm * 256 * 2048;
            u.B = P.at(n < 2 ? WS_WB01 : WS_WB2P) + ((size_t)pn * 256 * 1024 + (n == 1 ? 512 : 0)) * 2; }
        return true;
    }
};
struct SchedOut {
    Ptrs P; int G, c;
    __device__ __forceinline__ bool next(int i, Unit& u) const {
        const int L = i * G + c; if (L >= 1280) return false;
        int pm, pn; pg8::tile_order(L, 320, 4, pm, pn);
        u.A = P.at(WS_ZA) + (size_t)pm * 256 * 2048; u.B = P.at(WS_WOUT) + (size_t)pn * 256 * 2048;
        u.nt = 16; u.kind = 0; u.r0 = pm * 256; u.c0 = pn * 256; u.aux = 0; u.ldc = 1024; u.sc = 1.f;
        u.O = P.at(WS_XN) + ((size_t)pm * 256 * 1024 + pn * 256) * 2;
        return true;
    }
};

__device__ __forceinline__ void cross_attn_phase(bf16_t* ZC, const bf16_t* MKV, LAS unsigned char* lds, int vcu, int G) {
    constexpr int D = 128, KPL = 136, VPL = 260;
    const int tid = threadIdx.x, lane = tid & 63, r32 = lane & 31, hi = lane >> 5; const int wid = __builtin_amdgcn_readfirstlane(tid >> 6);
    LAS bf16_t* Ks = (LAS bf16_t*)lds;
    LAS bf16_t* Vt = (LAS bf16_t*)(lds + 256 * KPL * 2);
    LAS float* wsf = (LAS float*)(lds + 256 * KPL * 2 + D * VPL * 2) + wid * 32;
    const int i_lo = (int)((long)vcu * 1280 / G), i_hi = (int)((long)(vcu + 1) * 1280 / G);
    int loaded = -1;
    for (int I = i_lo; I < i_hi; ++I) {
        int bh, qt, row0;
        if (I < 256) { bh = I >> 5; qt = I & 31; row0 = (bh >> 2) * L_P + qt * 256; }
        else { const int J = I - 256; bh = 8 + (J >> 4); qt = J & 15; row0 = T_P + ((bh >> 2) - 2) * L_S + qt * 256; }
        const int b = bh >> 2, h = bh & 3;
        if (bh != loaded) {
            __syncthreads();
            const bf16_t* Kg = MKV + (size_t)b * NMEM * 1024 + h * 128; const bf16_t* Vg = Kg + 512;
#pragma unroll
            for (int c = 0; c < 8; ++c) { const int idx = tid + c * 512, key = idx >> 4, ch = idx & 15;
                const u32x4 kv = *(const u32x4*)(Kg + (size_t)key * 1024 + ch * 8), vv = *(const u32x4*)(Vg + (size_t)key * 1024 + ch * 8);
                *(LAS u32x4*)(Ks + key * KPL + ch * 8) = kv;
                const unsigned w[4] = {vv.x, vv.y, vv.z, vv.w};
#pragma unroll
                for (int j = 0; j < 4; ++j) { Vt[(ch * 8 + 2 * j) * VPL + key] = (bf16_t)(w[j] & 0xffffu); Vt[(ch * 8 + 2 * j + 1) * VPL + key] = (bf16_t)(w[j] >> 16); } }
            __syncthreads();
            loaded = bh;
        }
        bf16_t* Q = ZC + (size_t)(row0 + wid * 32) * 1024 + h * 128;
        bf16x8 qf[D / 16];
#pragma unroll
        for (int d0 = 0; d0 < D / 16; ++d0) qf[d0] = *(const bf16x8*)(Q + (size_t)r32 * 1024 + d0 * 16 + hi * 8);
        f32x16 o[D / 32];
#pragma unroll
        for (int dt = 0; dt < D / 32; ++dt)
#pragma unroll
            for (int r = 0; r < 16; ++r) o[dt][r] = 0.f;
        float m_run = -1e30f, l_run = 0.f;
#pragma unroll 1
        for (int kt = 0; kt < 4; ++kt) {
            f32x16 s0, s1;
#pragma unroll
            for (int r = 0; r < 16; ++r) { s0[r] = 0.f; s1[r] = 0.f; }
#pragma unroll
            for (int d0 = 0; d0 < D / 16; ++d0) {
                const bf16x8 a0 = *(const LAS bf16x8*)(Ks + (kt * 64 + r32) * KPL + d0 * 16 + hi * 8);
                const bf16x8 a1 = *(const LAS bf16x8*)(Ks + (kt * 64 + 32 + r32) * KPL + d0 * 16 + hi * 8);
                s0 = __builtin_amdgcn_mfma_f32_32x32x16_bf16(a0, qf[d0], s0, 0, 0, 0);
                s1 = __builtin_amdgcn_mfma_f32_32x32x16_bf16(a1, qf[d0], s1, 0, 0, 0);
            }
            float mx = s0[0];
#pragma unroll
            for (int r = 0; r < 16; ++r) { mx = fmaxf(mx, s0[r]); mx = fmaxf(mx, s1[r]); }
            mx = fmaxf(mx, __shfl_xor(mx, 32));
            const float m_new = fmaxf(m_run, mx);
            const float alpha = __builtin_amdgcn_exp2f(m_run - m_new);
            m_run = m_new;
            float rs = 0.f;
#pragma unroll
            for (int r = 0; r < 16; ++r) { s0[r] = __builtin_amdgcn_exp2f(s0[r] - m_new); s1[r] = __builtin_amdgcn_exp2f(s1[r] - m_new); rs += s0[r] + s1[r]; }
            l_run = l_run * alpha + rs;
            if (kt > 0) {
                __builtin_amdgcn_wave_barrier();
                if (hi == 0) wsf[r32] = alpha;
                __builtin_amdgcn_fence(__ATOMIC_RELEASE, "wavefront"); __builtin_amdgcn_wave_barrier(); __builtin_amdgcn_fence(__ATOMIC_ACQUIRE, "wavefront");
#pragma unroll
                for (int r = 0; r < 16; ++r) { const float a = wsf[crow(r, hi)];
#pragma unroll
                    for (int dt = 0; dt < D / 32; ++dt) o[dt][r] *= a; }
            }
            bf16x8 pw[4];
            { u32x4 p;
              p.x = pk2(s0[0], s0[1]); p.y = pk2(s0[2], s0[3]); p.z = pk2(s0[4], s0[5]); p.w = pk2(s0[6], s0[7]); pw[0] = __builtin_bit_cast(bf16x8, p);
              p.x = pk2(s0[8], s0[9]); p.y = pk2(s0[10], s0[11]); p.z = pk2(s0[12], s0[13]); p.w = pk2(s0[14], s0[15]); pw[1] = __builtin_bit_cast(bf16x8, p);
              p.x = pk2(s1[0], s1[1]); p.y = pk2(s1[2], s1[3]); p.z = pk2(s1[4], s1[5]); p.w = pk2(s1[6], s1[7]); pw[2] = __builtin_bit_cast(bf16x8, p);
              p.x = pk2(s1[8], s1[9]); p.y = pk2(s1[10], s1[11]); p.z = pk2(s1[12], s1[13]); p.w = pk2(s1[14], s1[15]); pw[3] = __builtin_bit_cast(bf16x8, p); }
#pragma unroll
            for (int dt = 0; dt < D / 32; ++dt)
#pragma unroll
                for (int ks = 0; ks < 4; ++ks) {
                    const LAS bf16_t* vp = Vt + (dt * 32 + r32) * VPL + kt * 64 + 16 * ks + 4 * hi;
                    const s16x4 lo = *(const LAS s16x4*)vp, hh = *(const LAS s16x4*)(vp + 8);
                    const bf16x8 bb = __builtin_shufflevector(lo, hh, 0, 1, 2, 3, 4, 5, 6, 7);
                    o[dt] = __builtin_amdgcn_mfma_f32_32x32x16_bf16(pw[ks], bb, o[dt], 0, 0, 0);
                }
        }
        l_run += __shfl_xor(l_run, 32);
        __builtin_amdgcn_wave_barrier();
        if (hi == 0) wsf[r32] = fast_rcp(l_run);
        __builtin_amdgcn_fence(__ATOMIC_RELEASE, "wavefront"); __builtin_amdgcn_wave_barrier(); __builtin_amdgcn_fence(__ATOMIC_ACQUIRE, "wavefront");
#pragma unroll
        for (int r = 0; r < 16; ++r) {
            const int row = crow(r, hi); const float inv = wsf[row];
#pragma unroll
            for (int dt = 0; dt < D / 32; ++dt) {
                const int col = dt * 32 + r32;
                const float g = __builtin_bit_cast(float, (unsigned)Q[(size_t)row * 1024 + 512 + col] << 16);
                Q[(size_t)row * 1024 + col] = (bf16_t)f2bf(o[dt][r] * inv * g);
            }
        }
        __builtin_amdgcn_wave_barrier();
    }
    __syncthreads();
}

__device__ __forceinline__ void transpose_item(const float* W, int ldw, int nblk, bf16_t* WT, LAS float* scr, int item, int lane) {
    const int kb = item / nblk, nb = item % nblk, k0 = 64 * kb, n0 = 32 * nb;
#pragma unroll 8
    for (int i = 0; i < 32; ++i) { const int kk = 2 * i + (lane >> 5); scr[kk * 33 + (lane & 31)] = W[(size_t)(k0 + kk) * ldw + n0 + (lane & 31)]; }
    asm volatile("s_waitcnt lgkmcnt(0)" ::: "memory");
    const int c = lane & 7;
#pragma unroll
    for (int j = 0; j < 4; ++j) { const int n = (lane >> 3) + 8 * j; const LAS float* s = scr + (8 * c) * 33 + n;
        u32x4 o; o.x = pk2(s[0 * 33], s[1 * 33]); o.y = pk2(s[2 * 33], s[3 * 33]); o.z = pk2(s[4 * 33], s[5 * 33]); o.w = pk2(s[6 * 33], s[7 * 33]);
        *(u32x4*)(WT + (size_t)(n0 + n) * 1024 + k0 + 8 * c) = o; }
    asm volatile("s_waitcnt lgkmcnt(0)" ::: "memory");
}
__device__ __forceinline__ void rms_row_to_bf16(const float* xrow, const float* g, bf16_t* orow, int lane) {
    const f32x4* xr = (const f32x4*)xrow + lane; const f32x4* gr = (const f32x4*)g + lane;
    f32x4 v[4]; float s = 0.f;
#pragma unroll
    for (int j = 0; j < 4; ++j) { v[j] = xr[64 * j]; s += (v[j].x * v[j].x + v[j].y * v[j].y) + (v[j].z * v[j].z + v[j].w * v[j].w); }
    const float rinv = 1.0f / sqrtf(wave_sum(s) * (1.f / 1024.f) + EPS);
    u32x2* o8 = (u32x2*)orow + lane;
#pragma unroll
    for (int j = 0; j < 4; ++j) { const f32x4 gg = gr[64 * j]; u32x2 w; w.x = pk2(v[j].x * rinv * gg.x, v[j].y * rinv * gg.y); w.y = pk2(v[j].z * rinv * gg.z, v[j].w * rinv * gg.w); o8[64 * j] = w; }
}

__device__ __forceinline__ void rms_row2_to_bf16(const float* xa, const float* xb, const float* g, bf16_t* oa, bf16_t* ob, int lane) {
    const f32x4* ra = (const f32x4*)xa + lane; const f32x4* rb = (const f32x4*)xb + lane; const f32x4* gr = (const f32x4*)g + lane;
    f32x4 va[4], vb[4]; float sa = 0.f, sb = 0.f;
#pragma unroll
    for (int j = 0; j < 4; ++j) { va[j] = ra[64 * j]; vb[j] = rb[64 * j]; }
#pragma unroll
    for (int j = 0; j < 4; ++j) { sa += (va[j].x * va[j].x + va[j].y * va[j].y) + (va[j].z * va[j].z + va[j].w * va[j].w); sb += (vb[j].x * vb[j].x + vb[j].y * vb[j].y) + (vb[j].z * vb[j].z + vb[j].w * vb[j].w); }
#pragma unroll
    for (int o = 1; o < 64; o <<= 1) { sa += __shfl_xor(sa, o); sb += __shfl_xor(sb, o); }
    const float ia = 1.0f / sqrtf(sa * (1.f / 1024.f) + EPS), ib = 1.0f / sqrtf(sb * (1.f / 1024.f) + EPS);
    u32x2* pa = (u32x2*)oa + lane; u32x2* pb = (u32x2*)ob + lane;
#pragma unroll
    for (int j = 0; j < 4; ++j) { const f32x4 gg = gr[64 * j]; u32x2 w;
        w.x = pk2(va[j].x * ia * gg.x, va[j].y * ia * gg.y); w.y = pk2(va[j].z * ia * gg.z, va[j].w * ia * gg.w); pa[64 * j] = w;
        w.x = pk2(vb[j].x * ib * gg.x, vb[j].y * ib * gg.y); w.y = pk2(vb[j].z * ib * gg.z, vb[j].w * ib * gg.w); pb[64 * j] = w; }
}

__device__ __forceinline__ void rms_row4_to_bf16(const float* x0, const float* x1, const float* x2, const float* x3, const float* g, bf16_t* o0, bf16_t* o1, bf16_t* o2, bf16_t* o3, int lane) {
    const f32x4* r[4] = {(const f32x4*)x0 + lane, (const f32x4*)x1 + lane, (const f32x4*)x2 + lane, (const f32x4*)x3 + lane}; const f32x4* gr = (const f32x4*)g + lane;
    u32x2* po[4] = {(u32x2*)o0 + lane, (u32x2*)o1 + lane, (u32x2*)o2 + lane, (u32x2*)o3 + lane};
    f32x4 v[4][4]; float sq[4] = {0.f, 0.f, 0.f, 0.f};
#pragma unroll
    for (int q = 0; q < 4; ++q)
#pragma unroll
        for (int j = 0; j < 4; ++j) v[q][j] = __builtin_nontemporal_load(r[q] + 64 * j);
#pragma unroll
    for (int q = 0; q < 4; ++q)
#pragma unroll
        for (int j = 0; j < 4; ++j) sq[q] += (v[q][j].x * v[q][j].x + v[q][j].y * v[q][j].y) + (v[q][j].z * v[q][j].z + v[q][j].w * v[q][j].w);
#pragma unroll
    for (int o = 1; o < 64; o <<= 1) { sq[0] += __shfl_xor(sq[0], o); sq[1] += __shfl_xor(sq[1], o); sq[2] += __shfl_xor(sq[2], o); sq[3] += __shfl_xor(sq[3], o); }
#pragma unroll
    for (int j = 0; j < 4; ++j) { const f32x4 gg = gr[64 * j];
#pragma unroll
        for (int q = 0; q < 4; ++q) { const float iv = 1.0f / sqrtf(sq[q] * (1.f / 1024.f) + EPS); u32x2 w;
            w.x = pk2(v[q][j].x * iv * gg.x, v[q][j].y * iv * gg.y); w.y = pk2(v[q][j].z * iv * gg.z, v[q][j].w * iv * gg.w); po[q][64 * j] = w; } }
}

struct Args { const float* in[16]; float* out; unsigned char* ws; };

__global__ void __launch_bounds__(512) fwd_megakernel(Args args) {
    extern __shared__ __attribute__((aligned(16))) unsigned char lds_raw[];
    LAS unsigned char* lds = (LAS unsigned char*)lds_raw;
    cg::grid_group grid = cg::this_grid();
    volatile LAS unsigned* xb_st = (volatile LAS unsigned*)(lds + LDS_BYTES - 16);
    if (threadIdx.x == 0) { xb_st[0] = 0u; xb_st[1] = 0u; }
    __syncthreads();
    const XcdBarrier xbar = xcd_barrier_post((unsigned*)(args.ws + WS_BAR), xb_st);
    const int tid = threadIdx.x, lane = tid & 63; const int wave = __builtin_amdgcn_readfirstlane(tid >> 6);
    const int G = gridDim.x, bx = blockIdx.x;
    const int vcu = (G % 8 == 0) ? (bx % 8) * (G / 8) + bx / 8 : bx;
    const int gw = vcu * NWAVES + wave, NGW = G * NWAVES;
    unsigned char* ws = args.ws; Ptrs P{ws};
    const float* x_prompt = args.in[0]; const float* x_sample = args.in[1]; const float* mem_prompt = args.in[2]; const float* mem_sample = args.in[3];
    const float* ln_pre = args.in[4]; const float* ln_post = args.in[5]; const float* ln_mem = args.in[6]; const float* w_in = args.in[7];
    const float* b_merge = args.in[8]; const float* q_norm = args.in[9]; const float* k_norm = args.in[10]; const float* w_pool = args.in[11];
    const float* pool_scale = args.in[12]; const float* w_mem_kv = args.in[13]; const float* w_branch = args.in[14]; const float* w_out = args.in[15];
    bf16_t* XN = (bf16_t*)(ws + WS_XN); bf16_t* ZA = (bf16_t*)(ws + WS_ZA); bf16_t* ZB = (bf16_t*)(ws + WS_ZB); bf16_t* ZC = (bf16_t*)(ws + WS_ZC);
    bf16_t* ZD = (bf16_t*)(ws + WS_ZD); bf16_t* MIX = (bf16_t*)(ws + WS_MIX); bf16_t* MEMN = (bf16_t*)(ws + WS_MEMN); bf16_t* MKV = (bf16_t*)(ws + WS_MKV);
    float* SS = (float*)(ws + WS_SS);

    {
        LAS float* scr = (LAS float*)(lds + wave * 16384);
        constexpr int I_IN = 16 * 184, I_SQ = 16 * 32, I_BR = 8 * 32;
        constexpr int NITEMS = I_IN + 2 * I_SQ + 3 * I_BR;
        for (int it = gw; it < NITEMS; it += NGW) {
            int r = it;
            if (r < I_IN) { transpose_item(w_in + 512, IN_DIM, 184, (bf16_t*)(ws + WS_WIN) + (size_t)512 * 1024, scr, r, lane); continue; } r -= I_IN;
            if (r < I_SQ) { transpose_item(w_mem_kv, 1024, 32, (bf16_t*)(ws + WS_WMKV), scr, r, lane); continue; } r -= I_SQ;
            if (r < I_SQ) { transpose_item(w_out, 1024, 32, (bf16_t*)(ws + WS_WOUT), scr, r, lane); continue; } r -= I_SQ;
            if (r < 3 * I_BR) { const int n = r / I_BR; r -= n * I_BR;
                transpose_item(w_branch + (size_t)n * 512 * 1024, 1024, 32, (bf16_t*)(ws + (n < 2 ? WS_WB01 : WS_WB2P)) + (n == 1 ? 512 : 0), scr, r, lane); continue; }
        }
        for (int it = gw; it < 128 * 4 * 2; it += NGW) {
            const int kb = it >> 3, g = (it >> 1) & 3, dh = it & 1, d = dh * 64 + lane;
            const float* wi = w_in + (size_t)(kb * 8) * IN_DIM + g * 128; const float* wp = w_pool + (size_t)g * 128 * 128 + d;
            float a8[8] = {0.f, 0.f, 0.f, 0.f, 0.f, 0.f, 0.f, 0.f};
#pragma unroll 4
            for (int c = 0; c < 128; ++c) { const float b = wp[(size_t)c * 128];
#pragma unroll
                for (int kk = 0; kk < 8; ++kk) a8[kk] += wi[(size_t)kk * IN_DIM + c] * b; }
            u32x4 o; o.x = pk2(a8[0], a8[1]); o.y = pk2(a8[2], a8[3]); o.z = pk2(a8[4], a8[5]); o.w = pk2(a8[6], a8[7]);
            *(u32x4*)((bf16_t*)(ws + WS_WIN) + (size_t)(g * 128 + d) * 1024 + kb * 8) = o;
        }
        for (int m = gw; m < T; m += 4 * NGW) {
            const float* xr[4]; int mr[4];
#pragma unroll
            for (int q = 0; q < 4; ++q) { const int mq = m + q * NGW; mr[q] = (mq < T) ? mq : m; xr[q] = (mr[q] < T_P) ? x_prompt + (size_t)mr[q] * DM : x_sample + (size_t)(mr[q] - T_P) * DM; }
            rms_row4_to_bf16(xr[0], xr[1], xr[2], xr[3], ln_pre, XN + (size_t)mr[0] * DM, XN + (size_t)mr[1] * DM, XN + (size_t)mr[2] * DM, XN + (size_t)mr[3] * DM, lane);
        }
        for (int m = gw; m < MEMROWS; m += NGW) { const float* xr = (m < 2 * NMEM) ? mem_prompt + (size_t)m * DM : mem_sample + (size_t)(m - 2 * NMEM) * DM; rms_row_to_bf16(xr, ln_mem, MEMN + (size_t)m * DM, lane); }
        for (int i = bx * 512 + tid; i < T; i += G * 512) SS[i] = 0.f;
        if (bx == 0 && tid < 320) ((unsigned*)(ws + WS_CNT))[tid] = 0u;
    }
    grid.sync();

    { SchedP1 S{P, G, bx}; EpiStore E{pool_scale}; pg8::gemm_phase(lds, S, E); }
#if DUP_MASK & 1
    __syncthreads();
    { SchedP1 S{P, G, bx}; EpiStore E{pool_scale}; pg8::gemm_phase(lds, S, E); }
#endif
    xcd_barrier(xbar);

    {
        for (int base = gw * 8; base < T * 10; base += NGW * 8 * 8) {
            u32x4 raw4[8];
#pragma unroll
            for (int uu = 0; uu < 8; ++uu) { const int it = base + uu * NGW * 8 + (lane >> 3);
                if (it < T * 10) { const int tok = it / 10, hh = it - tok * 10, sub = lane & 7;
                    const bf16_t* ptr = (hh < 8) ? ZB + (size_t)tok * 1024 + hh * 64 + sub * 8 : ZD + (size_t)tok * 256 + (hh - 8) * 64 + sub * 8;
                    raw4[uu] = *(const u32x4*)ptr; } else raw4[uu] = (u32x4){0u, 0u, 0u, 0u}; }
#pragma unroll
            for (int uu = 0; uu < 8; ++uu) {
                const int it = base + uu * NGW * 8 + (lane >> 3);
                const bool ok = it < T * 10;
                const int tok = it / 10, hh = it - tok * 10, sub = lane & 7;
                bf16_t* ptr = (hh < 8) ? ZB + (size_t)tok * 1024 + hh * 64 + sub * 8 : ZD + (size_t)tok * 256 + (hh - 8) * 64 + sub * 8;
                const u32x4 raw = raw4[uu];
                float v[8] = {bflo(raw.x), bfhi(raw.x), bflo(raw.y), bfhi(raw.y), bflo(raw.z), bfhi(raw.z), bflo(raw.w), bfhi(raw.w)};
                float ssq = 0.f;
#pragma unroll
                for (int j = 0; j < 8; ++j) ssq += v[j] * v[j];
                ssq += __shfl_xor(ssq, 1); ssq += __shfl_xor(ssq, 2); ssq += __shfl_xor(ssq, 4);
                const float rinv = 1.0f / sqrtf(ssq * (1.f / 64.f) + EPS);
                const float* gn = ((hh < 8) ? q_norm : k_norm) + sub * 8;
                const int tl = (tok < T_P) ? (tok & (L_P - 1)) : ((tok - T_P) & (L_S - 1));
                const float pos = (sub < 4) ? (float)(tl >> 6) : (float)(tl & 63);
                const float osc = (hh < 8) ? C2_SELF : 1.0f;
                float o[8];
#pragma unroll
                for (int jj = 0; jj < 4; ++jj) {
                    const int fi = (sub & 3) * 4 + jj;
                    const float inv = __builtin_amdgcn_exp2f(-(float)(2 * fi) * (13.287712379549449f / 32.0f));
                    const float rev = pos * inv * 0.15915494309189535f;
                    const float cs = __builtin_amdgcn_cosf(rev), sn = __builtin_amdgcn_sinf(rev);
                    const float y0 = v[2 * jj] * rinv * gn[2 * jj], y1 = v[2 * jj + 1] * rinv * gn[2 * jj + 1];
                    o[2 * jj] = (y0 * cs - y1 * sn) * osc; o[2 * jj + 1] = (y0 * sn + y1 * cs) * osc;
                }
                u32x4 w; w.x = pk2(o[0], o[1]); w.y = pk2(o[2], o[3]); w.z = pk2(o[4], o[5]); w.w = pk2(o[6], o[7]);
                if (ok) *(u32x4*)ptr = w;
            }
        }
        for (int it = gw; it < 4 * (T / 32); it += NGW) {
            const int g = (it + it / NGW) & 3, tok0 = ((it >> 2) * 4 + (lane >> 4)) * 8, col = g * 128 + (lane & 15) * 8;
            const int Lq = (tok0 < T_P) ? L_P : L_S; const int tl0 = (tok0 < T_P) ? (tok0 & (L_P - 1)) : ((tok0 - T_P) & (L_S - 1));
            const bf16_t* bp = ZA + (size_t)tok0 * 1024 + col;
            const f32x4 p0 = *(const f32x4*)(pool_scale + col), p1 = *(const f32x4*)(pool_scale + col + 4);
            u32x4 gt[4];
#pragma unroll
            for (int i = 0; i < 4; ++i) gt[i] = *(const u32x4*)(bp + (size_t)i * 1024 + 512);
#define UNP(V_, F_) { F_[0] = bflo((V_).x); F_[1] = bfhi((V_).x); F_[2] = bflo((V_).y); F_[3] = bfhi((V_).y); F_[4] = bflo((V_).z); F_[5] = bfhi((V_).z); F_[6] = bflo((V_).w); F_[7] = bfhi((V_).w); }
#define MK(j_) (((unsigned)(tl0 - W_ / 2 + (j_)) < (unsigned)Lq) ? 1.f : 0.f)
#define POOL_RUN(WW) { constexpr int W_ = WW; constexpr int NR = 8 + W_ - 1; u32x4 rw[NR]; \
                _Pragma("unroll") for (int j = 0; j < NR; ++j) { const bool ok = (unsigned)(tl0 - W_ / 2 + j) < (unsigned)Lq; rw[j] = *(const u32x4*)(bp + (ok ? (j - W_ / 2) : 0) * 1024); } \
                float sm[8] = {0.f, 0.f, 0.f, 0.f, 0.f, 0.f, 0.f, 0.f}; float cnt = 0.f; \
                _Pragma("unroll") for (int j = 0; j < W_; ++j) { float f[8]; UNP(rw[j], f); const float mk = MK(j); cnt += mk; _Pragma("unroll") for (int e = 0; e < 8; ++e) sm[e] += mk * f[e]; } \
                _Pragma("unroll") for (int i = 0; i < 8; ++i) { \
                    const float ic = 1.0f / cnt; float c[8], gg[8]; UNP(rw[i + W_ / 2], c); UNP(gt[i & 3], gg); \
                    if (i == 3) { _Pragma("unroll") for (int q = 0; q < 4; ++q) gt[q] = *(const u32x4*)(bp + (size_t)(4 + q) * 1024 + 512); } \
                    u32x4 wv; wv.x = pk2((sm[0] * ic - c[0]) * p0.x * gg[0], (sm[1] * ic - c[1]) * p0.y * gg[1]); \
                    wv.y = pk2((sm[2] * ic - c[2]) * p0.z * gg[2], (sm[3] * ic - c[3]) * p0.w * gg[3]); \
                    wv.z = pk2((sm[4] * ic - c[4]) * p1.x * gg[4], (sm[5] * ic - c[5]) * p1.y * gg[5]); \
                    wv.w = pk2((sm[6] * ic - c[6]) * p1.z * gg[6], (sm[7] * ic - c[7]) * p1.w * gg[7]); \
                    *(u32x4*)(MIX + (size_t)(tok0 + i) * 1024 + col) = wv; \
                    if (i < 7) { float fa[8], fs[8]; UNP(rw[i + W_], fa); UNP(rw[i], fs); const float ma = MK(i + W_), ms = MK(i); cnt += ma - ms; \
                        _Pragma("unroll") for (int e = 0; e < 8; ++e) sm[e] += ma * fa[e] - ms * fs[e]; } } }
            if (g == 0) POOL_RUN(2) else if (g == 1) POOL_RUN(4) else if (g == 2) POOL_RUN(8) else POOL_RUN(16)
#undef POOL_RUN
#undef MK
#undef UNP
        }
        cross_attn_phase(ZC, MKV, lds, vcu, G);
    }
    xcd_barrier(xbar);

    {
        for (int L = vcu; L < 2560; L += G) {
            int row0, Lq, kvh, hq, qb;
            if (L < 2048) { const int grp = L >> 6, ui = L & 63; const int seq = grp >> 1; kvh = grp & 1; hq = ui >> 4; qb = ui & 15; row0 = T_P + seq * L_S; Lq = L_S; }
            else { const int p = L - 2048, grp = p >> 7, ui = p & 127; const int seq = grp >> 1; kvh = grp & 1; hq = ui >> 5; qb = ui & 31; row0 = seq * L_P; Lq = L_P; }
            const int h = kvh * 4 + hq;
            bf16_t* Qp = ZB + (size_t)(row0 + qb * 256) * 1024 + h * 64;
            const bf16_t* Kp = ZD + (size_t)row0 * 256 + kvh * 64;
#if DUP_MASK & 2
            attn_body::attn_unit<8>((const attn_body::bf16*)Qp, (const attn_body::bf16*)Kp, (const attn_body::bf16*)(Kp + 128), Lq / 64, (const attn_body::bf16*)(Qp + 512), (attn_body::bf16*)(ws + WS_SCR + (size_t)bx * SCR_PER_BLOCK), (char*)lds_raw);
#endif
            attn_body::attn_unit<8>((const attn_body::bf16*)Qp, (const attn_body::bf16*)Kp, (const attn_body::bf16*)(Kp + 128), Lq / 64, (const attn_body::bf16*)(Qp + 512), (attn_body::bf16*)Qp, (char*)lds_raw);
        }
    }
    xcd_barrier(xbar);

    { SchedMerge S{P, G, bx}; EpiGate E{b_merge, (char*)ws + WS_SCR + (size_t)bx * SCR_PER_BLOCK}; pg8::gemm_phase(lds, S, E); }
#if DUP_MASK & 4
    __syncthreads();
    { SchedMerge S{P, G, bx}; EpiGate E{b_merge, (char*)ws + WS_SCR + (size_t)bx * SCR_PER_BLOCK}; pg8::gemm_phase(lds, S, E); }
#endif
    xcd_barrier(xbar);

    { SchedOut S{P, G, bx}; EpiOut E{SS, (unsigned*)(ws + WS_CNT), x_prompt, x_sample, ln_post, args.out}; pg8::gemm_phase(lds, S, E); }
}

extern "C" void kernel_launch(void* const* d_in, const int* in_sizes, int n_in, void* d_out, int out_size, void* d_ws, size_t ws_size, hipStream_t stream) {
    static int grid_blocks = 0;
    if (grid_blocks == 0) {
        if (n_in != 16 || out_size != T * DM || ws_size < WS_END) { fprintf(stderr, "kernel_launch: unexpected shapes (n_in %d out %d ws %zu need %zu)\n", n_in, out_size, ws_size, (size_t)WS_END); grid_blocks = -1; return; }
        int dev = 0, cus = 0, per_cu = 0;
        hipGetDevice(&dev);
        hipDeviceGetAttribute(&cus, hipDeviceAttributeMultiprocessorCount, dev);
        if (hipFuncSetAttribute((const void*)fwd_megakernel, hipFuncAttributeMaxDynamicSharedMemorySize, LDS_BYTES) != hipSuccess) { fprintf(stderr, "kernel_launch: hipFuncSetAttribute failed\n"); grid_blocks = -1; return; }
        if (hipOccupancyMaxActiveBlocksPerMultiprocessor(&per_cu, (const void*)fwd_megakernel, 512, LDS_BYTES) != hipSuccess || per_cu < 1) { fprintf(stderr, "kernel_launch: occupancy query failed (%d)\n", per_cu); (void)hipGetLastError(); per_cu = 1; }
        grid_blocks = cus * 1;
        if (grid_blocks > 256) grid_blocks = 256;
    }
    if (grid_blocks < 0) return;
    if (hipMemsetAsync((char*)d_ws + WS_BAR, 0, XCD_BAR_WORDS * 4, stream) != hipSuccess) { fprintf(stderr, "kernel_launch: hipMemsetAsync failed\n"); return; }
    Args a{};
    for (int i = 0; i < 16; ++i) a.in[i] = (const float*)d_in[i];
    a.out = (float*)d_out; a.ws = (unsigned char*)d_ws;
    void* kargs[] = {&a};
    hipError_t e = hipLaunchCooperativeKernel((const void*)fwd_megakernel, dim3(grid_blocks), dim3(512), kargs, LDS_BYTES, stream);
    if (e != hipSuccess) fprintf(stderr, "cooperative launch failed: %s (grid %d)\n", hipGetErrorString(e), grid_blocks);
}
```

```cpp
#include <hip/hip_runtime.h>
#include <hip/hip_cooperative_groups.h>
#include <cstdio>
#include <cstdint>
#include <cmath>
#include <hip/hip_bf16.h>
namespace cg = cooperative_groups;
#ifndef DUP_MASK
#define DUP_MASK 0
#endif

#define LAS __attribute__((address_space(3)))
typedef unsigned short bf16_t;
typedef short bf16x8 __attribute__((ext_vector_type(8)));
typedef short s16x4 __attribute__((ext_vector_type(4)));
typedef float f32x4 __attribute__((ext_vector_type(4)));
typedef float f32x16 __attribute__((ext_vector_type(16)));
typedef unsigned u32x4 __attribute__((ext_vector_type(4)));
typedef unsigned u32x2 __attribute__((ext_vector_type(2)));
typedef float f32x2_t __attribute__((ext_vector_type(2)));
typedef __bf16 bf16x2_t __attribute__((ext_vector_type(2)));

constexpr int DM = 1024;
constexpr int T_P = 2 * 8192, T_S = 16 * 4096, T = T_P + T_S;
constexpr int L_P = 8192, L_S = 4096;
constexpr int NMEM = 256, MEMROWS = 18 * NMEM;
constexpr int IN_DIM = 6400, ZW = 3328;
constexpr float EPS = 1e-6f;
constexpr float LOG2E = 1.4426950408889634f;
constexpr float C2_SELF = 0.125f * LOG2E;
constexpr float C2_CROSS = 0.08838834764831845f * LOG2E;

constexpr size_t MiB = 1u << 20;
constexpr size_t TB = (size_t)T * 1024 * 2;
constexpr size_t WS_SS = 0;
constexpr size_t WS_CNT = 512 * 1024;
constexpr size_t WS_BAR = 768 * 1024;
constexpr size_t WS_WIN = 1 * MiB;
constexpr size_t WS_WMKV = 14 * MiB, WS_WOUT = 16 * MiB, WS_WB01 = 18 * MiB, WS_WB2P = 20 * MiB;
constexpr size_t WS_MEMN = 22 * MiB, WS_MKV = 31 * MiB;
constexpr size_t WS_XN = 40 * MiB;
constexpr size_t WS_ZA = WS_XN + TB, WS_ZB = WS_ZA + TB, WS_ZC = WS_ZB + TB;
constexpr size_t WS_ZD = WS_ZC + TB;
constexpr size_t WS_MIX = WS_ZD + (size_t)T * 256 * 2;
constexpr size_t WS_SCR = WS_MIX + TB;
constexpr size_t SCR_PER_BLOCK = 256 * 1024;
constexpr size_t WS_END = WS_SCR + 256 * SCR_PER_BLOCK;
static_assert(WS_END <= 1024 * MiB, "workspace map");

constexpr int LDS_BYTES = 139264;
constexpr int NWAVES = 8;

__device__ __forceinline__ unsigned f2bf(float f) { unsigned u = __builtin_bit_cast(unsigned, f); return (u + 0x7fffu + ((u >> 16) & 1u)) >> 16; }
__device__ __forceinline__ unsigned pk2(float lo, float hi) { f32x2_t v = {lo, hi}; bf16x2_t b = __builtin_convertvector(v, bf16x2_t); return __builtin_bit_cast(unsigned, b); }
__device__ __forceinline__ float bflo(unsigned w) { return __builtin_bit_cast(float, w << 16); }
__device__ __forceinline__ float bfhi(unsigned w) { return __builtin_bit_cast(float, w & 0xffff0000u); }
__device__ __forceinline__ float fast_rcp(float x) { return __builtin_amdgcn_rcpf(x); }
__device__ __forceinline__ float sigmoidf_(float x) { return fast_rcp(1.0f + __builtin_amdgcn_exp2f(-x * LOG2E)); }
__device__ __forceinline__ float siluf_(float x) { return x * sigmoidf_(x); }
__device__ __forceinline__ float wave_sum(float v) {
#pragma unroll
    for (int o = 1; o < 64; o <<= 1) v += __shfl_xor(v, o);
    return v;
}
__device__ __forceinline__ int crow(int r, int hi) { return (r & 3) + 8 * (r >> 2) + 4 * hi; }

namespace pg8 {
constexpr int BM = 256, BK = 64, HALF = 128, HTB = HALF * BK * 2, STAGE_BYTES = 8 * HTB, NXCD = 8, WGM = 8;
constexpr int KP = 1024;
__device__ __forceinline__ int lds_byte(int r, int c) { const int st = (r >> 4) * 2 + (c >> 5), rr = r & 15, cc = c & 31, ob = rr * 64 + cc * 2; return st * 1024 + (ob ^ (((ob >> 9) & 1) << 5)); }
__device__ __forceinline__ void stage_rc(int b, int& R, int& C) { const int st = b / 1024, sb = b % 1024, swz = sb ^ (((sb >> 9) & 1) << 5); R = (st >> 1) * 16 + swz / 64; C = (st & 1) * 32 + (swz % 64) / 2; }
__device__ __forceinline__ int perm32(int rho) { const int n = rho >> 4, i = rho & 15; return 8 * (i >> 2) + 4 * n + (i & 3); }

struct Unit { const char* A; const char* B; int nt; int kind; int r0; int c0; int aux; char* O; int ldc; float sc; };

__device__ __forceinline__ void tile_order(int L, int nM, int nN, int& pm, int& pn) {
    const int nwg = nM * nN; int wgid = L;
    { const int q = nwg / NXCD, r = nwg % NXCD, xcd = wgid % NXCD, off = wgid / NXCD; wgid = (xcd < r ? xcd * (q + 1) : r * (q + 1) + (xcd - r) * q) + off; }
    const int nig = WGM * nN, gid = wgid / nig, fm = gid * WGM, gsz = (nM - fm) < WGM ? (nM - fm) : WGM;
    pm = fm + ((wgid % nig) % gsz); pn = (wgid % nig) / gsz;
}

template <class Epi, class Sched>
__device__ __forceinline__ void gemm_phase(LAS unsigned char* lds, const Sched& S, const Epi& E) {
    constexpr bool ALIGN_EPI = true;
    int tid = threadIdx.x; asm volatile("" : "+v"(tid));
    const int wid = __builtin_amdgcn_readfirstlane(tid >> 6), lane = tid & 63, wr = wid >> 2, wc = wid & 3, fr = lane & 15, fq = lane >> 4;
    const int K = KP;
    unsigned voffA[2], voffB[2];
#pragma unroll
    for (int i = 0; i < 2; ++i) { int R, C; stage_rc(tid * 16 + i * 8192, R, C); const int Rb = (R & ~31) + perm32(R & 31);
        voffA[i] = (unsigned)(R * K + C) * 2u; voffB[i] = (unsigned)(Rb * K + C) * 2u; }
    const size_t kstep = (size_t)(BK * 2);
    const size_t hstep = (size_t)HALF * K * 2;
    const unsigned ldsw = (unsigned)wid * 1024u;
    const int aoff = lds_byte(wr * 64 + fr, fq * 8), boff = lds_byte(wc * 32 + fr, fq * 8);
#define PG8_SA(b, h) (((b) * 2 + (h)) * HTB)
#define PG8_SB(b, h) ((4 + (b) * 2 + (h)) * HTB)
#define PG8_STAGE(bufoff, gbase, voff) do { _Pragma("unroll") for (int _i = 0; _i < 2; ++_i) \
        __builtin_amdgcn_global_load_lds((const unsigned*)((const char*)(gbase) + (voff)[_i]), (LAS unsigned*)(lds + (bufoff) + ldsw + _i * 8192), 16, 0, 0); } while (0)
#define PG8_LDA(dst, b, h) do { _Pragma("unroll") for (int m = 0; m < 4; ++m) _Pragma("unroll") for (int k = 0; k < 2; ++k) dst[m][k] = *(const LAS bf16x8*)(lds + PG8_SA(b, h) + aoff + m * 2048 + k * 1024); } while (0)
#define PG8_LDB(dst, b, h) do { _Pragma("unroll") for (int n = 0; n < 2; ++n) _Pragma("unroll") for (int k = 0; k < 2; ++k) dst[n][k] = *(const LAS bf16x8*)(lds + PG8_SB(b, h) + boff + n * 2048 + k * 1024); } while (0)
#define PG8_MMA(ai, bj, At, Bt) do { __builtin_amdgcn_s_setprio(1); _Pragma("unroll") for (int m = 0; m < 4; ++m) _Pragma("unroll") for (int n = 0; n < 2; ++n) _Pragma("unroll") for (int k = 0; k < 2; ++k) \
        acc[ai][bj][m][n] = __builtin_amdgcn_mfma_f32_16x16x32_bf16(Bt[n][k], At[m][k], acc[ai][bj][m][n], 0, 0, 0); __builtin_amdgcn_s_setprio(0); } while (0)
#define PG8_WAIT_V(n) asm volatile("s_waitcnt vmcnt(" #n ")" ::: "memory")
#define PG8_WAIT_L(n) asm volatile("s_waitcnt lgkmcnt(" #n ")" ::: "memory")
#define PG8_BAR __builtin_amdgcn_s_barrier()
#define PG8_SCHED __builtin_amdgcn_sched_barrier(0)
    Unit cur, nxt; int ui = 0;
    if (!S.next(0, cur)) return;
    f32x4 acc[2][2][4][2];
#pragma unroll
    for (int a = 0; a < 2; ++a)
#pragma unroll
        for (int b = 0; b < 2; ++b)
#pragma unroll
            for (int m = 0; m < 4; ++m)
#pragma unroll
                for (int n = 0; n < 2; ++n) acc[a][b][m][n] = (f32x4){0.f, 0.f, 0.f, 0.f};
    bf16x8 At[4][2], B0[2][2], B1[2][2];
    const char* cA = cur.A; const char* cB = cur.B;
    PG8_STAGE(PG8_SB(0, 0), cB, voffB); PG8_STAGE(PG8_SB(0, 1), cB + hstep, voffB); PG8_STAGE(PG8_SA(0, 0), cA, voffA); PG8_STAGE(PG8_SA(0, 1), cA + hstep, voffA);
    if (wr == 1) PG8_BAR;
    PG8_WAIT_V(2); PG8_BAR;
    PG8_STAGE(PG8_SB(1, 0), cB + kstep, voffB); PG8_STAGE(PG8_SA(1, 0), cA + kstep, voffA); PG8_STAGE(PG8_SB(1, 1), cB + hstep + kstep, voffB);
    PG8_WAIT_V(6); PG8_BAR;
    for (;;) {
        const bool has_next = S.next(ui + 1, nxt);
        const char* nA = has_next ? nxt.A : cA; const char* nB = has_next ? nxt.B : cB;
        const int nt = cur.nt;
        for (int t = 0; t < nt; t += 2) {
            const bool last = (t == nt - 2);
            const char* a1 = cA + (size_t)(t + 1) * kstep;
            const char* a2 = last ? nA : cA + (size_t)(t + 2) * kstep; const char* b2 = last ? nB : cB + (size_t)(t + 2) * kstep;
            const char* a3 = a2 + kstep; const char* b3 = b2 + kstep;
            PG8_LDB(B0, 0, 0); PG8_LDB(B1, 0, 1); PG8_SCHED; PG8_LDA(At, 0, 0); PG8_STAGE(PG8_SA(1, 1), a1 + hstep, voffA);
            PG8_WAIT_V(8); PG8_WAIT_L(0); PG8_BAR; PG8_MMA(0, 0, At, B0); PG8_MMA(0, 1, At, B1); PG8_BAR; PG8_SCHED;
            PG8_LDA(At, 0, 1); PG8_STAGE(PG8_SB(0, 0), b2, voffB); PG8_STAGE(PG8_SB(0, 1), b2 + hstep, voffB); PG8_STAGE(PG8_SA(0, 0), a2, voffA);
            PG8_WAIT_V(8); PG8_WAIT_L(0); PG8_BAR; PG8_MMA(1, 0, At, B0); PG8_MMA(1, 1, At, B1); PG8_BAR; PG8_SCHED;
            PG8_LDB(B0, 1, 0); PG8_LDB(B1, 1, 1); PG8_SCHED; PG8_LDA(At, 1, 0); PG8_STAGE(PG8_SA(0, 1), a2 + hstep, voffA);
            PG8_WAIT_V(8); PG8_WAIT_L(0); PG8_BAR; PG8_MMA(0, 0, At, B0); PG8_MMA(0, 1, At, B1); PG8_BAR; PG8_SCHED;
            PG8_LDA(At, 1, 1); PG8_STAGE(PG8_SB(1, 0), b3, voffB); PG8_STAGE(PG8_SB(1, 1), b3 + hstep, voffB); PG8_STAGE(PG8_SA(1, 0), a3, voffA);
            PG8_WAIT_V(8); PG8_WAIT_L(0); PG8_BAR; PG8_MMA(1, 0, At, B0); PG8_MMA(1, 1, At, B1); PG8_BAR; PG8_SCHED;
        }
        if constexpr (ALIGN_EPI) { if (wr == 0) PG8_BAR; }
        E(acc, cur, wr, wc, fr, fq);
        if (!has_next) break;
#pragma unroll
        for (int a = 0; a < 2; ++a)
#pragma unroll
            for (int b = 0; b < 2; ++b)
#pragma unroll
                for (int m = 0; m < 4; ++m)
#pragma unroll
                    for (int n = 0; n < 2; ++n) acc[a][b][m][n] = (f32x4){0.f, 0.f, 0.f, 0.f};
        cur = nxt; cA = nA; cB = nB; ++ui;
        if constexpr (ALIGN_EPI) { if (wr == 1) PG8_BAR; }
    }
    PG8_WAIT_V(0);
    if constexpr (!ALIGN_EPI) { if (wr == 0) PG8_BAR; }
    PG8_BAR;
#undef PG8_SA
#undef PG8_SB
#undef PG8_STAGE
#undef PG8_LDA
#undef PG8_LDB
#undef PG8_MMA
#undef PG8_WAIT_V
#undef PG8_WAIT_L
#undef PG8_BAR
#undef PG8_SCHED
}
}

namespace attn_body {
using bf16=__hip_bfloat16;
using bf16x8=__attribute__((ext_vector_type(8)))short;
using s16x4=__attribute__((ext_vector_type(4)))short;
using f32x16=__attribute__((ext_vector_type(16)))float;
using u32x4=__attribute__((ext_vector_type(4)))unsigned;
constexpr int D=64,QP=1024,KVP=256;
constexpr int NW=8,QBLK=32,QB=QBLK*NW,KVBLK=64;
__device__ __forceinline__ int crow(int r,int hi){return (r&3)+8*(r>>2)+4*hi;}
#define SBAR() __builtin_amdgcn_sched_barrier(0)
__device__ __forceinline__ void cmask(f32x16&p0,f32x16&p1,int jb,int qrel,int hi){
  const float NEG=-INFINITY; int kb=64*jb+4*hi;
  #pragma unroll
  for(int r=0;r<16;++r){int kv=kb+(r&3)+8*(r>>2); if(kv>qrel)p0[r]=NEG; if(kv+32>qrel)p1[r]=NEG;}
}

constexpr int NSLOT=3, SLOTB=8192;
constexpr int LDS_K=0, LDS_V=NSLOT*SLOTB, LDS_WS=2*NSLOT*SLOTB, LDS_OST=LDS_WS+NW*64*4, LDS_BYTES=LDS_OST+NW*4096;
constexpr float C2=0.125f*1.4426950408889634f;
__device__ __forceinline__ void glds16(const void*gsrc,unsigned lds_dst){unsigned keep;
  asm volatile("s_mov_b32 %0, m0\n\ts_mov_b32 m0, %2\n\ts_nop 0\n\tglobal_load_lds_dwordx4 %1, off\n\ts_mov_b32 m0, %0":"=&s"(keep):"v"(gsrc),"s"(lds_dst):"memory");}
__device__ __forceinline__ float max3f(float a,float b,float c){float r;asm("v_max3_f32 %0, %1, %2, %3":"=v"(r):"v"(a),"v"(b),"v"(c));return r;}
__device__ __forceinline__ float max2f(float a,float b){float r;asm("v_max_f32_e32 %0, %1, %2":"=v"(r):"v"(a),"v"(b));return r;}
__device__ __forceinline__ float fadd_s(float a,float b){float r;asm("v_add_f32_e32 %0, %1, %2":"=v"(r):"v"(a),"v"(b));return r;}
__device__ __forceinline__ float fsub_s(float a,float b){float r;asm("v_sub_f32_e32 %0, %1, %2":"=v"(r):"v"(a),"v"(b));return r;}
typedef float f32x2_t __attribute__((ext_vector_type(2))); typedef __bf16 bf16x2_t __attribute__((ext_vector_type(2)));
__device__ __forceinline__ unsigned cvtpk_s(float lo,float hi){f32x2_t v={lo,hi};bf16x2_t b=__builtin_convertvector(v,bf16x2_t);return __builtin_bit_cast(unsigned,b);}
#define WAIT_BAR(N) asm volatile("s_waitcnt vmcnt(" #N ") lgkmcnt(0)\n\ts_barrier":::"memory")

__device__ __forceinline__ void qkt(f32x16&p0,f32x16&p1,const char*Kslot,const bf16x8*qr,const f32x16&negm,int r32,int hi){
  const char*kb=Kslot+hi*1024+r32*16;
  #pragma unroll
  for(int d0=0;d0<4;++d0){
    const bf16x8 b0=*reinterpret_cast<const bf16x8*>(kb+d0*2048);
    const bf16x8 b1=*reinterpret_cast<const bf16x8*>(kb+d0*2048+512);
    if(d0==0){p0=__builtin_amdgcn_mfma_f32_32x32x16_bf16(b0,qr[0],negm,0,0,0);p1=__builtin_amdgcn_mfma_f32_32x32x16_bf16(b1,qr[0],negm,0,0,0);}
    else{p0=__builtin_amdgcn_mfma_f32_32x32x16_bf16(b0,qr[d0],p0,0,0,0);p1=__builtin_amdgcn_mfma_f32_32x32x16_bf16(b1,qr[d0],p1,0,0,0);}}
}
typedef __attribute__((address_space(3))) const char* lds_cptr;
typedef short v4i16_t __attribute__((ext_vector_type(4)));
__device__ __forceinline__ void kload8(bf16x8*kf,lds_cptr kp){
  kf[0]=*(const __attribute__((address_space(3))) bf16x8*)(kp);      kf[1]=*(const __attribute__((address_space(3))) bf16x8*)(kp+512);
  kf[2]=*(const __attribute__((address_space(3))) bf16x8*)(kp+2048); kf[3]=*(const __attribute__((address_space(3))) bf16x8*)(kp+2560);
  kf[4]=*(const __attribute__((address_space(3))) bf16x8*)(kp+4096); kf[5]=*(const __attribute__((address_space(3))) bf16x8*)(kp+4608);
  kf[6]=*(const __attribute__((address_space(3))) bf16x8*)(kp+6144); kf[7]=*(const __attribute__((address_space(3))) bf16x8*)(kp+6656);
}
__device__ __forceinline__ void kload2(bf16x8*kf,lds_cptr kp,int j){ kf[2*j]=*(const __attribute__((address_space(3))) bf16x8*)(kp+j*2048); kf[2*j+1]=*(const __attribute__((address_space(3))) bf16x8*)(kp+j*2048+512); }
__device__ __forceinline__ s16x4 vtr(lds_cptr p){ return __builtin_bit_cast(s16x4,__builtin_amdgcn_ds_read_tr16_b64_v4i16((__attribute__((address_space(3))) v4i16_t*)p)); }
__device__ __forceinline__ float rowmax(const f32x16&p0,const f32x16&p1){
  float a=max3f(p0[0],p0[1],p1[0]),b=max3f(p0[2],p0[3],p1[1]);a=max3f(a,p1[2],p1[3]);
  #pragma unroll
  for(int r=4;r<16;r+=4){a=max3f(a,p0[r],p0[r+1]);b=max3f(b,p0[r+2],p0[r+3]);a=max3f(a,p1[r],p1[r+1]);b=max3f(b,p1[r+2],p1[r+3]);}
  const float m=max2f(a,b);
  auto rr=__builtin_amdgcn_permlane32_swap(__float_as_uint(m),__float_as_uint(m),false,false);
  return max2f(__uint_as_float(rr[0]),__uint_as_float(rr[1]));
}
__device__ __forceinline__ void pv(f32x16*o,int vb,bf16x8 pa0,bf16x8 pa1,bf16x8 pa2,bf16x8 pa3){
  #pragma unroll
  for(int d0=0;d0<2;++d0){s16x4 lo[4],hi[4];
    #pragma unroll
    for(int ks=0;ks<4;++ks){
      asm volatile("ds_read_b64_tr_b16 %0,%1 offset:%c2":"=&v"(lo[ks]):"v"(vb),"i"(d0*4096+ks*1024):"memory");
      asm volatile("ds_read_b64_tr_b16 %0,%1 offset:%c2":"=&v"(hi[ks]):"v"(vb),"i"(d0*4096+ks*1024+512):"memory");}
    asm volatile("s_waitcnt lgkmcnt(0)":::"memory");SBAR();
    #define PK(k) (bf16x8){lo[k][0],lo[k][1],lo[k][2],lo[k][3],hi[k][0],hi[k][1],hi[k][2],hi[k][3]}
    o[d0]=__builtin_amdgcn_mfma_f32_32x32x16_bf16(pa0,PK(0),o[d0],0,0,0);
    o[d0]=__builtin_amdgcn_mfma_f32_32x32x16_bf16(pa1,PK(1),o[d0],0,0,0);
    o[d0]=__builtin_amdgcn_mfma_f32_32x32x16_bf16(pa2,PK(2),o[d0],0,0,0);
    o[d0]=__builtin_amdgcn_mfma_f32_32x32x16_bf16(pa3,PK(3),o[d0],0,0,0);
    #undef PK
  }
}

#ifndef ATTN_STORE16
#define ATTN_STORE16(p,v) (*(u32x4*)(p)=(v))
#endif
template<int THRL> __device__ __forceinline__ void attn_unit(const bf16*Qb,const bf16*__restrict__ Kh,const bf16*__restrict__ Vh,const int NT,const bf16*Gb,bf16*Ob,char*shm){
  const int tid=threadIdx.x,lane=tid&63,r32=lane&31,hi=lane>>5; const int wid=__builtin_amdgcn_readfirstlane(tid>>6);
  const bf16*Qw=Qb+(long)(wid*QBLK)*QP;
  const unsigned lds0=(unsigned)(uintptr_t)shm;
  float*wsf=(float*)(shm+LDS_WS)+wid*64;
  const bf16*ksrc=Kh+(long)lane*KVP+wid*8;
  const bf16*vsrc=Vh+(long)(16*(wid&3)+(lane>>2))*KVP+(wid>>2)*32+(lane&3)*8;
  const unsigned kdst=lds0+LDS_K+wid*1024, vdst=lds0+LDS_V+wid*1024;
  #define DMA_K(t,slot) glds16(ksrc+(long)(t)*KVBLK*KVP,(unsigned)__builtin_amdgcn_readfirstlane(kdst+(slot)))
  #define DMA_V(t,slot) glds16(vsrc+(long)(t)*KVBLK*KVP,(unsigned)__builtin_amdgcn_readfirstlane(vdst+(slot)))
  const int vb0=(int)(lds0+LDS_V)+((lane>>4)&1)*32+(lane&3)*8+(4*hi+((lane&15)>>2))*64;
  const char*Kbase=shm+LDS_K; bf16x8 kf[8];
  const lds_cptr shm3=(lds_cptr)shm; const lds_cptr kp0=shm3+LDS_K+hi*1024+r32*16; const lds_cptr vp0=shm3+LDS_V+((lane>>4)&1)*32+(lane&3)*8+(4*hi+((lane&15)>>2))*64;
  DMA_K(0,0);DMA_V(0,0);DMA_K(1,SLOTB);
  bf16x8 qr[4];
  #pragma unroll
  for(int d0=0;d0<4;++d0)qr[d0]=*reinterpret_cast<const bf16x8*>(&Qw[(long)r32*QP+d0*16+hi*8]);
  float mhat=0.f,l_reg=0.f;f32x16 o[2];o[0]=f32x16{};o[1]=f32x16{};f32x16 negm=f32x16{};asm volatile("":"+v"(negm));
  #define CMASK(P0,P1,t) do{}while(0)
  bool resc=false;
  #define START(P0,P1) do{ const float rm=rowmax(P0,P1); resc=false; \
    { const float dl=rm; mhat=fadd_s(mhat,dl); \
      _Pragma("unroll") for(int r=0;r<16;++r){P0[r]=fsub_s(P0[r],dl);P1[r]=fsub_s(P1[r],dl);} \
      _Pragma("unroll") for(int r=0;r<16;++r)negm[r]=-mhat; asm volatile("":"+v"(negm)); } \
    _Pragma("unroll") for(int r=0;r<16;++r)P0[r]=__builtin_amdgcn_exp2f(P0[r]); }while(0)
  #define RESC() do{ if(resc){ asm volatile("s_waitcnt lgkmcnt(0)":::"memory"); \
      _Pragma("unroll") for(int d_=0;d_<2;++d_) _Pragma("unroll") for(int r=0;r<16;++r)o[d_][r]*=wsf[crow(r,hi)]; } }while(0)
  f32x16 pA0,pA1,pB0,pB1;
  int sl_prev=0,sl_cur=0,sl_next=SLOTB;
  #define ROT() do{sl_prev=sl_cur;sl_cur=sl_next;sl_next=(sl_next==(NSLOT-1)*SLOTB)?0:sl_next+SLOTB;}while(0)
  DMA_K(2,2*SLOTB);
  WAIT_BAR(3);
  qkt(pA0,pA1,Kbase,qr,negm,r32,hi);asm volatile("s_nop 15\n\ts_nop 7":"+v"(pA0),"+v"(pA1));CMASK(pA0,pA1,0);
  START(pA0,pA1);
  _Pragma("unroll") for(int r=0;r<16;++r)pA1[r]=__builtin_amdgcn_exp2f(pA1[r]);
  WAIT_BAR(0);
  DMA_K(3,0);DMA_V(1,SLOTB);
  ROT();
  kload8(kf,kp0+sl_cur);
  WAIT_BAR(2);
  s16x4 vlo[8],vhi[8]; u32x4 pw0,pw1,pw2,pw3;
  #define PKW(P,B) cvtpk_s(P[B],P[B+1])
  #define PAF(k) __builtin_bit_cast(bf16x8,pw##k)
  #define VFR(i) (bf16x8){vlo[i][0],vlo[i][1],vlo[i][2],vlo[i][3],vhi[i][0],vhi[i][1],vhi[i][2],vhi[i][3]}
  #define PIN(x) asm volatile("":"+v"(x))
  #define MX3(a,b,c) __builtin_fmaxf(__builtin_fmaxf((a),(b)),(c))
  #define GAPA(MF,A0,A1,A2,A3,W0,W1,PW) do{ MF; sacc+=A0; sacc+=A1; sacc+=A2; sacc+=A3; PIN(sacc); W0; W1; PIN(PW); SBAR(); }while(0)
  #define EX(v) __builtin_amdgcn_exp2f(v)
  #define GAPB(MF,X,B) do{ MF; X[B]=EX(X[B]); X[B+1]=EX(X[B+1]); X[B+2]=EX(X[B+2]); X[B+3]=EX(X[B+3]); PIN(X); SBAR(); }while(0)
  #define VRD(i) do{ vlo[i]=vtr(vp_+(((i)>>2)*4096+((i)&3)*1024)); vhi[i]=vtr(vp_+(((i)>>2)*4096+((i)&3)*1024+512)); }while(0)
  #define KRD(G,j) do{ if(G){ kload2(kf,kp0+sl_next,j); SBAR(); } }while(0)
  #define STEP(C0,C1,P0,P1,t,GK,GV,GL) do{ SBAR(); \
    const lds_cptr vp_=vp0+sl_prev; \
    VRD(0); SBAR(); float sacc=(P0[0]+P0[1]); \
    GAPA(C0=__builtin_amdgcn_mfma_f32_32x32x16_bf16(kf[0],qr[0],negm,0,0,0), P0[2],P0[3],P0[4],P0[5],     pw0[0]=PKW(P0,0), pw0[1]=PKW(P0,2), pw0); \
    VRD(4); SBAR(); GAPA(C1=__builtin_amdgcn_mfma_f32_32x32x16_bf16(kf[1],qr[0],negm,0,0,0), P0[6],P0[7],P0[8],P0[9],     pw0[2]=PKW(P0,4), pw0[3]=PKW(P0,6), pw0); \
    VRD(1); SBAR(); GAPA(C0=__builtin_amdgcn_mfma_f32_32x32x16_bf16(kf[2],qr[1],C0,0,0,0),   P0[10],P0[11],P0[12],P0[13], pw1[0]=PKW(P0,8), pw1[1]=PKW(P0,10), pw1); \
    VRD(5); SBAR(); GAPA(C1=__builtin_amdgcn_mfma_f32_32x32x16_bf16(kf[3],qr[1],C1,0,0,0),   P0[14],P0[15],P1[0],P1[1],   pw1[2]=PKW(P0,12),pw1[3]=PKW(P0,14), pw1); \
    VRD(2); SBAR(); GAPA(C0=__builtin_amdgcn_mfma_f32_32x32x16_bf16(kf[4],qr[2],C0,0,0,0),   P1[2],P1[3],P1[4],P1[5],     pw2[0]=PKW(P1,0), pw2[1]=PKW(P1,2), pw2); \
    VRD(6); SBAR(); GAPA(C1=__builtin_amdgcn_mfma_f32_32x32x16_bf16(kf[5],qr[2],C1,0,0,0),   P1[6],P1[7],P1[8],P1[9],     pw2[2]=PKW(P1,4), pw2[3]=PKW(P1,6), pw2); \
    VRD(3); SBAR(); GAPA(C0=__builtin_amdgcn_mfma_f32_32x32x16_bf16(kf[6],qr[3],C0,0,0,0),   P1[10],P1[11],P1[12],P1[13], pw3[0]=PKW(P1,8), pw3[1]=PKW(P1,10), pw3); \
    VRD(7); SBAR(); GAPA(C1=__builtin_amdgcn_mfma_f32_32x32x16_bf16(kf[7],qr[3],C1,0,0,0),   P1[14],P1[15],0.f,0.f,       pw3[2]=PKW(P1,12),pw3[3]=PKW(P1,14), pw3); \
    l_reg+=sacc; \
    if(GK){DMA_K((t)+3,sl_cur);} if(GV){DMA_V((t)+1,sl_next);} \
    CMASK(C0,C1,t); \
    { float a=MX3(C0[0],C0[1],C1[0]),b=MX3(C0[2],C0[3],C1[1]); a=MX3(a,C1[2],C1[3]); \
      _Pragma("unroll") for(int r=4;r<16;r+=4){a=MX3(a,C0[r],C0[r+1]);b=MX3(b,C0[r+2],C0[r+3]);a=MX3(a,C1[r],C1[r+1]);b=MX3(b,C1[r+2],C1[r+3]);} \
      float rm=__builtin_fmaxf(a,b); { auto rr=__builtin_amdgcn_permlane32_swap(__float_as_uint(rm),__float_as_uint(rm),false,false); rm=__builtin_fmaxf(__uint_as_float(rr[0]),__uint_as_float(rr[1])); } \
      resc=false; \
      if(__builtin_expect(__any(rm>(float)THRL),0)){ const float dl=__builtin_fmaxf(rm,0.f); mhat+=dl; \
        _Pragma("unroll") for(int r=0;r<16;++r){C0[r]-=dl;C1[r]-=dl;} \
        _Pragma("unroll") for(int r=0;r<16;++r)negm[r]=-mhat; asm volatile("":"+v"(negm)); \
        const float f=__builtin_amdgcn_exp2f(-dl); l_reg*=f; if(hi==0)wsf[r32]=f; resc=true; } } \
    SBAR(); \
    GAPB(o[0]=__builtin_amdgcn_mfma_f32_32x32x16_bf16(PAF(0),VFR(0),o[0],0,0,0), C0,0); \
    GAPB(o[1]=__builtin_amdgcn_mfma_f32_32x32x16_bf16(PAF(0),VFR(4),o[1],0,0,0), C0,4); \
    KRD(GL,0); GAPB(o[0]=__builtin_amdgcn_mfma_f32_32x32x16_bf16(PAF(1),VFR(1),o[0],0,0,0), C0,8); \
    KRD(GL,1); GAPB(o[1]=__builtin_amdgcn_mfma_f32_32x32x16_bf16(PAF(1),VFR(5),o[1],0,0,0), C0,12); \
    KRD(GL,2); GAPB(o[0]=__builtin_amdgcn_mfma_f32_32x32x16_bf16(PAF(2),VFR(2),o[0],0,0,0), C1,0); \
    KRD(GL,3); GAPB(o[1]=__builtin_amdgcn_mfma_f32_32x32x16_bf16(PAF(2),VFR(6),o[1],0,0,0), C1,4); \
    GAPB(o[0]=__builtin_amdgcn_mfma_f32_32x32x16_bf16(PAF(3),VFR(3),o[0],0,0,0), C1,8); \
    GAPB(o[1]=__builtin_amdgcn_mfma_f32_32x32x16_bf16(PAF(3),VFR(7),o[1],0,0,0), C1,12); \
    }while(0)
  int t=1;
  #undef CMASK
  #define CMASK(P0,P1,t) do{}while(0)
  for(;t+5<NT;t+=2){
    STEP(pB0,pB1,pA0,pA1,t,true,true,true);     WAIT_BAR(2); RESC(); ROT();
    STEP(pA0,pA1,pB0,pB1,t+1,true,true,true);   WAIT_BAR(2); RESC(); ROT();
  }
  #undef CMASK
  #define CMASK(P0,P1,t) do{}while(0)
  #define ENDW(tt) do{ if((tt)+3<NT){WAIT_BAR(2);} else if((tt)+2<NT){WAIT_BAR(1);} else {WAIT_BAR(0);} }while(0)
  for(;t+1<NT;t+=2){
    STEP(pB0,pB1,pA0,pA1,t,(t+3<NT),(t+1<NT),(t+1<NT));       ENDW(t);   RESC(); ROT();
    STEP(pA0,pA1,pB0,pB1,t+1,(t+4<NT),(t+2<NT),(t+2<NT));     ENDW(t+1); RESC(); ROT();
  }
  STEP(pB0,pB1,pA0,pA1,NT-1,false,false,false); RESC();
  { float sacc=pB0[0]+pB0[1]; _Pragma("unroll") for(int r=2;r<16;++r)sacc+=pB0[r]; _Pragma("unroll") for(int r=0;r<16;++r)sacc+=pB1[r]; l_reg+=sacc;
    pw0=(u32x4){PKW(pB0,0),PKW(pB0,2),PKW(pB0,4),PKW(pB0,6)};pw1=(u32x4){PKW(pB0,8),PKW(pB0,10),PKW(pB0,12),PKW(pB0,14)};pw2=(u32x4){PKW(pB1,0),PKW(pB1,2),PKW(pB1,4),PKW(pB1,6)};pw3=(u32x4){PKW(pB1,8),PKW(pB1,10),PKW(pB1,12),PKW(pB1,14)};
    SBAR(); pv(o,vb0+sl_cur,PAF(0),PAF(1),PAF(2),PAF(3)); }
  #undef PKW
  #undef PAF
  #undef VFR
  #undef PIN
  #undef MX3
  #undef GAPA
  #undef GAPB
  #undef EX
  #undef VRD
  #undef KRD
  #undef STEP
  #undef ENDW
  u32x4 gpre[4];
  { const bf16*Gw0=Gb+(long)(wid*QBLK)*QP;
    #pragma unroll
    for(int i=0;i<4;++i)gpre[i]=*(const u32x4*)(Gw0+(long)(i*8+(lane>>3))*QP+(lane&7)*8); }
  {auto rr=__builtin_amdgcn_permlane32_swap(__float_as_uint(l_reg),__float_as_uint(l_reg),false,false);l_reg=__uint_as_float(rr[0])+__uint_as_float(rr[1]);}
  if(hi==0)wsf[32+r32]=l_reg;asm volatile("s_waitcnt lgkmcnt(0)":::"memory");
  float rli[16];
  #pragma unroll
  for(int r=0;r<16;++r)rli[r]=__builtin_amdgcn_rcpf(wsf[32+crow(r,hi)]);
  bf16*Ow=Ob+(long)(wid*QBLK)*QP; const bf16*Gw=Gb+(long)(wid*QBLK)*QP;
  { bf16*stg=(bf16*)(shm+LDS_OST)+wid*2048;
    #pragma unroll
    for(int r=0;r<16;++r){const int orow=crow(r,hi);
      #pragma unroll
      for(int d0=0;d0<2;++d0)stg[orow*64+d0*32+r32]=__float2bfloat16(o[d0][r]*rli[r]);}
    asm volatile("s_waitcnt lgkmcnt(0)":::"memory");
    #pragma unroll
    for(int i=0;i<4;++i){const int row=i*8+(lane>>3),ch=lane&7; const u32x4 v=*(const u32x4*)(stg+row*64+ch*8); const u32x4 g=gpre[i]; u32x4 w;
      #define GM(a,b) cvtpk_s(__uint_as_float((a)<<16)*__uint_as_float((b)<<16),__uint_as_float((a)&0xffff0000u)*__uint_as_float((b)&0xffff0000u))
      w.x=GM(v.x,g.x);w.y=GM(v.y,g.y);w.z=GM(v.z,g.z);w.w=GM(v.w,g.w);
      #undef GM
      ATTN_STORE16(Ow+(long)row*QP+ch*8,w);} }
  asm volatile("s_waitcnt lgkmcnt(0)\n\ts_barrier":::"memory");
  #undef DMA_K
  #undef DMA_V
  #undef CMASK
  #undef START
  #undef RESC
  #undef ROT
}
constexpr int ATTN_LDS_BYTES=LDS_BYTES;
#undef SBAR
#undef WAIT_BAR
}

__device__ __forceinline__ unsigned xb_ld(unsigned* p)              { return __hip_atomic_load(p, __ATOMIC_RELAXED, __HIP_MEMORY_SCOPE_AGENT); }
__device__ __forceinline__ unsigned xb_add(unsigned* p, unsigned v) { return __hip_atomic_fetch_add(p, v, __ATOMIC_RELAXED, __HIP_MEMORY_SCOPE_AGENT); }
#define XB_TMO      128
#define XB_XCNT(j)  (256  + 64 * (j))
#define XB_XSUB(j)  (1280 + 64 * (j))
#define XB_XGEN(j)  (2304 + 64 * (j))
#define XB_TOP      3328
#define XB_TOPGEN   3392
#define XCD_BAR_WORDS 3456
#define XB_SPIN_CAP (1u << 18)

__device__ __forceinline__ unsigned xb_xcc_id() { return (unsigned)__builtin_amdgcn_s_getreg((3 << 11) | 20) & 0xFu; }
#define XB_SPIN(cond, bar) do { unsigned _sp = 0; while (cond) { __builtin_amdgcn_s_sleep(1); \
    if ((++_sp & 255u) == 0u) { if (xb_ld(&(bar)[XB_TMO])) break; if (_sp > XB_SPIN_CAP) { atomicAdd(&(bar)[XB_TMO], 1u); break; } } } } while (0)

struct XcdBarrier {
    unsigned* bar; unsigned x;
    volatile LAS unsigned* st;
};

__device__ __forceinline__ XcdBarrier xcd_barrier_post(unsigned* bar, volatile LAS unsigned* st) {
    XcdBarrier b; b.bar = bar; b.x = xb_xcc_id(); b.st = st;
    if (threadIdx.x == 0) (void)xb_add(&bar[XB_XCNT(b.x)], 1u);
    return b;
}
__device__ __forceinline__ void xcd_barrier_complete(unsigned* bar, unsigned x, unsigned& nloc, unsigned& nx) {
    const unsigned G = gridDim.x * gridDim.y * gridDim.z;
    unsigned sum, cnt, mine, sp = 0u;
    for (;;) {
        sum = 0u; cnt = 0u; mine = 0u;
#pragma unroll
        for (unsigned j = 0; j < 16; ++j) { const unsigned c = xb_ld(&bar[XB_XCNT(j)]); sum += c; cnt += (c > 0u) ? 1u : 0u; mine = (j == x) ? c : mine; }
        if (sum == G) break;
        __builtin_amdgcn_s_sleep(1);
        if ((++sp & 255u) == 0u) { if (xb_ld(&bar[XB_TMO])) break; if (sp > XB_SPIN_CAP) { atomicAdd(&bar[XB_TMO], 1u); break; } }
    }
    nloc = mine > 0u ? mine : 1u; nx = cnt > 0u ? cnt : 1u;
}

__device__ __forceinline__ void xcd_barrier(const XcdBarrier& b) {
    asm volatile("s_waitcnt vmcnt(0)" ::: "memory");
    __syncthreads();
    if (threadIdx.x == 0) {
        unsigned* bar = b.bar;
        __builtin_amdgcn_s_waitcnt(0);
        unsigned nloc = b.st[0], nx = b.st[1];
        if (nloc == 0u) { xcd_barrier_complete(bar, b.x, nloc, nx); b.st[0] = nloc; b.st[1] = nx; }
        const unsigned old = xb_add(&bar[XB_XSUB(b.x)], 1u);
        const unsigned gen = old / nloc;
        if (old + 1u == (gen + 1u) * nloc) {
            __builtin_amdgcn_fence(__ATOMIC_RELEASE, "agent");
            asm volatile("s_waitcnt vmcnt(0)" ::: "memory");
            const unsigned og = xb_add(&bar[XB_TOP], 1u);
            const unsigned tg = og / nx;
            if (og + 1u == (tg + 1u) * nx) xb_add(&bar[XB_TOPGEN], 1u);
            else XB_SPIN(xb_ld(&bar[XB_TOPGEN]) == tg, bar);
            __builtin_amdgcn_fence(__ATOMIC_ACQUIRE, "agent");
            xb_add(&bar[XB_XGEN(b.x)], 1u);
            asm volatile("s_waitcnt vmcnt(0)" ::: "memory");
        } else {
            XB_SPIN(xb_ld(&bar[XB_XGEN(b.x)]) == gen, bar);
            __builtin_amdgcn_fence(__ATOMIC_ACQUIRE, "agent");
            asm volatile("s_waitcnt vmcnt(0)" ::: "memory");
        }
    }
    __syncthreads();
}

using pg8::Unit;
typedef f32x4 AccT[2][2][4][2];

struct EpiStore {
    const float* pscale;
    __device__ __forceinline__ void operator()(const AccT& acc, const Unit& u, int wr, int wc, int fr, int fq) const {
        asm volatile("" : "+v"(fr), "+v"(fq));
        bf16_t* base = (bf16_t*)u.O; const int ldc = u.ldc, kind = u.kind; const float sc = u.sc;
#pragma unroll
        for (int ai = 0; ai < 2; ++ai)
#pragma unroll
            for (int m = 0; m < 4; ++m) {
                bf16_t* rowp = base + (size_t)(ai * 128 + wr * 64 + m * 16 + fr) * ldc + wc * 32 + 8 * fq;
#pragma unroll
                for (int bj = 0; bj < 2; ++bj) {
                    f32x4 v0 = acc[ai][bj][m][0], v1 = acc[ai][bj][m][1];
                    if (kind == 1) {
#pragma unroll
                        for (int e = 0; e < 4; ++e) { v0[e] = siluf_(v0[e]); v1[e] = siluf_(v1[e]); }
                    } else if (kind == 2) { v0 = v0 * sc; v1 = v1 * sc; }
                    u32x4 w; w.x = pk2(v0[0], v0[1]); w.y = pk2(v0[2], v0[3]); w.z = pk2(v1[0], v1[1]); w.w = pk2(v1[2], v1[3]);
                    *(u32x4*)(rowp + bj * 128) = w;
                }
            }
    }
};
struct EpiGate {
    const float* bmerge; char* scr;
    __device__ __forceinline__ void operator()(const AccT& acc, const Unit& u, int wr, int wc, int fr, int fq) const {
        asm volatile("" : "+v"(fr), "+v"(fq));
        int tid = threadIdx.x; const int n = u.aux; asm volatile("" : "+v"(tid));
        u32x4* gst = (u32x4*)scr;
        if (u.kind == 0) {
            const float* bp = bmerge + n * 1024 + u.c0 + wc * 32 + 8 * fq;
            f32x4 bb[2][2];
#pragma unroll
            for (int bj = 0; bj < 2; ++bj) { bb[bj][0] = *(const f32x4*)(bp + bj * 128); bb[bj][1] = *(const f32x4*)(bp + bj * 128 + 4); }
#pragma unroll
            for (int bj = 0; bj < 2; ++bj) {
#pragma unroll
                for (int ai = 0; ai < 2; ++ai)
#pragma unroll
                    for (int m = 0; m < 4; ++m) {
                        const f32x4 v0 = (acc[ai][bj][m][0] + bb[bj][0]) * (-LOG2E), v1 = (acc[ai][bj][m][1] + bb[bj][1]) * (-LOG2E);
                        u32x4 w; w.x = pk2(__builtin_amdgcn_exp2f(v0[0]), __builtin_amdgcn_exp2f(v0[1])); w.y = pk2(__builtin_amdgcn_exp2f(v0[2]), __builtin_amdgcn_exp2f(v0[3]));
                        w.z = pk2(__builtin_amdgcn_exp2f(v1[0]), __builtin_amdgcn_exp2f(v1[1])); w.w = pk2(__builtin_amdgcn_exp2f(v1[2]), __builtin_amdgcn_exp2f(v1[3]));
                        gst[((ai * 2 + bj) * 4 + m) * 512 + tid] = w;
                    }
                asm volatile("" ::: "memory");
            }
        } else {
            bf16_t* base = (bf16_t*)u.O;
            u32x4* mst = (u32x4*)(scr + 131072);
#pragma unroll
            for (int ai = 0; ai < 2; ++ai) {
                u32x4 g[8], pm[8];
#pragma unroll
                for (int e = 0; e < 8; ++e) { const int si = (ai * 2 + (e & 1)) * 4 + (e >> 1); g[e] = gst[si * 512 + tid]; if (n > 0) pm[e] = mst[si * 512 + tid]; }
#pragma unroll
                for (int e = 0; e < 8; ++e) {
                    const int bj = e & 1, m = e >> 1, si = (ai * 2 + bj) * 4 + m;
                    f32x4 v0 = acc[ai][bj][m][0], v1 = acc[ai][bj][m][1];
#define GSIG(x_) fast_rcp(1.0f + (x_))
                    v0[0] *= GSIG(bflo(g[e].x)); v0[1] *= GSIG(bfhi(g[e].x)); v0[2] *= GSIG(bflo(g[e].y)); v0[3] *= GSIG(bfhi(g[e].y));
                    v1[0] *= GSIG(bflo(g[e].z)); v1[1] *= GSIG(bfhi(g[e].z)); v1[2] *= GSIG(bflo(g[e].w)); v1[3] *= GSIG(bfhi(g[e].w));
#undef GSIG
                    if (n > 0) { v0[0] += bflo(pm[e].x); v0[1] += bfhi(pm[e].x); v0[2] += bflo(pm[e].y); v0[3] += bfhi(pm[e].y);
                                 v1[0] += bflo(pm[e].z); v1[1] += bfhi(pm[e].z); v1[2] += bflo(pm[e].w); v1[3] += bfhi(pm[e].w); }
                    u32x4 w; w.x = pk2(v0[0], v0[1]); w.y = pk2(v0[2], v0[3]); w.z = pk2(v1[0], v1[1]); w.w = pk2(v1[2], v1[3]);
                    if (n < 2) mst[si * 512 + tid] = w;
                    else *(u32x4*)(base + (size_t)(ai * 128 + wr * 64 + m * 16 + fr) * 1024 + wc * 32 + 8 * fq + bj * 128) = w;
                }
                asm volatile("" ::: "memory");
            }
        }
    }
};
struct EpiOut {
    float* ss; unsigned* cnt; const float* xp; const float* xs; const float* gpost; float* out;
    __device__ __forceinline__ void operator()(const AccT& acc, const Unit& u, int wr, int wc, int fr, int fq) const {
        asm volatile("" : "+v"(fr), "+v"(fq));
        const int pm = u.r0 >> 8;
        const float* xb = (u.r0 < T_P) ? xp + (size_t)u.r0 * DM : xs + (size_t)(u.r0 - T_P) * DM;
        float* ob = out + (size_t)u.r0 * DM;
        const int colb = u.c0 + wc * 32 + 8 * fq;
        f32x4 gg[2][2], xv[4][2][2];
#pragma unroll
        for (int bj = 0; bj < 2; ++bj) { gg[bj][0] = *(const f32x4*)(gpost + colb + bj * 128); gg[bj][1] = *(const f32x4*)(gpost + colb + bj * 128 + 4); }
#pragma unroll
        for (int m = 0; m < 4; ++m) { const int row = wr * 64 + m * 16 + fr;
#pragma unroll
            for (int bj = 0; bj < 2; ++bj) { const size_t off = (size_t)row * DM + colb + bj * 128; xv[m][bj][0] = *(const f32x4*)(xb + off); xv[m][bj][1] = *(const f32x4*)(xb + off + 4); } }
#pragma unroll
        for (int ai = 0; ai < 2; ++ai)
#pragma unroll
            for (int m = 0; m < 4; ++m) {
                float s = 0.f;
#pragma unroll
                for (int bj = 0; bj < 2; ++bj) {
                    const f32x4 v0 = acc[ai][bj][m][0], v1 = acc[ai][bj][m][1];
                    s += (v0[0] * v0[0] + v0[1] * v0[1]) + (v0[2] * v0[2] + v0[3] * v0[3]) + (v1[0] * v1[0] + v1[1] * v1[1]) + (v1[2] * v1[2] + v1[3] * v1[3]);
                }
                s += __shfl_xor(s, 16); s += __shfl_xor(s, 32);
                if (fq == 0) __hip_atomic_fetch_add(ss + u.r0 + ai * 128 + wr * 64 + m * 16 + fr, s, __ATOMIC_RELAXED, __HIP_MEMORY_SCOPE_AGENT);
            }
        asm volatile("s_waitcnt vmcnt(0)" ::: "memory");
        __builtin_amdgcn_s_barrier();
        if (threadIdx.x == 0) __hip_atomic_fetch_add(cnt + pm, 1u, __ATOMIC_RELAXED, __HIP_MEMORY_SCOPE_AGENT);
        { unsigned sp = 0;
          while ((unsigned)__builtin_amdgcn_readfirstlane(__hip_atomic_load(cnt + pm, __ATOMIC_RELAXED, __HIP_MEMORY_SCOPE_AGENT)) < 4u && sp < (1u << 22)) { __builtin_amdgcn_s_sleep(2); ++sp; } }
        asm volatile("" ::: "memory");
        float sv[2][4];
#pragma unroll
        for (int ai = 0; ai < 2; ++ai)
#pragma unroll
            for (int m = 0; m < 4; ++m) sv[ai][m] = __hip_atomic_load(ss + u.r0 + ai * 128 + wr * 64 + m * 16 + fr, __ATOMIC_RELAXED, __HIP_MEMORY_SCOPE_AGENT);
#pragma unroll
        for (int ai = 0; ai < 2; ++ai) {
            if (ai == 1) {
#pragma unroll
                for (int m = 0; m < 4; ++m) { const int row = 128 + wr * 64 + m * 16 + fr;
#pragma unroll
                    for (int bj = 0; bj < 2; ++bj) { const size_t off = (size_t)row * DM + colb + bj * 128; xv[m][bj][0] = *(const f32x4*)(xb + off); xv[m][bj][1] = *(const f32x4*)(xb + off + 4); } }
            }
#pragma unroll
            for (int m = 0; m < 4; ++m) { const int row = ai * 128 + wr * 64 + m * 16 + fr;
                const float rinv = 1.0f / sqrtf(sv[ai][m] * (1.f / 1024.f) + EPS);
#pragma unroll
                for (int bj = 0; bj < 2; ++bj) { const size_t off = (size_t)row * DM + colb + bj * 128;
                    *(f32x4*)(ob + off) = xv[m][bj][0] + acc[ai][bj][m][0] * rinv * gg[bj][0];
                    *(f32x4*)(ob + off + 4) = xv[m][bj][1] + acc[ai][bj][m][1] * rinv * gg[bj][1]; } }
            asm volatile("" ::: "memory");
        }
    }
};

struct Ptrs {
    unsigned char* ws;
    __device__ __forceinline__ char* at(size_t off) const { return (char*)ws + off; }
};
struct SchedP1 {
    Ptrs P; int G, c;
    __device__ __forceinline__ bool next(int i, Unit& u) const {
        const int L = i * G + c; constexpr int N1 = 320 * 13, N2 = 18 * 4;
        if (L >= N1 + N2) return false;
        u.nt = 16; u.aux = 0; u.sc = 1.f;
        if (L < N1) {
            int pm, pn; pg8::tile_order(L, 320, 13, pm, pn);
            u.A = P.at(WS_XN) + (size_t)pm * 256 * 2048; u.B = P.at(WS_WIN) + (size_t)pn * 256 * 2048; u.r0 = pm * 256;
            size_t dst; int col, ldc = 1024, kind = 0;
            if (pn < 2) { dst = WS_ZA; col = pn * 256; }
            else if (pn < 4) { dst = WS_ZA; col = 512 + (pn - 2) * 256; kind = 1; }
            else if (pn < 6) { dst = WS_ZB; col = (pn - 4) * 256; }
            else if (pn == 6) { dst = WS_ZD; col = 0; ldc = 256; }
            else if (pn < 9) { dst = WS_ZB; col = 512 + (pn - 7) * 256; kind = 1; }
            else if (pn < 11) { dst = WS_ZC; col = (pn - 9) * 256; kind = 2; u.sc = C2_CROSS; }
            else { dst = WS_ZC; col = 512 + (pn - 11) * 256; kind = 1; }
            u.kind = kind; u.ldc = ldc; u.c0 = col; u.O = P.at(dst) + ((size_t)pm * 256 * ldc + col) * 2;
        } else {
            const int l = L - N1, pm = l >> 2, pn = l & 3;
            u.A = P.at(WS_MEMN) + (size_t)pm * 256 * 2048; u.B = P.at(WS_WMKV) + (size_t)pn * 256 * 2048; u.r0 = pm * 256; u.c0 = pn * 256;
            u.kind = 0; u.ldc = 1024; u.O = P.at(WS_MKV) + ((size_t)pm * 256 * 1024 + pn * 256) * 2;
        }
        return true;
    }
};
struct SchedMerge {
    Ptrs P; int G, c;
    __device__ __forceinline__ bool next(int i, Unit& u) const {
        const int ti = i / 6, sub = i - ti * 6; const int L = ti * G + c; if (L >= 1280) return false;
        int pm, pn; pg8::tile_order(L, 320, 4, pm, pn);
        const int n = sub >> 1; u.aux = n; u.r0 = pm * 256; u.c0 = pn * 256; u.ldc = 1024; u.sc = 1.f;
        u.O = P.at(WS_ZA) + ((size_t)pm * 256 * 1024 + pn * 256) * 2;
        if ((sub & 1) == 0) { u.kind = 0; u.nt = 16; u.A = P.at(WS_XN) + (size_t)pm * 256 * 2048; u.B = P.at(WS_WIN) + (size_t)(ZW + n * 1024 + pn * 256) * 2048; }
        else { u.kind = 1; u.nt = 8;
            u.A = P.at(n == 0 ? WS_MIX : (n == 1 ? WS_ZB : WS_ZC)) + (size_t)pm * 256 * 2048;
            u.B = P.at(n < 2 ? WS_WB01 : WS_WB2P) + ((size_t)pn * 256 * 1024 + (n == 1 ? 512 : 0)) * 2; }
        return true;
    }
};
struct SchedOut {
    Ptrs P; int G, c;
    __device__ __forceinline__ bool next(int i, Unit& u) const {
        const int L = i * G + c; if (L >= 1280) return false;
        int pm, pn; pg8::tile_order(L, 320, 4, pm, pn);
        u.A = P.at(WS_ZA) + (size_t)pm * 256 * 2048; u.B = P.at(WS_WOUT) + (size_t)pn * 256 * 2048;
        u.nt = 16; u.kind = 0; u.r0 = pm * 256; u.c0 = pn * 256; u.aux = 0; u.ldc = 1024; u.sc = 1.f;
        u.O = P.at(WS_XN) + ((size_t)pm * 256 * 1024 + pn * 256) * 2;
        return true;
    }
};

__device__ __forceinline__ void cross_attn_phase(bf16_t* ZC, const bf16_t* MKV, LAS unsigned char* lds, int vcu, int G) {
    constexpr int D = 128, KPL = 136, VPL = 260;
    const int tid = threadIdx.x, lane = tid & 63, r32 = lane & 31, hi = lane >> 5; const int wid = __builtin_amdgcn_readfirstlane(tid >> 6);
    LAS bf16_t* Ks = (LAS bf16_t*)lds;
    LAS bf16_t* Vt = (LAS bf16_t*)(lds + 256 * KPL * 2);
    LAS float* wsf = (LAS float*)(lds + 256 * KPL * 2 + D * VPL * 2) + wid * 32;
    const int i_lo = (int)((long)vcu * 1280 / G), i_hi = (int)((long)(vcu + 1) * 1280 / G);
    int loaded = -1;
    for (int I = i_lo; I < i_hi; ++I) {
        int bh, qt, row0;
        if (I < 256) { bh = I >> 5; qt = I & 31; row0 = (bh >> 2) * L_P + qt * 256; }
        else { const int J = I - 256; bh = 8 + (J >> 4); qt = J & 15; row0 = T_P + ((bh >> 2) - 2) * L_S + qt * 256; }
        const int b = bh >> 2, h = bh & 3;
        if (bh != loaded) {
            __syncthreads();
            const bf16_t* Kg = MKV + (size_t)b * NMEM * 1024 + h * 128; const bf16_t* Vg = Kg + 512;
#pragma unroll
            for (int c = 0; c < 8; ++c) { const int idx = tid + c * 512, key = idx >> 4, ch = idx & 15;
                const u32x4 kv = *(const u32x4*)(Kg + (size_t)key * 1024 + ch * 8), vv = *(const u32x4*)(Vg + (size_t)key * 1024 + ch * 8);
                *(LAS u32x4*)(Ks + key * KPL + ch * 8) = kv;
                const unsigned w[4] = {vv.x, vv.y, vv.z, vv.w};
#pragma unroll
                for (int j = 0; j < 4; ++j) { Vt[(ch * 8 + 2 * j) * VPL + key] = (bf16_t)(w[j] & 0xffffu); Vt[(ch * 8 + 2 * j + 1) * VPL + key] = (bf16_t)(w[j] >> 16); } }
            __syncthreads();
            loaded = bh;
        }
        bf16_t* Q = ZC + (size_t)(row0 + wid * 32) * 1024 + h * 128;
        bf16x8 qf[D / 16];
#pragma unroll
        for (int d0 = 0; d0 < D / 16; ++d0) qf[d0] = *(const bf16x8*)(Q + (size_t)r32 * 1024 + d0 * 16 + hi * 8);
        f32x16 o[D / 32];
#pragma unroll
        for (int dt = 0; dt < D / 32; ++dt)
#pragma unroll
            for (int r = 0; r < 16; ++r) o[dt][r] = 0.f;
        float m_run = -1e30f, l_run = 0.f;
#pragma unroll 1
        for (int kt = 0; kt < 4; ++kt) {
            f32x16 s0, s1;
#pragma unroll
            for (int r = 0; r < 16; ++r) { s0[r] = 0.f; s1[r] = 0.f; }
#pragma unroll
            for (int d0 = 0; d0 < D / 16; ++d0) {
                const bf16x8 a0 = *(const LAS bf16x8*)(Ks + (kt * 64 + r32) * KPL + d0 * 16 + hi * 8);
                const bf16x8 a1 = *(const LAS bf16x8*)(Ks + (kt * 64 + 32 + r32) * KPL + d0 * 16 + hi * 8);
                s0 = __builtin_amdgcn_mfma_f32_32x32x16_bf16(a0, qf[d0], s0, 0, 0, 0);
                s1 = __builtin_amdgcn_mfma_f32_32x32x16_bf16(a1, qf[d0], s1, 0, 0, 0);
            }
            float mx = s0[0];
#pragma unroll
            for (int r = 0; r < 16; ++r) { mx = fmaxf(mx, s0[r]); mx = fmaxf(mx, s1[r]); }
            mx = fmaxf(mx, __shfl_xor(mx, 32));
            const float m_new = fmaxf(m_run, mx);
            const float alpha = __builtin_amdgcn_exp2f(m_run - m_new);
            m_run = m_new;
            float rs = 0.f;
#pragma unroll
            for (int r = 0; r < 16; ++r) { s0[r] = __builtin_amdgcn_exp2f(s0[r] - m_new); s1[r] = __builtin_amdgcn_exp2f(s1[r] - m_new); rs += s0[r] + s1[r]; }
            l_run = l_run * alpha + rs;
            if (kt > 0) {
                __builtin_amdgcn_wave_barrier();
                if (hi == 0) wsf[r32] = alpha;
                __builtin_amdgcn_fence(__ATOMIC_RELEASE, "wavefront"); __builtin_amdgcn_wave_barrier(); __builtin_amdgcn_fence(__ATOMIC_ACQUIRE, "wavefront");
#pragma unroll
                for (int r = 0; r < 16; ++r) { const float a = wsf[crow(r, hi)];
#pragma unroll
                    for (int dt = 0; dt < D / 32; ++dt) o[dt][r] *= a; }
            }
            bf16x8 pw[4];
            { u32x4 p;
              p.x = pk2(s0[0], s0[1]); p.y = pk2(s0[2], s0[3]); p.z = pk2(s0[4], s0[5]); p.w = pk2(s0[6], s0[7]); pw[0] = __builtin_bit_cast(bf16x8, p);
              p.x = pk2(s0[8], s0[9]); p.y = pk2(s0[10], s0[11]); p.z = pk2(s0[12], s0[13]); p.w = pk2(s0[14], s0[15]); pw[1] = __builtin_bit_cast(bf16x8, p);
              p.x = pk2(s1[0], s1[1]); p.y = pk2(s1[2], s1[3]); p.z = pk2(s1[4], s1[5]); p.w = pk2(s1[6], s1[7]); pw[2] = __builtin_bit_cast(bf16x8, p);
              p.x = pk2(s1[8], s1[9]); p.y = pk2(s1[10], s1[11]); p.z = pk2(s1[12], s1[13]); p.w = pk2(s1[14], s1[15]); pw[3] = __builtin_bit_cast(bf16x8, p); }
#pragma unroll
            for (int dt = 0; dt < D / 32; ++dt)
#pragma unroll
                for (int ks = 0; ks < 4; ++ks) {
                    const LAS bf16_t* vp = Vt + (dt * 32 + r32) * VPL + kt * 64 + 16 * ks + 4 * hi;
                    const s16x4 lo = *(const LAS s16x4*)vp, hh = *(const LAS s16x4*)(vp + 8);
                    const bf16x8 bb = __builtin_shufflevector(lo, hh, 0, 1, 2, 3, 4, 5, 6, 7);
                    o[dt] = __builtin_amdgcn_mfma_f32_32x32x16_bf16(pw[ks], bb, o[dt], 0, 0, 0);
                }
        }
        l_run += __shfl_xor(l_run, 32);
        __builtin_amdgcn_wave_barrier();
        if (hi == 0) wsf[r32] = fast_rcp(l_run);
        __builtin_amdgcn_fence(__ATOMIC_RELEASE, "wavefront"); __builtin_amdgcn_wave_barrier(); __builtin_amdgcn_fence(__ATOMIC_ACQUIRE, "wavefront");
#pragma unroll
        for (int r = 0; r < 16; ++r) {
            const int row = crow(r, hi); const float inv = wsf[row];
#pragma unroll
            for (int dt = 0; dt < D / 32; ++dt) {
                const int col = dt * 32 + r32;
                const float g = __builtin_bit_cast(float, (unsigned)Q[(size_t)row * 1024 + 512 + col] << 16);
                Q[(size_t)row * 1024 + col] = (bf16_t)f2bf(o[dt][r] * inv * g);
            }
        }
        __builtin_amdgcn_wave_barrier();
    }
    __syncthreads();
}

__device__ __forceinline__ void transpose_item(const float* W, int ldw, int nblk, bf16_t* WT, LAS float* scr, int item, int lane) {
    const int kb = item / nblk, nb = item % nblk, k0 = 64 * kb, n0 = 32 * nb;
#pragma unroll 8
    for (int i = 0; i < 32; ++i) { const int kk = 2 * i + (lane >> 5); scr[kk * 33 + (lane & 31)] = W[(size_t)(k0 + kk) * ldw + n0 + (lane & 31)]; }
    asm volatile("s_waitcnt lgkmcnt(0)" ::: "memory");
    const int c = lane & 7;
#pragma unroll
    for (int j = 0; j < 4; ++j) { const int n = (lane >> 3) + 8 * j; const LAS float* s = scr + (8 * c) * 33 + n;
        u32x4 o; o.x = pk2(s[0 * 33], s[1 * 33]); o.y = pk2(s[2 * 33], s[3 * 33]); o.z = pk2(s[4 * 33], s[5 * 33]); o.w = pk2(s[6 * 33], s[7 * 33]);
        *(u32x4*)(WT + (size_t)(n0 + n) * 1024 + k0 + 8 * c) = o; }
    asm volatile("s_waitcnt lgkmcnt(0)" ::: "memory");
}
__device__ __forceinline__ void rms_row_to_bf16(const float* xrow, const float* g, bf16_t* orow, int lane) {
    const f32x4* xr = (const f32x4*)xrow + lane; const f32x4* gr = (const f32x4*)g + lane;
    f32x4 v[4]; float s = 0.f;
#pragma unroll
    for (int j = 0; j < 4; ++j) { v[j] = xr[64 * j]; s += (v[j].x * v[j].x + v[j].y * v[j].y) + (v[j].z * v[j].z + v[j].w * v[j].w); }
    const float rinv = 1.0f / sqrtf(wave_sum(s) * (1.f / 1024.f) + EPS);
    u32x2* o8 = (u32x2*)orow + lane;
#pragma unroll
    for (int j = 0; j < 4; ++j) { const f32x4 gg = gr[64 * j]; u32x2 w; w.x = pk2(v[j].x * rinv * gg.x, v[j].y * rinv * gg.y); w.y = pk2(v[j].z * rinv * gg.z, v[j].w * rinv * gg.w); o8[64 * j] = w; }
}

__device__ __forceinline__ void rms_row2_to_bf16(const float* xa, const float* xb, const float* g, bf16_t* oa, bf16_t* ob, int lane) {
    const f32x4* ra = (const f32x4*)xa + lane; const f32x4* rb = (const f32x4*)xb + lane; const f32x4* gr = (const f32x4*)g + lane;
    f32x4 va[4], vb[4]; float sa = 0.f, sb = 0.f;
#pragma unroll
    for (int j = 0; j < 4; ++j) { va[j] = ra[64 * j]; vb[j] = rb[64 * j]; }
#pragma unroll
    for (int j = 0; j < 4; ++j) { sa += (va[j].x * va[j].x + va[j].y * va[j].y) + (va[j].z * va[j].z + va[j].w * va[j].w); sb += (vb[j].x * vb[j].x + vb[j].y * vb[j].y) + (vb[j].z * vb[j].z + vb[j].w * vb[j].w); }
#pragma unroll
    for (int o = 1; o < 64; o <<= 1) { sa += __shfl_xor(sa, o); sb += __shfl_xor(sb, o); }
    const float ia = 1.0f / sqrtf(sa * (1.f / 1024.f) + EPS), ib = 1.0f / sqrtf(sb * (1.f / 1024.f) + EPS);
    u32x2* pa = (u32x2*)oa + lane; u32x2* pb = (u32x2*)ob + lane;
#pragma unroll
    for (int j = 0; j < 4; ++j) { const f32x4 gg = gr[64 * j]; u32x2 w;
        w.x = pk2(va[j].x * ia * gg.x, va[j].y * ia * gg.y); w.y = pk2(va[j].z * ia * gg.z, va[j].w * ia * gg.w); pa[64 * j] = w;
        w.x = pk2(vb[j].x * ib * gg.x, vb[j].y * ib * gg.y); w.y = pk2(vb[j].z * ib * gg.z, vb[j].w * ib * gg.w); pb[64 * j] = w; }
}

__device__ __forceinline__ void rms_row4_to_bf16(const float* x0, const float* x1, const float* x2, const float* x3, const float* g, bf16_t* o0, bf16_t* o1, bf16_t* o2, bf16_t* o3, int lane) {
    const f32x4* r[4] = {(const f32x4*)x0 + lane, (const f32x4*)x1 + lane, (const f32x4*)x2 + lane, (const f32x4*)x3 + lane}; const f32x4* gr = (const f32x4*)g + lane;
    u32x2* po[4] = {(u32x2*)o0 + lane, (u32x2*)o1 + lane, (u32x2*)o2 + lane, (u32x2*)o3 + lane};
    f32x4 v[4][4]; float sq[4] = {0.f, 0.f, 0.f, 0.f};
#pragma unroll
    for (int q = 0; q < 4; ++q)
#pragma unroll
        for (int j = 0; j < 4; ++j) v[q][j] = __builtin_nontemporal_load(r[q] + 64 * j);
#pragma unroll
    for (int q = 0; q < 4; ++q)
#pragma unroll
        for (int j = 0; j < 4; ++j) sq[q] += (v[q][j].x * v[q][j].x + v[q][j].y * v[q][j].y) + (v[q][j].z * v[q][j].z + v[q][j].w * v[q][j].w);
#pragma unroll
    for (int o = 1; o < 64; o <<= 1) { sq[0] += __shfl_xor(sq[0], o); sq[1] += __shfl_xor(sq[1], o); sq[2] += __shfl_xor(sq[2], o); sq[3] += __shfl_xor(sq[3], o); }
#pragma unroll
    for (int j = 0; j < 4; ++j) { const f32x4 gg = gr[64 * j];
#pragma unroll
        for (int q = 0; q < 4; ++q) { const float iv = 1.0f / sqrtf(sq[q] * (1.f / 1024.f) + EPS); u32x2 w;
            w.x = pk2(v[q][j].x * iv * gg.x, v[q][j].y * iv * gg.y); w.y = pk2(v[q][j].z * iv * gg.z, v[q][j].w * iv * gg.w); po[q][64 * j] = w; } }
}

struct Args { const float* in[16]; float* out; unsigned char* ws; };

__global__ void __launch_bounds__(512) fwd_megakernel(Args args) {
    extern __shared__ __attribute__((aligned(16))) unsigned char lds_raw[];
    LAS unsigned char* lds = (LAS unsigned char*)lds_raw;
    cg::grid_group grid = cg::this_grid();
    volatile LAS unsigned* xb_st = (volatile LAS unsigned*)(lds + LDS_BYTES - 16);
    if (threadIdx.x == 0) { xb_st[0] = 0u; xb_st[1] = 0u; }
    __syncthreads();
    const XcdBarrier xbar = xcd_barrier_post((unsigned*)(args.ws + WS_BAR), xb_st);
    const int tid = threadIdx.x, lane = tid & 63; const int wave = __builtin_amdgcn_readfirstlane(tid >> 6);
    const int G = gridDim.x, bx = blockIdx.x;
    const int vcu = (G % 8 == 0) ? (bx % 8) * (G / 8) + bx / 8 : bx;
    const int gw = vcu * NWAVES + wave, NGW = G * NWAVES;
    unsigned char* ws = args.ws; Ptrs P{ws};
    const float* x_prompt = args.in[0]; const float* x_sample = args.in[1]; const float* mem_prompt = args.in[2]; const float* mem_sample = args.in[3];
    const float* ln_pre = args.in[4]; const float* ln_post = args.in[5]; const float* ln_mem = args.in[6]; const float* w_in = args.in[7];
    const float* b_merge = args.in[8]; const float* q_norm = args.in[9]; const float* k_norm = args.in[10]; const float* w_pool = args.in[11];
    const float* pool_scale = args.in[12]; const float* w_mem_kv = args.in[13]; const float* w_branch = args.in[14]; const float* w_out = args.in[15];
    bf16_t* XN = (bf16_t*)(ws + WS_XN); bf16_t* ZA = (bf16_t*)(ws + WS_ZA); bf16_t* ZB = (bf16_t*)(ws + WS_ZB); bf16_t* ZC = (bf16_t*)(ws + WS_ZC);
    bf16_t* ZD = (bf16_t*)(ws + WS_ZD); bf16_t* MIX = (bf16_t*)(ws + WS_MIX); bf16_t* MEMN = (bf16_t*)(ws + WS_MEMN); bf16_t* MKV = (bf16_t*)(ws + WS_MKV);
    float* SS = (float*)(ws + WS_SS);

    {
        LAS float* scr = (LAS float*)(lds + wave * 16384);
        constexpr int I_IN = 16 * 184, I_SQ = 16 * 32, I_BR = 8 * 32;
        constexpr int NITEMS = I_IN + 2 * I_SQ + 3 * I_BR;
        for (int it = gw; it < NITEMS; it += NGW) {
            int r = it;
            if (r < I_IN) { transpose_item(w_in + 512, IN_DIM, 184, (bf16_t*)(ws + WS_WIN) + (size_t)512 * 1024, scr, r, lane); continue; } r -= I_IN;
            if (r < I_SQ) { transpose_item(w_mem_kv, 1024, 32, (bf16_t*)(ws + WS_WMKV), scr, r, lane); continue; } r -= I_SQ;
            if (r < I_SQ) { transpose_item(w_out, 1024, 32, (bf16_t*)(ws + WS_WOUT), scr, r, lane); continue; } r -= I_SQ;
            if (r < 3 * I_BR) { const int n = r / I_BR; r -= n * I_BR;
                transpose_item(w_branch + (size_t)n * 512 * 1024, 1024, 32, (bf16_t*)(ws + (n < 2 ? WS_WB01 : WS_WB2P)) + (n == 1 ? 512 : 0), scr, r, lane); continue; }
        }
        for (int it = NGW - 1 - gw; it < 128 * 4 * 2; it += NGW) {
            const int kb = it >> 3, g = (it >> 1) & 3, dh = it & 1, d = dh * 64 + lane;
            const float* wi = w_in + (size_t)(kb * 8) * IN_DIM + g * 128; const float* wp = w_pool + (size_t)g * 128 * 128 + d;
            float a8[8] = {0.f, 0.f, 0.f, 0.f, 0.f, 0.f, 0.f, 0.f};
#pragma unroll 4
            for (int c = 0; c < 128; ++c) { const float b = wp[(size_t)c * 128];
#pragma unroll
                for (int kk = 0; kk < 8; ++kk) a8[kk] += wi[(size_t)kk * IN_DIM + c] * b; }
            u32x4 o; o.x = pk2(a8[0], a8[1]); o.y = pk2(a8[2], a8[3]); o.z = pk2(a8[4], a8[5]); o.w = pk2(a8[6], a8[7]);
            *(u32x4*)((bf16_t*)(ws + WS_WIN) + (size_t)(g * 128 + d) * 1024 + kb * 8) = o;
        }
        for (int m = gw; m < T; m += 4 * NGW) {
            const float* xr[4]; int mr[4];
#pragma unroll
            for (int q = 0; q < 4; ++q) { const int mq = m + q * NGW; mr[q] = (mq < T) ? mq : m; xr[q] = (mr[q] < T_P) ? x_prompt + (size_t)mr[q] * DM : x_sample + (size_t)(mr[q] - T_P) * DM; }
            rms_row4_to_bf16(xr[0], xr[1], xr[2], xr[3], ln_pre, XN + (size_t)mr[0] * DM, XN + (size_t)mr[1] * DM, XN + (size_t)mr[2] * DM, XN + (size_t)mr[3] * DM, lane);
        }
        for (int m = gw; m < MEMROWS; m += NGW) { const float* xr = (m < 2 * NMEM) ? mem_prompt + (size_t)m * DM : mem_sample + (size_t)(m - 2 * NMEM) * DM; rms_row_to_bf16(xr, ln_mem, MEMN + (size_t)m * DM, lane); }
        for (int i = bx * 512 + tid; i < T; i += G * 512) SS[i] = 0.f;
        if (bx == 0 && tid < 320) ((unsigned*)(ws + WS_CNT))[tid] = 0u;
    }
    grid.sync();

    { SchedP1 S{P, G, bx}; EpiStore E{pool_scale}; pg8::gemm_phase(lds, S, E); }
#if DUP_MASK & 1
    __syncthreads();
    { SchedP1 S{P, G, bx}; EpiStore E{pool_scale}; pg8::gemm_phase(lds, S, E); }
#endif
    xcd_barrier(xbar);

    {
        for (int base = gw * 8; base < T * 10; base += NGW * 8 * 8) {
            u32x4 raw4[8];
#pragma unroll
            for (int uu = 0; uu < 8; ++uu) { const int it = base + uu * NGW * 8 + (lane >> 3);
                if (it < T * 10) { const int tok = it / 10, hh = it - tok * 10, sub = lane & 7;
                    const bf16_t* ptr = (hh < 8) ? ZB + (size_t)tok * 1024 + hh * 64 + sub * 8 : ZD + (size_t)tok * 256 + (hh - 8) * 64 + sub * 8;
                    raw4[uu] = *(const u32x4*)ptr; } else raw4[uu] = (u32x4){0u, 0u, 0u, 0u}; }
#pragma unroll
            for (int uu = 0; uu < 8; ++uu) {
                const int it = base + uu * NGW * 8 + (lane >> 3);
                const bool ok = it < T * 10;
                const int tok = it / 10, hh = it - tok * 10, sub = lane & 7;
                bf16_t* ptr = (hh < 8) ? ZB + (size_t)tok * 1024 + hh * 64 + sub * 8 : ZD + (size_t)tok * 256 + (hh - 8) * 64 + sub * 8;
                const u32x4 raw = raw4[uu];
                float v[8] = {bflo(raw.x), bfhi(raw.x), bflo(raw.y), bfhi(raw.y), bflo(raw.z), bfhi(raw.z), bflo(raw.w), bfhi(raw.w)};
                float ssq = 0.f;
#pragma unroll
                for (int j = 0; j < 8; ++j) ssq += v[j] * v[j];
                ssq += __shfl_xor(ssq, 1); ssq += __shfl_xor(ssq, 2); ssq += __shfl_xor(ssq, 4);
                const float rinv = 1.0f / sqrtf(ssq * (1.f / 64.f) + EPS);
                const float* gn = ((hh < 8) ? q_norm : k_norm) + sub * 8;
                const int tl = (tok < T_P) ? (tok & (L_P - 1)) : ((tok - T_P) & (L_S - 1));
                const float pos = (sub < 4) ? (float)(tl >> 6) : (float)(tl & 63);
                const float osc = (hh < 8) ? C2_SELF : 1.0f;
                float o[8];
#pragma unroll
                for (int jj = 0; jj < 4; ++jj) {
                    const int fi = (sub & 3) * 4 + jj;
                    const float inv = __builtin_amdgcn_exp2f(-(float)(2 * fi) * (13.287712379549449f / 32.0f));
                    const float rev = pos * inv * 0.15915494309189535f;
                    const float cs = __builtin_amdgcn_cosf(rev), sn = __builtin_amdgcn_sinf(rev);
                    const float y0 = v[2 * jj] * rinv * gn[2 * jj], y1 = v[2 * jj + 1] * rinv * gn[2 * jj + 1];
                    o[2 * jj] = (y0 * cs - y1 * sn) * osc; o[2 * jj + 1] = (y0 * sn + y1 * cs) * osc;
                }
                u32x4 w; w.x = pk2(o[0], o[1]); w.y = pk2(o[2], o[3]); w.z = pk2(o[4], o[5]); w.w = pk2(o[6], o[7]);
                if (ok) *(u32x4*)ptr = w;
            }
        }
        for (int it = gw; it < 4 * (T / 32); it += NGW) {
            const int g = (it + it / NGW) & 3, tok0 = ((it >> 2) * 4 + (lane >> 4)) * 8, col = g * 128 + (lane & 15) * 8;
            const int Lq = (tok0 < T_P) ? L_P : L_S; const int tl0 = (tok0 < T_P) ? (tok0 & (L_P - 1)) : ((tok0 - T_P) & (L_S - 1));
            const bf16_t* bp = ZA + (size_t)tok0 * 1024 + col;
            const f32x4 p0 = *(const f32x4*)(pool_scale + col), p1 = *(const f32x4*)(pool_scale + col + 4);
            u32x4 gt[4];
#pragma unroll
            for (int i = 0; i < 4; ++i) gt[i] = *(const u32x4*)(bp + (size_t)i * 1024 + 512);
#define UNP(V_, F_) { F_[0] = bflo((V_).x); F_[1] = bfhi((V_).x); F_[2] = bflo((V_).y); F_[3] = bfhi((V_).y); F_[4] = bflo((V_).z); F_[5] = bfhi((V_).z); F_[6] = bflo((V_).w); F_[7] = bfhi((V_).w); }
#define MK(j_) (((unsigned)(tl0 - W_ / 2 + (j_)) < (unsigned)Lq) ? 1.f : 0.f)
#define POOL_RUN(WW) { constexpr int W_ = WW; constexpr int NR = 8 + W_ - 1; u32x4 rw[NR]; \
                _Pragma("unroll") for (int j = 0; j < NR; ++j) { const bool ok = (unsigned)(tl0 - W_ / 2 + j) < (unsigned)Lq; rw[j] = *(const u32x4*)(bp + (ok ? (j - W_ / 2) : 0) * 1024); } \
                float sm[8] = {0.f, 0.f, 0.f, 0.f, 0.f, 0.f, 0.f, 0.f}; float cnt = 0.f; \
                _Pragma("unroll") for (int j = 0; j < W_; ++j) { float f[8]; UNP(rw[j], f); const float mk = MK(j); cnt += mk; _Pragma("unroll") for (int e = 0; e < 8; ++e) sm[e] += mk * f[e]; } \
                _Pragma("unroll") for (int i = 0; i < 8; ++i) { \
                    const float ic = 1.0f / cnt; float c[8], gg[8]; UNP(rw[i + W_ / 2], c); UNP(gt[i & 3], gg); \
                    if (i == 3) { _Pragma("unroll") for (int q = 0; q < 4; ++q) gt[q] = *(const u32x4*)(bp + (size_t)(4 + q) * 1024 + 512); } \
                    u32x4 wv; wv.x = pk2((sm[0] * ic - c[0]) * p0.x * gg[0], (sm[1] * ic - c[1]) * p0.y * gg[1]); \
                    wv.y = pk2((sm[2] * ic - c[2]) * p0.z * gg[2], (sm[3] * ic - c[3]) * p0.w * gg[3]); \
                    wv.z = pk2((sm[4] * ic - c[4]) * p1.x * gg[4], (sm[5] * ic - c[5]) * p1.y * gg[5]); \
                    wv.w = pk2((sm[6] * ic - c[6]) * p1.z * gg[6], (sm[7] * ic - c[7]) * p1.w * gg[7]); \
                    *(u32x4*)(MIX + (size_t)(tok0 + i) * 1024 + col) = wv; \
                    if (i < 7) { float fa[8], fs[8]; UNP(rw[i + W_], fa); UNP(rw[i], fs); const float ma = MK(i + W_), ms = MK(i); cnt += ma - ms; \
                        _Pragma("unroll") for (int e = 0; e < 8; ++e) sm[e] += ma * fa[e] - ms * fs[e]; } } }
            if (g == 0) POOL_RUN(2) else if (g == 1) POOL_RUN(4) else if (g == 2) POOL_RUN(8) else POOL_RUN(16)
#undef POOL_RUN
#undef MK
#undef UNP
        }
        cross_attn_phase(ZC, MKV, lds, vcu, G);
    }
    xcd_barrier(xbar);

    {
        for (int L = vcu; L < 2560; L += G) {
            int row0, Lq, kvh, hq, qb;
            if (L < 2048) { const int grp = L >> 6, ui = L & 63; const int seq = grp >> 1; kvh = grp & 1; hq = ui >> 4; qb = ui & 15; row0 = T_P + seq * L_S; Lq = L_S; }
            else { const int p = L - 2048, grp = p >> 7, ui = p & 127; const int seq = grp >> 1; kvh = grp & 1; hq = ui >> 5; qb = ui & 31; row0 = seq * L_P; Lq = L_P; }
            const int h = kvh * 4 + hq;
            bf16_t* Qp = ZB + (size_t)(row0 + qb * 256) * 1024 + h * 64;
            const bf16_t* Kp = ZD + (size_t)row0 * 256 + kvh * 64;
#if DUP_MASK & 2
            attn_body::attn_unit<8>((const attn_body::bf16*)Qp, (const attn_body::bf16*)Kp, (const attn_body::bf16*)(Kp + 128), Lq / 64, (const attn_body::bf16*)(Qp + 512), (attn_body::bf16*)(ws + WS_SCR + (size_t)bx * SCR_PER_BLOCK), (char*)lds_raw);
#endif
            attn_body::attn_unit<8>((const attn_body::bf16*)Qp, (const attn_body::bf16*)Kp, (const attn_body::bf16*)(Kp + 128), Lq / 64, (const attn_body::bf16*)(Qp + 512), (attn_body::bf16*)Qp, (char*)lds_raw);
        }
    }
    xcd_barrier(xbar);

    { SchedMerge S{P, G, bx}; EpiGate E{b_merge, (char*)ws + WS_SCR + (size_t)bx * SCR_PER_BLOCK}; pg8::gemm_phase(lds, S, E); }
#if DUP_MASK & 4
    __syncthreads();
    { SchedMerge S{P, G, bx}; EpiGate E{b_merge, (char*)ws + WS_SCR + (size_t)bx * SCR_PER_BLOCK}; pg8::gemm_phase(lds, S, E); }
#endif
    xcd_barrier(xbar);

    { SchedOut S{P, G, bx}; EpiOut E{SS, (unsigned*)(ws + WS_CNT), x_prompt, x_sample, ln_post, args.out}; pg8::gemm_phase(lds, S, E); }
}

extern "C" void kernel_launch(void* const* d_in, const int* in_sizes, int n_in, void* d_out, int out_size, void* d_ws, size_t ws_size, hipStream_t stream) {
    static int grid_blocks = 0;
    if (grid_blocks == 0) {
        if (n_in != 16 || out_size != T * DM || ws_size < WS_END) { fprintf(stderr, "kernel_launch: unexpected shapes (n_in %d out %d ws %zu need %zu)\n", n_in, out_size, ws_size, (size_t)WS_END); grid_blocks = -1; return; }
        int dev = 0, cus = 0, per_cu = 0;
        hipGetDevice(&dev);
        hipDeviceGetAttribute(&cus, hipDeviceAttributeMultiprocessorCount, dev);
        if (hipFuncSetAttribute((const void*)fwd_megakernel, hipFuncAttributeMaxDynamicSharedMemorySize, LDS_BYTES) != hipSuccess) { fprintf(stderr, "kernel_launch: hipFuncSetAttribute failed\n"); grid_blocks = -1; return; }
        if (hipOccupancyMaxActiveBlocksPerMultiprocessor(&per_cu, (const void*)fwd_megakernel, 512, LDS_BYTES) != hipSuccess || per_cu < 1) { fprintf(stderr, "kernel_launch: occupancy query failed (%d)\n", per_cu); (void)hipGetLastError(); per_cu = 1; }
        grid_blocks = cus * 1;
        if (grid_blocks > 256) grid_blocks = 256;
    }
    if (grid_blocks < 0) return;
    if (hipMemsetAsync((char*)d_ws + WS_BAR, 0, XCD_BAR_WORDS * 4, stream) != hipSuccess) { fprintf(stderr, "kernel_launch: hipMemsetAsync failed\n"); return; }
    Args a{};
    for (int i = 0; i < 16; ++i) a.in[i] = (const float*)d_in[i];
    a.out = (float*)d_out; a.ws = (unsigned char*)d_ws;
    void* kargs[] = {&a};
    hipError_t e = hipLaunchCooperativeKernel((const void*)fwd_megakernel, dim3(grid_blocks), dim3(512), kargs, LDS_BYTES, stream);
    if (e != hipSuccess) fprintf(stderr, "cooperative launch failed: %s (grid %d)\n", hipGetErrorString(e), grid_blocks);
}
```

```cpp
#include <hip/hip_runtime.h>
#include <hip/hip_cooperative_groups.h>
#include <cstdio>
#include <cstdint>
#include <cmath>
#include <hip/hip_bf16.h>
namespace cg = cooperative_groups;
#ifndef DUP_MASK
#define DUP_MASK 0
#endif

#define LAS __attribute__((address_space(3)))
typedef unsigned short bf16_t;
typedef short bf16x8 __attribute__((ext_vector_type(8)));
typedef short s16x4 __attribute__((ext_vector_type(4)));
typedef float f32x4 __attribute__((ext_vector_type(4)));
typedef float f32x16 __attribute__((ext_vector_type(16)));
typedef unsigned u32x4 __attribute__((ext_vector_type(4)));
typedef unsigned u32x2 __attribute__((ext_vector_type(2)));
typedef float f32x2_t __attribute__((ext_vector_type(2)));
typedef __bf16 bf16x2_t __attribute__((ext_vector_type(2)));

constexpr int DM = 1024;
constexpr int T_P = 2 * 8192, T_S = 16 * 4096, T = T_P + T_S;
constexpr int L_P = 8192, L_S = 4096;
constexpr int NMEM = 256, MEMROWS = 18 * NMEM;
constexpr int IN_DIM = 6400, ZW = 3328;
constexpr float EPS = 1e-6f;
constexpr float LOG2E = 1.4426950408889634f;
constexpr float C2_SELF = 0.125f * LOG2E;
constexpr float C2_CROSS = 0.08838834764831845f * LOG2E;

constexpr size_t MiB = 1u << 20;
constexpr size_t TB = (size_t)T * 1024 * 2;
constexpr size_t WS_SS = 0;
constexpr size_t WS_CNT = 512 * 1024;
constexpr size_t WS_BAR = 768 * 1024;
constexpr size_t WS_WIN = 1 * MiB;
constexpr size_t WS_WMKV = 14 * MiB, WS_WOUT = 16 * MiB, WS_WB01 = 18 * MiB, WS_WB2P = 20 * MiB;
constexpr size_t WS_MEMN = 22 * MiB, WS_MKV = 31 * MiB;
constexpr size_t WS_XN = 40 * MiB;
constexpr size_t WS_ZA = WS_XN + TB, WS_ZB = WS_ZA + TB, WS_ZC = WS_ZB + TB;
constexpr size_t WS_ZD = WS_ZC + TB;
constexpr size_t WS_MIX = WS_ZD + (size_t)T * 256 * 2;
constexpr size_t WS_SCR = WS_MIX + TB;
constexpr size_t SCR_PER_BLOCK = 256 * 1024;
constexpr size_t WS_END = WS_SCR + 256 * SCR_PER_BLOCK;
static_assert(WS_END <= 1024 * MiB, "workspace map");

constexpr int LDS_BYTES = 139264;
constexpr int NWAVES = 8;

__device__ __forceinline__ unsigned f2bf(float f) { unsigned u = __builtin_bit_cast(unsigned, f); return (u + 0x7fffu + ((u >> 16) & 1u)) >> 16; }
__device__ __forceinline__ unsigned pk2(float lo, float hi) { f32x2_t v = {lo, hi}; bf16x2_t b = __builtin_convertvector(v, bf16x2_t); return __builtin_bit_cast(unsigned, b); }
__device__ __forceinline__ float bflo(unsigned w) { return __builtin_bit_cast(float, w << 16); }
__device__ __forceinline__ float bfhi(unsigned w) { return __builtin_bit_cast(float, w & 0xffff0000u); }
__device__ __forceinline__ float fast_rcp(float x) { return __builtin_amdgcn_rcpf(x); }
__device__ __forceinline__ float sigmoidf_(float x) { return fast_rcp(1.0f + __builtin_amdgcn_exp2f(-x * LOG2E)); }
__device__ __forceinline__ float siluf_(float x) { return x * sigmoidf_(x); }
__device__ __forceinline__ float wave_sum(float v) {
#pragma unroll
    for (int o = 1; o < 64; o <<= 1) v += __shfl_xor(v, o);
    return v;
}
__device__ __forceinline__ int crow(int r, int hi) { return (r & 3) + 8 * (r >> 2) + 4 * hi; }

namespace pg8 {
constexpr int BM = 256, BK = 64, HALF = 128, HTB = HALF * BK * 2, STAGE_BYTES = 8 * HTB, NXCD = 8, WGM = 8;
constexpr int KP = 1024;
__device__ __forceinline__ int lds_byte(int r, int c) { const int st = (r >> 4) * 2 + (c >> 5), rr = r & 15, cc = c & 31, ob = rr * 64 + cc * 2; return st * 1024 + (ob ^ (((ob >> 9) & 1) << 5)); }
__device__ __forceinline__ void stage_rc(int b, int& R, int& C) { const int st = b / 1024, sb = b % 1024, swz = sb ^ (((sb >> 9) & 1) << 5); R = (st >> 1) * 16 + swz / 64; C = (st & 1) * 32 + (swz % 64) / 2; }
__device__ __forceinline__ int perm32(int rho) { const int n = rho >> 4, i = rho & 15; return 8 * (i >> 2) + 4 * n + (i & 3); }

struct Unit { const char* A; const char* B; int nt; int kind; int r0; int c0; int aux; char* O; int ldc; float sc; };

__device__ __forceinline__ void tile_order(int L, int nM, int nN, int& pm, int& pn) {
    const int nwg = nM * nN; int wgid = L;
    { const int q = nwg / NXCD, r = nwg % NXCD, xcd = wgid % NXCD, off = wgid / NXCD; wgid = (xcd < r ? xcd * (q + 1) : r * (q + 1) + (xcd - r) * q) + off; }
    const int nig = WGM * nN, gid = wgid / nig, fm = gid * WGM, gsz = (nM - fm) < WGM ? (nM - fm) : WGM;
    pm = fm + ((wgid % nig) % gsz); pn = (wgid % nig) / gsz;
}

template <class Epi, class Sched>
__device__ __forceinline__ void gemm_phase(LAS unsigned char* lds, const Sched& S, const Epi& E) {
    constexpr bool ALIGN_EPI = true;
    int tid = threadIdx.x; asm volatile("" : "+v"(tid));
    const int wid = __builtin_amdgcn_readfirstlane(tid >> 6), lane = tid & 63, wr = wid >> 2, wc = wid & 3, fr = lane & 15, fq = lane >> 4;
    const int K = KP;
    unsigned voffA[2], voffB[2];
#pragma unroll
    for (int i = 0; i < 2; ++i) { int R, C; stage_rc(tid * 16 + i * 8192, R, C); const int Rb = (R & ~31) + perm32(R & 31);
        voffA[i] = (unsigned)(R * K + C) * 2u; voffB[i] = (unsigned)(Rb * K + C) * 2u; }
    const size_t kstep = (size_t)(BK * 2);
    const size_t hstep = (size_t)HALF * K * 2;
    const unsigned ldsw = (unsigned)wid * 1024u;
    const int aoff = lds_byte(wr * 64 + fr, fq * 8), boff = lds_byte(wc * 32 + fr, fq * 8);
#define PG8_SA(b, h) (((b) * 2 + (h)) * HTB)
#define PG8_SB(b, h) ((4 + (b) * 2 + (h)) * HTB)
#define PG8_STAGE(bufoff, gbase, voff) do { _Pragma("unroll") for (int _i = 0; _i < 2; ++_i) \
        __builtin_amdgcn_global_load_lds((const unsigned*)((const char*)(gbase) + (voff)[_i]), (LAS unsigned*)(lds + (bufoff) + ldsw + _i * 8192), 16, 0, 0); } while (0)
#define PG8_LDA(dst, b, h) do { _Pragma("unroll") for (int m = 0; m < 4; ++m) _Pragma("unroll") for (int k = 0; k < 2; ++k) dst[m][k] = *(const LAS bf16x8*)(lds + PG8_SA(b, h) + aoff + m * 2048 + k * 1024); } while (0)
#define PG8_LDB(dst, b, h) do { _Pragma("unroll") for (int n = 0; n < 2; ++n) _Pragma("unroll") for (int k = 0; k < 2; ++k) dst[n][k] = *(const LAS bf16x8*)(lds + PG8_SB(b, h) + boff + n * 2048 + k * 1024); } while (0)
#define PG8_MMA(ai, bj, At, Bt) do { __builtin_amdgcn_s_setprio(1); _Pragma("unroll") for (int m = 0; m < 4; ++m) _Pragma("unroll") for (int n = 0; n < 2; ++n) _Pragma("unroll") for (int k = 0; k < 2; ++k) \
        acc[ai][bj][m][n] = __builtin_amdgcn_mfma_f32_16x16x32_bf16(Bt[n][k], At[m][k], acc[ai][bj][m][n], 0, 0, 0); __builtin_amdgcn_s_setprio(0); } while (0)
#define PG8_WAIT_V(n) asm volatile("s_waitcnt vmcnt(" #n ")" ::: "memory")
#define PG8_WAIT_L(n) asm volatile("s_waitcnt lgkmcnt(" #n ")" ::: "memory")
#define PG8_BAR __builtin_amdgcn_s_barrier()
#define PG8_SCHED __builtin_amdgcn_sched_barrier(0)
    Unit cur, nxt; int ui = 0;
    if (!S.next(0, cur)) return;
    f32x4 acc[2][2][4][2];
#pragma unroll
    for (int a = 0; a < 2; ++a)
#pragma unroll
        for (int b = 0; b < 2; ++b)
#pragma unroll
            for (int m = 0; m < 4; ++m)
#pragma unroll
                for (int n = 0; n < 2; ++n) acc[a][b][m][n] = (f32x4){0.f, 0.f, 0.f, 0.f};
    bf16x8 At[4][2], B0[2][2], B1[2][2];
    const char* cA = cur.A; const char* cB = cur.B;
    PG8_STAGE(PG8_SB(0, 0), cB, voffB); PG8_STAGE(PG8_SB(0, 1), cB + hstep, voffB); PG8_STAGE(PG8_SA(0, 0), cA, voffA); PG8_STAGE(PG8_SA(0, 1), cA + hstep, voffA);
    if (wr == 1) PG8_BAR;
    PG8_WAIT_V(2); PG8_BAR;
    PG8_STAGE(PG8_SB(1, 0), cB + kstep, voffB); PG8_STAGE(PG8_SA(1, 0), cA + kstep, voffA); PG8_STAGE(PG8_SB(1, 1), cB + hstep + kstep, voffB);
    PG8_WAIT_V(6); PG8_BAR;
    for (;;) {
        const bool has_next = S.next(ui + 1, nxt);
        const char* nA = has_next ? nxt.A : cA; const char* nB = has_next ? nxt.B : cB;
        const int nt = cur.nt;
        for (int t = 0; t < nt; t += 2) {
            const bool last = (t == nt - 2);
            const char* a1 = cA + (size_t)(t + 1) * kstep;
            const char* a2 = last ? nA : cA + (size_t)(t + 2) * kstep; const char* b2 = last ? nB : cB + (size_t)(t + 2) * kstep;
            const char* a3 = a2 + kstep; const char* b3 = b2 + kstep;
            PG8_LDB(B0, 0, 0); PG8_LDB(B1, 0, 1); PG8_SCHED; PG8_LDA(At, 0, 0); PG8_STAGE(PG8_SA(1, 1), a1 + hstep, voffA);
            PG8_WAIT_V(8); PG8_WAIT_L(0); PG8_BAR; PG8_MMA(0, 0, At, B0); PG8_MMA(0, 1, At, B1); PG8_BAR; PG8_SCHED;
            PG8_LDA(At, 0, 1); PG8_STAGE(PG8_SB(0, 0), b2, voffB); PG8_STAGE(PG8_SB(0, 1), b2 + hstep, voffB); PG8_STAGE(PG8_SA(0, 0), a2, voffA);
            PG8_WAIT_V(8); PG8_WAIT_L(0); PG8_BAR; PG8_MMA(1, 0, At, B0); PG8_MMA(1, 1, At, B1); PG8_BAR; PG8_SCHED;
            PG8_LDB(B0, 1, 0); PG8_LDB(B1, 1, 1); PG8_SCHED; PG8_LDA(At, 1, 0); PG8_STAGE(PG8_SA(0, 1), a2 + hstep, voffA);
            PG8_WAIT_V(8); PG8_WAIT_L(0); PG8_BAR; PG8_MMA(0, 0, At, B0); PG8_MMA(0, 1, At, B1); PG8_BAR; PG8_SCHED;
            PG8_LDA(At, 1, 1); PG8_STAGE(PG8_SB(1, 0), b3, voffB); PG8_STAGE(PG8_SB(1, 1), b3 + hstep, voffB); PG8_STAGE(PG8_SA(1, 0), a3, voffA);
            PG8_WAIT_V(8); PG8_WAIT_L(0); PG8_BAR; PG8_MMA(1, 0, At, B0); PG8_MMA(1, 1, At, B1); PG8_BAR; PG8_SCHED;
        }
        if constexpr (ALIGN_EPI) { if (wr == 0) PG8_BAR; }
        E(acc, cur, wr, wc, fr, fq);
        if (!has_next) break;
#pragma unroll
        for (int a = 0; a < 2; ++a)
#pragma unroll
            for (int b = 0; b < 2; ++b)
#pragma unroll
                for (int m = 0; m < 4; ++m)
#pragma unroll
                    for (int n = 0; n < 2; ++n) acc[a][b][m][n] = (f32x4){0.f, 0.f, 0.f, 0.f};
        cur = nxt; cA = nA; cB = nB; ++ui;
        if constexpr (ALIGN_EPI) { if (wr == 1) PG8_BAR; }
    }
    PG8_WAIT_V(0);
    if constexpr (!ALIGN_EPI) { if (wr == 0) PG8_BAR; }
    PG8_BAR;
#undef PG8_SA
#undef PG8_SB
#undef PG8_STAGE
#undef PG8_LDA
#undef PG8_LDB
#undef PG8_MMA
#undef PG8_WAIT_V
#undef PG8_WAIT_L
#undef PG8_BAR
#undef PG8_SCHED
}
}

namespace attn_body {
using bf16=__hip_bfloat16;
using bf16x8=__attribute__((ext_vector_type(8)))short;
using s16x4=__attribute__((ext_vector_type(4)))short;
using f32x16=__attribute__((ext_vector_type(16)))float;
using u32x4=__attribute__((ext_vector_type(4)))unsigned;
constexpr int D=64,QP=1024,KVP=256;
constexpr int NW=8,QBLK=32,QB=QBLK*NW,KVBLK=64;
__device__ __forceinline__ int crow(int r,int hi){return (r&3)+8*(r>>2)+4*hi;}
#define SBAR() __builtin_amdgcn_sched_barrier(0)
__device__ __forceinline__ void cmask(f32x16&p0,f32x16&p1,int jb,int qrel,int hi){
  const float NEG=-INFINITY; int kb=64*jb+4*hi;
  #pragma unroll
  for(int r=0;r<16;++r){int kv=kb+(r&3)+8*(r>>2); if(kv>qrel)p0[r]=NEG; if(kv+32>qrel)p1[r]=NEG;}
}

constexpr int NSLOT=3, SLOTB=8192;
constexpr int LDS_K=0, LDS_V=NSLOT*SLOTB, LDS_WS=2*NSLOT*SLOTB, LDS_OST=LDS_WS+NW*64*4, LDS_BYTES=LDS_OST+NW*4096;
constexpr float C2=0.125f*1.4426950408889634f;
__device__ __forceinline__ void glds16(const void*gsrc,unsigned lds_dst){unsigned keep;
  asm volatile("s_mov_b32 %0, m0\n\ts_mov_b32 m0, %2\n\ts_nop 0\n\tglobal_load_lds_dwordx4 %1, off\n\ts_mov_b32 m0, %0":"=&s"(keep):"v"(gsrc),"s"(lds_dst):"memory");}
__device__ __forceinline__ float max3f(float a,float b,float c){float r;asm("v_max3_f32 %0, %1, %2, %3":"=v"(r):"v"(a),"v"(b),"v"(c));return r;}
__device__ __forceinline__ float max2f(float a,float b){float r;asm("v_max_f32_e32 %0, %1, %2":"=v"(r):"v"(a),"v"(b));return r;}
__device__ __forceinline__ float fadd_s(float a,float b){float r;asm("v_add_f32_e32 %0, %1, %2":"=v"(r):"v"(a),"v"(b));return r;}
__device__ __forceinline__ float fsub_s(float a,float b){float r;asm("v_sub_f32_e32 %0, %1, %2":"=v"(r):"v"(a),"v"(b));return r;}
typedef float f32x2_t __attribute__((ext_vector_type(2))); typedef __bf16 bf16x2_t __attribute__((ext_vector_type(2)));
__device__ __forceinline__ unsigned cvtpk_s(float lo,float hi){f32x2_t v={lo,hi};bf16x2_t b=__builtin_convertvector(v,bf16x2_t);return __builtin_bit_cast(unsigned,b);}
#define WAIT_BAR(N) asm volatile("s_waitcnt vmcnt(" #N ") lgkmcnt(0)\n\ts_barrier":::"memory")

__device__ __forceinline__ void qkt(f32x16&p0,f32x16&p1,const char*Kslot,const bf16x8*qr,const f32x16&negm,int r32,int hi){
  const char*kb=Kslot+hi*1024+r32*16;
  #pragma unroll
  for(int d0=0;d0<4;++d0){
    const bf16x8 b0=*reinterpret_cast<const bf16x8*>(kb+d0*2048);
    const bf16x8 b1=*reinterpret_cast<const bf16x8*>(kb+d0*2048+512);
    if(d0==0){p0=__builtin_amdgcn_mfma_f32_32x32x16_bf16(b0,qr[0],negm,0,0,0);p1=__builtin_amdgcn_mfma_f32_32x32x16_bf16(b1,qr[0],negm,0,0,0);}
    else{p0=__builtin_amdgcn_mfma_f32_32x32x16_bf16(b0,qr[d0],p0,0,0,0);p1=__builtin_amdgcn_mfma_f32_32x32x16_bf16(b1,qr[d0],p1,0,0,0);}}
}
typedef __attribute__((address_space(3))) const char* lds_cptr;
typedef short v4i16_t __attribute__((ext_vector_type(4)));
__device__ __forceinline__ void kload8(bf16x8*kf,lds_cptr kp){
  kf[0]=*(const __attribute__((address_space(3))) bf16x8*)(kp);      kf[1]=*(const __attribute__((address_space(3))) bf16x8*)(kp+512);
  kf[2]=*(const __attribute__((address_space(3))) bf16x8*)(kp+2048); kf[3]=*(const __attribute__((address_space(3))) bf16x8*)(kp+2560);
  kf[4]=*(const __attribute__((address_space(3))) bf16x8*)(kp+4096); kf[5]=*(const __attribute__((address_space(3))) bf16x8*)(kp+4608);
  kf[6]=*(const __attribute__((address_space(3))) bf16x8*)(kp+6144); kf[7]=*(const __attribute__((address_space(3))) bf16x8*)(kp+6656);
}
__device__ __forceinline__ void kload2(bf16x8*kf,lds_cptr kp,int j){ kf[2*j]=*(const __attribute__((address_space(3))) bf16x8*)(kp+j*2048); kf[2*j+1]=*(const __attribute__((address_space(3))) bf16x8*)(kp+j*2048+512); }
__device__ __forceinline__ s16x4 vtr(lds_cptr p){ return __builtin_bit_cast(s16x4,__builtin_amdgcn_ds_read_tr16_b64_v4i16((__attribute__((address_space(3))) v4i16_t*)p)); }
__device__ __forceinline__ float rowmax(const f32x16&p0,const f32x16&p1){
  float a=max3f(p0[0],p0[1],p1[0]),b=max3f(p0[2],p0[3],p1[1]);a=max3f(a,p1[2],p1[3]);
  #pragma unroll
  for(int r=4;r<16;r+=4){a=max3f(a,p0[r],p0[r+1]);b=max3f(b,p0[r+2],p0[r+3]);a=max3f(a,p1[r],p1[r+1]);b=max3f(b,p1[r+2],p1[r+3]);}
  const float m=max2f(a,b);
  auto rr=__builtin_amdgcn_permlane32_swap(__float_as_uint(m),__float_as_uint(m),false,false);
  return max2f(__uint_as_float(rr[0]),__uint_as_float(rr[1]));
}
__device__ __forceinline__ void pv(f32x16*o,int vb,bf16x8 pa0,bf16x8 pa1,bf16x8 pa2,bf16x8 pa3){
  #pragma unroll
  for(int d0=0;d0<2;++d0){s16x4 lo[4],hi[4];
    #pragma unroll
    for(int ks=0;ks<4;++ks){
      asm volatile("ds_read_b64_tr_b16 %0,%1 offset:%c2":"=&v"(lo[ks]):"v"(vb),"i"(d0*4096+ks*1024):"memory");
      asm volatile("ds_read_b64_tr_b16 %0,%1 offset:%c2":"=&v"(hi[ks]):"v"(vb),"i"(d0*4096+ks*1024+512):"memory");}
    asm volatile("s_waitcnt lgkmcnt(0)":::"memory");SBAR();
    #define PK(k) (bf16x8){lo[k][0],lo[k][1],lo[k][2],lo[k][3],hi[k][0],hi[k][1],hi[k][2],hi[k][3]}
    o[d0]=__builtin_amdgcn_mfma_f32_32x32x16_bf16(pa0,PK(0),o[d0],0,0,0);
    o[d0]=__builtin_amdgcn_mfma_f32_32x32x16_bf16(pa1,PK(1),o[d0],0,0,0);
    o[d0]=__builtin_amdgcn_mfma_f32_32x32x16_bf16(pa2,PK(2),o[d0],0,0,0);
    o[d0]=__builtin_amdgcn_mfma_f32_32x32x16_bf16(pa3,PK(3),o[d0],0,0,0);
    #undef PK
  }
}

#ifndef ATTN_STORE16
#define ATTN_STORE16(p,v) (*(u32x4*)(p)=(v))
#endif
template<int THRL> __device__ __forceinline__ void attn_unit(const bf16*Qb,const bf16*__restrict__ Kh,const bf16*__restrict__ Vh,const int NT,const bf16*Gb,bf16*Ob,char*shm,const float*qn,const int tl0){
  const int tid=threadIdx.x,lane=tid&63,r32=lane&31,hi=lane>>5; const int wid=__builtin_amdgcn_readfirstlane(tid>>6);
  const bf16*Qw=Qb+(long)(wid*QBLK)*QP;
  const unsigned lds0=(unsigned)(uintptr_t)shm;
  float*wsf=(float*)(shm+LDS_WS)+wid*64;
  const bf16*ksrc=Kh+(long)lane*KVP+wid*8;
  const bf16*vsrc=Vh+(long)(16*(wid&3)+(lane>>2))*KVP+(wid>>2)*32+(lane&3)*8;
  const unsigned kdst=lds0+LDS_K+wid*1024, vdst=lds0+LDS_V+wid*1024;
  #define DMA_K(t,slot) glds16(ksrc+(long)(t)*KVBLK*KVP,(unsigned)__builtin_amdgcn_readfirstlane(kdst+(slot)))
  #define DMA_V(t,slot) glds16(vsrc+(long)(t)*KVBLK*KVP,(unsigned)__builtin_amdgcn_readfirstlane(vdst+(slot)))
  const int vb0=(int)(lds0+LDS_V)+((lane>>4)&1)*32+(lane&3)*8+(4*hi+((lane&15)>>2))*64;
  const char*Kbase=shm+LDS_K; bf16x8 kf[8];
  const lds_cptr shm3=(lds_cptr)shm; const lds_cptr kp0=shm3+LDS_K+hi*1024+r32*16; const lds_cptr vp0=shm3+LDS_V+((lane>>4)&1)*32+(lane&3)*8+(4*hi+((lane&15)>>2))*64;
  DMA_K(0,0);DMA_V(0,0);DMA_K(1,SLOTB);
  bf16x8 qr[4];
  #pragma unroll
  for(int d0=0;d0<4;++d0)qr[d0]=*reinterpret_cast<const bf16x8*>(&Qw[(long)r32*QP+d0*16+hi*8]);
  { float qv[4][8]; float ssq=0.f;
    #pragma unroll
    for(int d0=0;d0<4;++d0){
      #pragma unroll
      for(int j=0;j<8;++j){qv[d0][j]=__uint_as_float(((unsigned)(unsigned short)qr[d0][j])<<16);ssq+=qv[d0][j]*qv[d0][j];}}
    {auto rr=__builtin_amdgcn_permlane32_swap(__float_as_uint(ssq),__float_as_uint(ssq),false,false);ssq=__uint_as_float(rr[0])+__uint_as_float(rr[1]);}
    const float rinv=1.0f/sqrtf(ssq*(1.f/64.f)+1e-6f);
    const int tl=tl0+wid*QBLK+r32;
    #pragma unroll
    for(int d0=0;d0<4;++d0){
      const float pos=(d0<2)?(float)(tl>>6):(float)(tl&63);
      const float*gp=qn+d0*16+hi*8;
      const float gq[8]={gp[0],gp[1],gp[2],gp[3],gp[4],gp[5],gp[6],gp[7]};
      u32x4 pk;
      #pragma unroll
      for(int jj=0;jj<4;++jj){
        const float inv=__builtin_amdgcn_exp2f(-(float)(2*(8*(d0&1)+4*hi+jj))*(13.287712379549449f/32.0f));
        const float rev=pos*inv*0.15915494309189535f;
        const float cs=__builtin_amdgcn_cosf(rev),sn=__builtin_amdgcn_sinf(rev);
        const float y0=qv[d0][2*jj]*rinv*gq[2*jj],y1=qv[d0][2*jj+1]*rinv*gq[2*jj+1];
        pk[jj]=cvtpk_s((y0*cs-y1*sn)*C2,(y0*sn+y1*cs)*C2);}
      qr[d0]=__builtin_bit_cast(bf16x8,pk);}
  }
  float mhat=0.f,l_reg=0.f;f32x16 o[2];o[0]=f32x16{};o[1]=f32x16{};f32x16 negm=f32x16{};asm volatile("":"+v"(negm));
  #define CMASK(P0,P1,t) do{}while(0)
  bool resc=false;
  #define START(P0,P1) do{ const float rm=rowmax(P0,P1); resc=false; \
    { const float dl=rm; mhat=fadd_s(mhat,dl); \
      _Pragma("unroll") for(int r=0;r<16;++r){P0[r]=fsub_s(P0[r],dl);P1[r]=fsub_s(P1[r],dl);} \
      _Pragma("unroll") for(int r=0;r<16;++r)negm[r]=-mhat; asm volatile("":"+v"(negm)); } \
    _Pragma("unroll") for(int r=0;r<16;++r)P0[r]=__builtin_amdgcn_exp2f(P0[r]); }while(0)
  #define RESC() do{ if(resc){ asm volatile("s_waitcnt lgkmcnt(0)":::"memory"); \
      _Pragma("unroll") for(int d_=0;d_<2;++d_) _Pragma("unroll") for(int r=0;r<16;++r)o[d_][r]*=wsf[crow(r,hi)]; } }while(0)
  f32x16 pA0,pA1,pB0,pB1;
  int sl_prev=0,sl_cur=0,sl_next=SLOTB;
  #define ROT() do{sl_prev=sl_cur;sl_cur=sl_next;sl_next=(sl_next==(NSLOT-1)*SLOTB)?0:sl_next+SLOTB;}while(0)
  DMA_K(2,2*SLOTB);
  WAIT_BAR(3);
  qkt(pA0,pA1,Kbase,qr,negm,r32,hi);asm volatile("s_nop 15\n\ts_nop 7":"+v"(pA0),"+v"(pA1));CMASK(pA0,pA1,0);
  START(pA0,pA1);
  _Pragma("unroll") for(int r=0;r<16;++r)pA1[r]=__builtin_amdgcn_exp2f(pA1[r]);
  WAIT_BAR(0);
  DMA_K(3,0);DMA_V(1,SLOTB);
  ROT();
  kload8(kf,kp0+sl_cur);
  WAIT_BAR(2);
  s16x4 vlo[8],vhi[8]; u32x4 pw0,pw1,pw2,pw3;
  #define PKW(P,B) cvtpk_s(P[B],P[B+1])
  #define PAF(k) __builtin_bit_cast(bf16x8,pw##k)
  #define VFR(i) (bf16x8){vlo[i][0],vlo[i][1],vlo[i][2],vlo[i][3],vhi[i][0],vhi[i][1],vhi[i][2],vhi[i][3]}
  #define PIN(x) asm volatile("":"+v"(x))
  #define MX3(a,b,c) __builtin_fmaxf(__builtin_fmaxf((a),(b)),(c))
  #define GAPA(MF,A0,A1,A2,A3,W0,W1,PW) do{ MF; sacc+=A0; sacc+=A1; sacc+=A2; sacc+=A3; PIN(sacc); W0; W1; PIN(PW); SBAR(); }while(0)
  #define EX(v) __builtin_amdgcn_exp2f(v)
  #define GAPB(MF,X,B) do{ MF; X[B]=EX(X[B]); X[B+1]=EX(X[B+1]); X[B+2]=EX(X[B+2]); X[B+3]=EX(X[B+3]); PIN(X); SBAR(); }while(0)
  #define VRD(i) do{ vlo[i]=vtr(vp_+(((i)>>2)*4096+((i)&3)*1024)); vhi[i]=vtr(vp_+(((i)>>2)*4096+((i)&3)*1024+512)); }while(0)
  #define KRD(G,j) do{ if(G){ kload2(kf,kp0+sl_next,j); SBAR(); } }while(0)
  #define STEP(C0,C1,P0,P1,t,GK,GV,GL) do{ SBAR(); \
    const lds_cptr vp_=vp0+sl_prev; \
    VRD(0); SBAR(); float sacc=(P0[0]+P0[1]); \
    GAPA(C0=__builtin_amdgcn_mfma_f32_32x32x16_bf16(kf[0],qr[0],negm,0,0,0), P0[2],P0[3],P0[4],P0[5],     pw0[0]=PKW(P0,0), pw0[1]=PKW(P0,2), pw0); \
    VRD(4); SBAR(); GAPA(C1=__builtin_amdgcn_mfma_f32_32x32x16_bf16(kf[1],qr[0],negm,0,0,0), P0[6],P0[7],P0[8],P0[9],     pw0[2]=PKW(P0,4), pw0[3]=PKW(P0,6), pw0); \
    VRD(1); SBAR(); GAPA(C0=__builtin_amdgcn_mfma_f32_32x32x16_bf16(kf[2],qr[1],C0,0,0,0),   P0[10],P0[11],P0[12],P0[13], pw1[0]=PKW(P0,8), pw1[1]=PKW(P0,10), pw1); \
    VRD(5); SBAR(); GAPA(C1=__builtin_amdgcn_mfma_f32_32x32x16_bf16(kf[3],qr[1],C1,0,0,0),   P0[14],P0[15],P1[0],P1[1],   pw1[2]=PKW(P0,12),pw1[3]=PKW(P0,14), pw1); \
    VRD(2); SBAR(); GAPA(C0=__builtin_amdgcn_mfma_f32_32x32x16_bf16(kf[4],qr[2],C0,0,0,0),   P1[2],P1[3],P1[4],P1[5],     pw2[0]=PKW(P1,0), pw2[1]=PKW(P1,2), pw2); \
    VRD(6); SBAR(); GAPA(C1=__builtin_amdgcn_mfma_f32_32x32x16_bf16(kf[5],qr[2],C1,0,0,0),   P1[6],P1[7],P1[8],P1[9],     pw2[2]=PKW(P1,4), pw2[3]=PKW(P1,6), pw2); \
    VRD(3); SBAR(); GAPA(C0=__builtin_amdgcn_mfma_f32_32x32x16_bf16(kf[6],qr[3],C0,0,0,0),   P1[10],P1[11],P1[12],P1[13], pw3[0]=PKW(P1,8), pw3[1]=PKW(P1,10), pw3); \
    VRD(7); SBAR(); GAPA(C1=__builtin_amdgcn_mfma_f32_32x32x16_bf16(kf[7],qr[3],C1,0,0,0),   P1[14],P1[15],0.f,0.f,       pw3[2]=PKW(P1,12),pw3[3]=PKW(P1,14), pw3); \
    l_reg+=sacc; \
    if(GK){DMA_K((t)+3,sl_cur);} if(GV){DMA_V((t)+1,sl_next);} \
    CMASK(C0,C1,t); \
    { float a=MX3(C0[0],C0[1],C1[0]),b=MX3(C0[2],C0[3],C1[1]); a=MX3(a,C1[2],C1[3]); \
      _Pragma("unroll") for(int r=4;r<16;r+=4){a=MX3(a,C0[r],C0[r+1]);b=MX3(b,C0[r+2],C0[r+3]);a=MX3(a,C1[r],C1[r+1]);b=MX3(b,C1[r+2],C1[r+3]);} \
      float rm=__builtin_fmaxf(a,b); { auto rr=__builtin_amdgcn_permlane32_swap(__float_as_uint(rm),__float_as_uint(rm),false,false); rm=__builtin_fmaxf(__uint_as_float(rr[0]),__uint_as_float(rr[1])); } \
      resc=false; \
      if(__builtin_expect(__any(rm>(float)THRL),0)){ const float dl=__builtin_fmaxf(rm,0.f); mhat+=dl; \
        _Pragma("unroll") for(int r=0;r<16;++r){C0[r]-=dl;C1[r]-=dl;} \
        _Pragma("unroll") for(int r=0;r<16;++r)negm[r]=-mhat; asm volatile("":"+v"(negm)); \
        const float f=__builtin_amdgcn_exp2f(-dl); l_reg*=f; if(hi==0)wsf[r32]=f; resc=true; } } \
    SBAR(); \
    GAPB(o[0]=__builtin_amdgcn_mfma_f32_32x32x16_bf16(PAF(0),VFR(0),o[0],0,0,0), C0,0); \
    GAPB(o[1]=__builtin_amdgcn_mfma_f32_32x32x16_bf16(PAF(0),VFR(4),o[1],0,0,0), C0,4); \
    KRD(GL,0); GAPB(o[0]=__builtin_amdgcn_mfma_f32_32x32x16_bf16(PAF(1),VFR(1),o[0],0,0,0), C0,8); \
    KRD(GL,1); GAPB(o[1]=__builtin_amdgcn_mfma_f32_32x32x16_bf16(PAF(1),VFR(5),o[1],0,0,0), C0,12); \
    KRD(GL,2); GAPB(o[0]=__builtin_amdgcn_mfma_f32_32x32x16_bf16(PAF(2),VFR(2),o[0],0,0,0), C1,0); \
    KRD(GL,3); GAPB(o[1]=__builtin_amdgcn_mfma_f32_32x32x16_bf16(PAF(2),VFR(6),o[1],0,0,0), C1,4); \
    GAPB(o[0]=__builtin_amdgcn_mfma_f32_32x32x16_bf16(PAF(3),VFR(3),o[0],0,0,0), C1,8); \
    GAPB(o[1]=__builtin_amdgcn_mfma_f32_32x32x16_bf16(PAF(3),VFR(7),o[1],0,0,0), C1,12); \
    }while(0)
  int t=1;
  #undef CMASK
  #define CMASK(P0,P1,t) do{}while(0)
  for(;t+5<NT;t+=2){
    STEP(pB0,pB1,pA0,pA1,t,true,true,true);     WAIT_BAR(2); RESC(); ROT();
    STEP(pA0,pA1,pB0,pB1,t+1,true,true,true);   WAIT_BAR(2); RESC(); ROT();
  }
  #undef CMASK
  #define CMASK(P0,P1,t) do{}while(0)
  #define ENDW(tt) do{ if((tt)+3<NT){WAIT_BAR(2);} else if((tt)+2<NT){WAIT_BAR(1);} else {WAIT_BAR(0);} }while(0)
  for(;t+1<NT;t+=2){
    STEP(pB0,pB1,pA0,pA1,t,(t+3<NT),(t+1<NT),(t+1<NT));       ENDW(t);   RESC(); ROT();
    STEP(pA0,pA1,pB0,pB1,t+1,(t+4<NT),(t+2<NT),(t+2<NT));     ENDW(t+1); RESC(); ROT();
  }
  STEP(pB0,pB1,pA0,pA1,NT-1,false,false,false); RESC();
  { float sacc=pB0[0]+pB0[1]; _Pragma("unroll") for(int r=2;r<16;++r)sacc+=pB0[r]; _Pragma("unroll") for(int r=0;r<16;++r)sacc+=pB1[r]; l_reg+=sacc;
    pw0=(u32x4){PKW(pB0,0),PKW(pB0,2),PKW(pB0,4),PKW(pB0,6)};pw1=(u32x4){PKW(pB0,8),PKW(pB0,10),PKW(pB0,12),PKW(pB0,14)};pw2=(u32x4){PKW(pB1,0),PKW(pB1,2),PKW(pB1,4),PKW(pB1,6)};pw3=(u32x4){PKW(pB1,8),PKW(pB1,10),PKW(pB1,12),PKW(pB1,14)};
    SBAR(); pv(o,vb0+sl_cur,PAF(0),PAF(1),PAF(2),PAF(3)); }
  #undef PKW
  #undef PAF
  #undef VFR
  #undef PIN
  #undef MX3
  #undef GAPA
  #undef GAPB
  #undef EX
  #undef VRD
  #undef KRD
  #undef STEP
  #undef ENDW
  u32x4 gpre[4];
  { const bf16*Gw0=Gb+(long)(wid*QBLK)*QP;
    #pragma unroll
    for(int i=0;i<4;++i)gpre[i]=*(const u32x4*)(Gw0+(long)(i*8+(lane>>3))*QP+(lane&7)*8); }
  {auto rr=__builtin_amdgcn_permlane32_swap(__float_as_uint(l_reg),__float_as_uint(l_reg),false,false);l_reg=__uint_as_float(rr[0])+__uint_as_float(rr[1]);}
  if(hi==0)wsf[32+r32]=l_reg;asm volatile("s_waitcnt lgkmcnt(0)":::"memory");
  float rli[16];
  #pragma unroll
  for(int r=0;r<16;++r)rli[r]=__builtin_amdgcn_rcpf(wsf[32+crow(r,hi)]);
  bf16*Ow=Ob+(long)(wid*QBLK)*QP; const bf16*Gw=Gb+(long)(wid*QBLK)*QP;
  { bf16*stg=(bf16*)(shm+LDS_OST)+wid*2048;
    #pragma unroll
    for(int r=0;r<16;++r){const int orow=crow(r,hi);
      #pragma unroll
      for(int d0=0;d0<2;++d0)stg[orow*64+d0*32+r32]=__float2bfloat16(o[d0][r]*rli[r]);}
    asm volatile("s_waitcnt lgkmcnt(0)":::"memory");
    #pragma unroll
    for(int i=0;i<4;++i){const int row=i*8+(lane>>3),ch=lane&7; const u32x4 v=*(const u32x4*)(stg+row*64+ch*8); const u32x4 g=gpre[i]; u32x4 w;
      #define GM(a,b) cvtpk_s(__uint_as_float((a)<<16)*__uint_as_float((b)<<16),__uint_as_float((a)&0xffff0000u)*__uint_as_float((b)&0xffff0000u))
      w.x=GM(v.x,g.x);w.y=GM(v.y,g.y);w.z=GM(v.z,g.z);w.w=GM(v.w,g.w);
      #undef GM
      ATTN_STORE16(Ow+(long)row*QP+ch*8,w);} }
  asm volatile("s_waitcnt lgkmcnt(0)\n\ts_barrier":::"memory");
  #undef DMA_K
  #undef DMA_V
  #undef CMASK
  #undef START
  #undef RESC
  #undef ROT
}
constexpr int ATTN_LDS_BYTES=LDS_BYTES;
#undef SBAR
#undef WAIT_BAR
}

__device__ __forceinline__ unsigned xb_ld(unsigned* p)              { return __hip_atomic_load(p, __ATOMIC_RELAXED, __HIP_MEMORY_SCOPE_AGENT); }
__device__ __forceinline__ unsigned xb_add(unsigned* p, unsigned v) { return __hip_atomic_fetch_add(p, v, __ATOMIC_RELAXED, __HIP_MEMORY_SCOPE_AGENT); }
#define XB_TMO      128
#define XB_XCNT(j)  (256  + 64 * (j))
#define XB_XSUB(j)  (1280 + 64 * (j))
#define XB_XGEN(j)  (2304 + 64 * (j))
#define XB_TOP      3328
#define XB_TOPGEN   3392
#define XCD_BAR_WORDS 3456
#define XB_SPIN_CAP (1u << 18)

__device__ __forceinline__ unsigned xb_xcc_id() { return (unsigned)__builtin_amdgcn_s_getreg((3 << 11) | 20) & 0xFu; }
#define XB_SPIN(cond, bar) do { unsigned _sp = 0; while (cond) { __builtin_amdgcn_s_sleep(1); \
    if ((++_sp & 255u) == 0u) { if (xb_ld(&(bar)[XB_TMO])) break; if (_sp > XB_SPIN_CAP) { atomicAdd(&(bar)[XB_TMO], 1u); break; } } } } while (0)

struct XcdBarrier {
    unsigned* bar; unsigned x;
    volatile LAS unsigned* st;
};

__device__ __forceinline__ XcdBarrier xcd_barrier_post(unsigned* bar, volatile LAS unsigned* st) {
    XcdBarrier b; b.bar = bar; b.x = xb_xcc_id(); b.st = st;
    if (threadIdx.x == 0) (void)xb_add(&bar[XB_XCNT(b.x)], 1u);
    return b;
}
__device__ __forceinline__ void xcd_barrier_complete(unsigned* bar, unsigned x, unsigned& nloc, unsigned& nx) {
    const unsigned G = gridDim.x * gridDim.y * gridDim.z;
    unsigned sum, cnt, mine, sp = 0u;
    for (;;) {
        sum = 0u; cnt = 0u; mine = 0u;
#pragma unroll
        for (unsigned j = 0; j < 16; ++j) { const unsigned c = xb_ld(&bar[XB_XCNT(j)]); sum += c; cnt += (c > 0u) ? 1u : 0u; mine = (j == x) ? c : mine; }
        if (sum == G) break;
        __builtin_amdgcn_s_sleep(1);
        if ((++sp & 255u) == 0u) { if (xb_ld(&bar[XB_TMO])) break; if (sp > XB_SPIN_CAP) { atomicAdd(&bar[XB_TMO], 1u); break; } }
    }
    nloc = mine > 0u ? mine : 1u; nx = cnt > 0u ? cnt : 1u;
}

__device__ __forceinline__ void xcd_barrier(const XcdBarrier& b) {
    asm volatile("s_waitcnt vmcnt(0)" ::: "memory");
    __syncthreads();
    if (threadIdx.x == 0) {
        unsigned* bar = b.bar;
        __builtin_amdgcn_s_waitcnt(0);
        unsigned nloc = b.st[0], nx = b.st[1];
        if (nloc == 0u) { xcd_barrier_complete(bar, b.x, nloc, nx); b.st[0] = nloc; b.st[1] = nx; }
        const unsigned old = xb_add(&bar[XB_XSUB(b.x)], 1u);
        const unsigned gen = old / nloc;
        if (old + 1u == (gen + 1u) * nloc) {
            __builtin_amdgcn_fence(__ATOMIC_RELEASE, "agent");
            asm volatile("s_waitcnt vmcnt(0)" ::: "memory");
            const unsigned og = xb_add(&bar[XB_TOP], 1u);
            const unsigned tg = og / nx;
            if (og + 1u == (tg + 1u) * nx) xb_add(&bar[XB_TOPGEN], 1u);
            else XB_SPIN(xb_ld(&bar[XB_TOPGEN]) == tg, bar);
            __builtin_amdgcn_fence(__ATOMIC_ACQUIRE, "agent");
            xb_add(&bar[XB_XGEN(b.x)], 1u);
            asm volatile("s_waitcnt vmcnt(0)" ::: "memory");
        } else {
            XB_SPIN(xb_ld(&bar[XB_XGEN(b.x)]) == gen, bar);
            __builtin_amdgcn_fence(__ATOMIC_ACQUIRE, "agent");
            asm volatile("s_waitcnt vmcnt(0)" ::: "memory");
        }
    }
    __syncthreads();
}

using pg8::Unit;
typedef f32x4 AccT[2][2][4][2];

struct EpiStore {
    const float* pscale;
    __device__ __forceinline__ void operator()(const AccT& acc, const Unit& u, int wr, int wc, int fr, int fq) const {
        asm volatile("" : "+v"(fr), "+v"(fq));
        bf16_t* base = (bf16_t*)u.O; const int ldc = u.ldc, kind = u.kind; const float sc = u.sc;
#pragma unroll
        for (int ai = 0; ai < 2; ++ai)
#pragma unroll
            for (int m = 0; m < 4; ++m) {
                bf16_t* rowp = base + (size_t)(ai * 128 + wr * 64 + m * 16 + fr) * ldc + wc * 32 + 8 * fq;
#pragma unroll
                for (int bj = 0; bj < 2; ++bj) {
                    f32x4 v0 = acc[ai][bj][m][0], v1 = acc[ai][bj][m][1];
                    if (kind == 1) {
#pragma unroll
                        for (int e = 0; e < 4; ++e) { v0[e] = siluf_(v0[e]); v1[e] = siluf_(v1[e]); }
                    } else if (kind == 2) { v0 = v0 * sc; v1 = v1 * sc; }
                    u32x4 w; w.x = pk2(v0[0], v0[1]); w.y = pk2(v0[2], v0[3]); w.z = pk2(v1[0], v1[1]); w.w = pk2(v1[2], v1[3]);
                    *(u32x4*)(rowp + bj * 128) = w;
                }
            }
    }
};
struct EpiGate {
    const float* bmerge; char* scr;
    __device__ __forceinline__ void operator()(const AccT& acc, const Unit& u, int wr, int wc, int fr, int fq) const {
        asm volatile("" : "+v"(fr), "+v"(fq));
        int tid = threadIdx.x; const int n = u.aux; asm volatile("" : "+v"(tid));
        u32x4* gst = (u32x4*)scr;
        if (u.kind == 0) {
            const float* bp = bmerge + n * 1024 + u.c0 + wc * 32 + 8 * fq;
            f32x4 bb[2][2];
#pragma unroll
            for (int bj = 0; bj < 2; ++bj) { bb[bj][0] = *(const f32x4*)(bp + bj * 128); bb[bj][1] = *(const f32x4*)(bp + bj * 128 + 4); }
#pragma unroll
            for (int bj = 0; bj < 2; ++bj) {
#pragma unroll
                for (int ai = 0; ai < 2; ++ai)
#pragma unroll
                    for (int m = 0; m < 4; ++m) {
                        const f32x4 v0 = (acc[ai][bj][m][0] + bb[bj][0]) * (-LOG2E), v1 = (acc[ai][bj][m][1] + bb[bj][1]) * (-LOG2E);
                        u32x4 w; w.x = pk2(__builtin_amdgcn_exp2f(v0[0]), __builtin_amdgcn_exp2f(v0[1])); w.y = pk2(__builtin_amdgcn_exp2f(v0[2]), __builtin_amdgcn_exp2f(v0[3]));
                        w.z = pk2(__builtin_amdgcn_exp2f(v1[0]), __builtin_amdgcn_exp2f(v1[1])); w.w = pk2(__builtin_amdgcn_exp2f(v1[2]), __builtin_amdgcn_exp2f(v1[3]));
                        gst[((ai * 2 + bj) * 4 + m) * 512 + tid] = w;
                    }
                asm volatile("" ::: "memory");
            }
        } else {
            bf16_t* base = (bf16_t*)u.O;
            u32x4* mst = (u32x4*)(scr + 131072);
#pragma unroll
            for (int ai = 0; ai < 2; ++ai) {
                u32x4 g[8], pm[8];
#pragma unroll
                for (int e = 0; e < 8; ++e) { const int si = (ai * 2 + (e & 1)) * 4 + (e >> 1); g[e] = gst[si * 512 + tid]; if (n > 0) pm[e] = mst[si * 512 + tid]; }
#pragma unroll
                for (int e = 0; e < 8; ++e) {
                    const int bj = e & 1, m = e >> 1, si = (ai * 2 + bj) * 4 + m;
                    f32x4 v0 = acc[ai][bj][m][0], v1 = acc[ai][bj][m][1];
#define GSIG(x_) fast_rcp(1.0f + (x_))
                    v0[0] *= GSIG(bflo(g[e].x)); v0[1] *= GSIG(bfhi(g[e].x)); v0[2] *= GSIG(bflo(g[e].y)); v0[3] *= GSIG(bfhi(g[e].y));
                    v1[0] *= GSIG(bflo(g[e].z)); v1[1] *= GSIG(bfhi(g[e].z)); v1[2] *= GSIG(bflo(g[e].w)); v1[3] *= GSIG(bfhi(g[e].w));
#undef GSIG
                    if (n > 0) { v0[0] += bflo(pm[e].x); v0[1] += bfhi(pm[e].x); v0[2] += bflo(pm[e].y); v0[3] += bfhi(pm[e].y);
                                 v1[0] += bflo(pm[e].z); v1[1] += bfhi(pm[e].z); v1[2] += bflo(pm[e].w); v1[3] += bfhi(pm[e].w); }
                    u32x4 w; w.x = pk2(v0[0], v0[1]); w.y = pk2(v0[2], v0[3]); w.z = pk2(v1[0], v1[1]); w.w = pk2(v1[2], v1[3]);
                    if (n < 2) mst[si * 512 + tid] = w;
                    else *(u32x4*)(base + (size_t)(ai * 128 + wr * 64 + m * 16 + fr) * 1024 + wc * 32 + 8 * fq + bj * 128) = w;
                }
                asm volatile("" ::: "memory");
            }
        }
    }
};
struct EpiOut {
    float* ss; unsigned* cnt; const float* xp; const float* xs; const float* gpost; float* out;
    __device__ __forceinline__ void operator()(const AccT& acc, const Unit& u, int wr, int wc, int fr, int fq) const {
        asm volatile("" : "+v"(fr), "+v"(fq));
        const int pm = u.r0 >> 8;
        const float* xb = (u.r0 < T_P) ? xp + (size_t)u.r0 * DM : xs + (size_t)(u.r0 - T_P) * DM;
        float* ob = out + (size_t)u.r0 * DM;
        const int colb = u.c0 + wc * 32 + 8 * fq;
        f32x4 gg[2][2], xv[4][2][2];
#pragma unroll
        for (int bj = 0; bj < 2; ++bj) { gg[bj][0] = *(const f32x4*)(gpost + colb + bj * 128); gg[bj][1] = *(const f32x4*)(gpost + colb + bj * 128 + 4); }
#pragma unroll
        for (int m = 0; m < 4; ++m) { const int row = wr * 64 + m * 16 + fr;
#pragma unroll
            for (int bj = 0; bj < 2; ++bj) { const size_t off = (size_t)row * DM + colb + bj * 128; xv[m][bj][0] = *(const f32x4*)(xb + off); xv[m][bj][1] = *(const f32x4*)(xb + off + 4); } }
#pragma unroll
        for (int ai = 0; ai < 2; ++ai)
#pragma unroll
            for (int m = 0; m < 4; ++m) {
                float s = 0.f;
#pragma unroll
                for (int bj = 0; bj < 2; ++bj) {
                    const f32x4 v0 = acc[ai][bj][m][0], v1 = acc[ai][bj][m][1];
                    s += (v0[0] * v0[0] + v0[1] * v0[1]) + (v0[2] * v0[2] + v0[3] * v0[3]) + (v1[0] * v1[0] + v1[1] * v1[1]) + (v1[2] * v1[2] + v1[3] * v1[3]);
                }
                s += __shfl_xor(s, 16); s += __shfl_xor(s, 32);
                if (fq == 0) __hip_atomic_fetch_add(ss + u.r0 + ai * 128 + wr * 64 + m * 16 + fr, s, __ATOMIC_RELAXED, __HIP_MEMORY_SCOPE_AGENT);
            }
        asm volatile("s_waitcnt vmcnt(0)" ::: "memory");
        __builtin_amdgcn_s_barrier();
        if (threadIdx.x == 0) __hip_atomic_fetch_add(cnt + pm, 1u, __ATOMIC_RELAXED, __HIP_MEMORY_SCOPE_AGENT);
        { unsigned sp = 0;
          while ((unsigned)__builtin_amdgcn_readfirstlane(__hip_atomic_load(cnt + pm, __ATOMIC_RELAXED, __HIP_MEMORY_SCOPE_AGENT)) < 4u && sp < (1u << 22)) { __builtin_amdgcn_s_sleep(2); ++sp; } }
        asm volatile("" ::: "memory");
        float sv[2][4];
#pragma unroll
        for (int ai = 0; ai < 2; ++ai)
#pragma unroll
            for (int m = 0; m < 4; ++m) sv[ai][m] = __hip_atomic_load(ss + u.r0 + ai * 128 + wr * 64 + m * 16 + fr, __ATOMIC_RELAXED, __HIP_MEMORY_SCOPE_AGENT);
#pragma unroll
        for (int ai = 0; ai < 2; ++ai) {
            if (ai == 1) {
#pragma unroll
                for (int m = 0; m < 4; ++m) { const int row = 128 + wr * 64 + m * 16 + fr;
#pragma unroll
                    for (int bj = 0; bj < 2; ++bj) { const size_t off = (size_t)row * DM + colb + bj * 128; xv[m][bj][0] = *(const f32x4*)(xb + off); xv[m][bj][1] = *(const f32x4*)(xb + off + 4); } }
            }
#pragma unroll
            for (int m = 0; m < 4; ++m) { const int row = ai * 128 + wr * 64 + m * 16 + fr;
                const float rinv = 1.0f / sqrtf(sv[ai][m] * (1.f / 1024.f) + EPS);
#pragma unroll
                for (int bj = 0; bj < 2; ++bj) { const size_t off = (size_t)row * DM + colb + bj * 128;
                    *(f32x4*)(ob + off) = xv[m][bj][0] + acc[ai][bj][m][0] * rinv * gg[bj][0];
                    *(f32x4*)(ob + off + 4) = xv[m][bj][1] + acc[ai][bj][m][1] * rinv * gg[bj][1]; } }
            asm volatile("" ::: "memory");
        }
    }
};

struct Ptrs {
    unsigned char* ws;
    __device__ __forceinline__ char* at(size_t off) const { return (char*)ws + off; }
};
struct SchedP1 {
    Ptrs P; int G, c;
    __device__ __forceinline__ bool next(int i, Unit& u) const {
        const int L = i * G + c; constexpr int N1 = 320 * 13, N2 = 18 * 4;
        if (L >= N1 + N2) return false;
        u.nt = 16; u.aux = 0; u.sc = 1.f;
        if (L < N1) {
            int pm, pn; pg8::tile_order(L, 320, 13, pm, pn);
            u.A = P.at(WS_XN) + (size_t)pm * 256 * 2048; u.B = P.at(WS_WIN) + (size_t)pn * 256 * 2048; u.r0 = pm * 256;
            size_t dst; int col, ldc = 1024, kind = 0;
            if (pn < 2) { dst = WS_ZA; col = pn * 256; }
            else if (pn < 4) { dst = WS_ZA; col = 512 + (pn - 2) * 256; kind = 1; }
            else if (pn < 6) { dst = WS_ZB; col = (pn - 4) * 256; }
            else if (pn == 6) { dst = WS_ZD; col = 0; ldc = 256; }
            else if (pn < 9) { dst = WS_ZB; col = 512 + (pn - 7) * 256; kind = 1; }
            else if (pn < 11) { dst = WS_ZC; col = (pn - 9) * 256; kind = 2; u.sc = C2_CROSS; }
            else { dst = WS_ZC; col = 512 + (pn - 11) * 256; kind = 1; }
            u.kind = kind; u.ldc = ldc; u.c0 = col; u.O = P.at(dst) + ((size_t)pm * 256 * ldc + col) * 2;
        } else {
            const int l = L - N1, pm = l >> 2, pn = l & 3;
            u.A = P.at(WS_MEMN) + (size_t)pm * 256 * 2048; u.B = P.at(WS_WMKV) + (size_t)pn * 256 * 2048; u.r0 = pm * 256; u.c0 = pn * 256;
            u.kind = 0; u.ldc = 1024; u.O = P.at(WS_MKV) + ((size_t)pm * 256 * 1024 + pn * 256) * 2;
        }
        return true;
    }
};
struct SchedMerge {
    Ptrs P; int G, c;
    __device__ __forceinline__ bool next(int i, Unit& u) const {
        const int ti = i / 6, sub = i - ti * 6; const int L = ti * G + c; if (L >= 1280) return false;
        int pm, pn; pg8::tile_order(L, 320, 4, pm, pn);
        const int n = sub >> 1; u.aux = n; u.r0 = pm * 256; u.c0 = pn * 256; u.ldc = 1024; u.sc = 1.f;
        u.O = P.at(WS_ZA) + ((size_t)pm * 256 * 1024 + pn * 256) * 2;
        if ((sub & 1) == 0) { u.kind = 0; u.nt = 16; u.A = P.at(WS_XN) + (size_t)pm * 256 * 2048; u.B = P.at(WS_WIN) + (size_t)(ZW + n * 1024 + pn * 256) * 2048; }
        else { u.kind = 1; u.nt = 8;
            u.A = P.at(n == 0 ? WS_MIX : (n == 1 ? WS_ZB : WS_ZC)) + (size_t)pm * 256 * 2048;
            u.B = P.at(n < 2 ? WS_WB01 : WS_WB2P) + ((size_t)pn * 256 * 1024 + (n == 1 ? 512 : 0)) * 2; }
        return true;
    }
};
struct SchedOut {
    Ptrs P; int G, c;
    __device__ __forceinline__ bool next(int i, Unit& u) const {
        const int L = i * G + c; if (L >= 1280) return false;
        int pm, pn; pg8::tile_order(L, 320, 4, pm, pn);
        u.A = P.at(WS_ZA) + (size_t)pm * 256 * 2048; u.B = P.at(WS_WOUT) + (size_t)pn * 256 * 2048;
        u.nt = 16; u.kind = 0; u.r0 = pm * 256; u.c0 = pn * 256; u.aux = 0; u.ldc = 1024; u.sc = 1.f;
        u.O = P.at(WS_XN) + ((size_t)pm * 256 * 1024 + pn * 256) * 2;
        return true;
    }
};

__device__ __forceinline__ void cross_attn_phase(bf16_t* ZC, const bf16_t* MKV, LAS unsigned char* lds, int vcu, int G) {
    constexpr int D = 128, KPL = 136, VPL = 260;
    const int tid = threadIdx.x, lane = tid & 63, r32 = lane & 31, hi = lane >> 5; const int wid = __builtin_amdgcn_readfirstlane(tid >> 6);
    LAS bf16_t* Ks = (LAS bf16_t*)lds;
    LAS bf16_t* Vt = (LAS bf16_t*)(lds + 256 * KPL * 2);
    LAS float* wsf = (LAS float*)(lds + 256 * KPL * 2 + D * VPL * 2) + wid * 32;
    const int i_lo = (int)((long)vcu * 1280 / G), i_hi = (int)((long)(vcu + 1) * 1280 / G);
    int loaded = -1;
    for (int I = i_lo; I < i_hi; ++I) {
        int bh, qt, row0;
        if (I < 256) { bh = I >> 5; qt = I & 31; row0 = (bh >> 2) * L_P + qt * 256; }
        else { const int J = I - 256; bh = 8 + (J >> 4); qt = J & 15; row0 = T_P + ((bh >> 2) - 2) * L_S + qt * 256; }
        const int b = bh >> 2, h = bh & 3;
        if (bh != loaded) {
            __syncthreads();
            const bf16_t* Kg = MKV + (size_t)b * NMEM * 1024 + h * 128; const bf16_t* Vg = Kg + 512;
#pragma unroll
            for (int c = 0; c < 8; ++c) { const int idx = tid + c * 512, key = idx >> 4, ch = idx & 15;
                const u32x4 kv = *(const u32x4*)(Kg + (size_t)key * 1024 + ch * 8), vv = *(const u32x4*)(Vg + (size_t)key * 1024 + ch * 8);
                *(LAS u32x4*)(Ks + key * KPL + ch * 8) = kv;
                const unsigned w[4] = {vv.x, vv.y, vv.z, vv.w};
#pragma unroll
                for (int j = 0; j < 4; ++j) { Vt[(ch * 8 + 2 * j) * VPL + key] = (bf16_t)(w[j] & 0xffffu); Vt[(ch * 8 + 2 * j + 1) * VPL + key] = (bf16_t)(w[j] >> 16); } }
            __syncthreads();
            loaded = bh;
        }
        bf16_t* Q = ZC + (size_t)(row0 + wid * 32) * 1024 + h * 128;
        bf16x8 qf[D / 16];
#pragma unroll
        for (int d0 = 0; d0 < D / 16; ++d0) qf[d0] = *(const bf16x8*)(Q + (size_t)r32 * 1024 + d0 * 16 + hi * 8);
        f32x16 o[D / 32];
#pragma unroll
        for (int dt = 0; dt < D / 32; ++dt)
#pragma unroll
            for (int r = 0; r < 16; ++r) o[dt][r] = 0.f;
        float m_run = -1e30f, l_run = 0.f;
#pragma unroll 1
        for (int kt = 0; kt < 4; ++kt) {
            f32x16 s0, s1;
#pragma unroll
            for (int r = 0; r < 16; ++r) { s0[r] = 0.f; s1[r] = 0.f; }
#pragma unroll
            for (int d0 = 0; d0 < D / 16; ++d0) {
                const bf16x8 a0 = *(const LAS bf16x8*)(Ks + (kt * 64 + r32) * KPL + d0 * 16 + hi * 8);
                const bf16x8 a1 = *(const LAS bf16x8*)(Ks + (kt * 64 + 32 + r32) * KPL + d0 * 16 + hi * 8);
                s0 = __builtin_amdgcn_mfma_f32_32x32x16_bf16(a0, qf[d0], s0, 0, 0, 0);
                s1 = __builtin_amdgcn_mfma_f32_32x32x16_bf16(a1, qf[d0], s1, 0, 0, 0);
            }
            float mx = s0[0];
#pragma unroll
            for (int r = 0; r < 16; ++r) { mx = fmaxf(mx, s0[r]); mx = fmaxf(mx, s1[r]); }
            mx = fmaxf(mx, __shfl_xor(mx, 32));
            const float m_new = fmaxf(m_run, mx);
            const float alpha = __builtin_amdgcn_exp2f(m_run - m_new);
            m_run = m_new;
            float rs = 0.f;
#pragma unroll
            for (int r = 0; r < 16; ++r) { s0[r] = __builtin_amdgcn_exp2f(s0[r] - m_new); s1[r] = __builtin_amdgcn_exp2f(s1[r] - m_new); rs += s0[r] + s1[r]; }
            l_run = l_run * alpha + rs;
            if (kt > 0) {
                __builtin_amdgcn_wave_barrier();
                if (hi == 0) wsf[r32] = alpha;
                __builtin_amdgcn_fence(__ATOMIC_RELEASE, "wavefront"); __builtin_amdgcn_wave_barrier(); __builtin_amdgcn_fence(__ATOMIC_ACQUIRE, "wavefront");
#pragma unroll
                for (int r = 0; r < 16; ++r) { const float a = wsf[crow(r, hi)];
#pragma unroll
                    for (int dt = 0; dt < D / 32; ++dt) o[dt][r] *= a; }
            }
            bf16x8 pw[4];
            { u32x4 p;
              p.x = pk2(s0[0], s0[1]); p.y = pk2(s0[2], s0[3]); p.z = pk2(s0[4], s0[5]); p.w = pk2(s0[6], s0[7]); pw[0] = __builtin_bit_cast(bf16x8, p);
              p.x = pk2(s0[8], s0[9]); p.y = pk2(s0[10], s0[11]); p.z = pk2(s0[12], s0[13]); p.w = pk2(s0[14], s0[15]); pw[1] = __builtin_bit_cast(bf16x8, p);
              p.x = pk2(s1[0], s1[1]); p.y = pk2(s1[2], s1[3]); p.z = pk2(s1[4], s1[5]); p.w = pk2(s1[6], s1[7]); pw[2] = __builtin_bit_cast(bf16x8, p);
              p.x = pk2(s1[8], s1[9]); p.y = pk2(s1[10], s1[11]); p.z = pk2(s1[12], s1[13]); p.w = pk2(s1[14], s1[15]); pw[3] = __builtin_bit_cast(bf16x8, p); }
#pragma unroll
            for (int dt = 0; dt < D / 32; ++dt)
#pragma unroll
                for (int ks = 0; ks < 4; ++ks) {
                    const LAS bf16_t* vp = Vt + (dt * 32 + r32) * VPL + kt * 64 + 16 * ks + 4 * hi;
                    const s16x4 lo = *(const LAS s16x4*)vp, hh = *(const LAS s16x4*)(vp + 8);
                    const bf16x8 bb = __builtin_shufflevector(lo, hh, 0, 1, 2, 3, 4, 5, 6, 7);
                    o[dt] = __builtin_amdgcn_mfma_f32_32x32x16_bf16(pw[ks], bb, o[dt], 0, 0, 0);
                }
        }
        l_run += __shfl_xor(l_run, 32);
        __builtin_amdgcn_wave_barrier();
        if (hi == 0) wsf[r32] = fast_rcp(l_run);
        __builtin_amdgcn_fence(__ATOMIC_RELEASE, "wavefront"); __builtin_amdgcn_wave_barrier(); __builtin_amdgcn_fence(__ATOMIC_ACQUIRE, "wavefront");
#pragma unroll
        for (int r = 0; r < 16; ++r) {
            const int row = crow(r, hi); const float inv = wsf[row];
#pragma unroll
            for (int dt = 0; dt < D / 32; ++dt) {
                const int col = dt * 32 + r32;
                const float g = __builtin_bit_cast(float, (unsigned)Q[(size_t)row * 1024 + 512 + col] << 16);
                Q[(size_t)row * 1024 + col] = (bf16_t)f2bf(o[dt][r] * inv * g);
            }
        }
        __builtin_amdgcn_wave_barrier();
    }
    __syncthreads();
}

__device__ __forceinline__ void transpose_item(const float* W, int ldw, int nblk, bf16_t* WT, LAS float* scr, int item, int lane) {
    const int kb = item / nblk, nb = item % nblk, k0 = 64 * kb, n0 = 32 * nb;
#pragma unroll 8
    for (int i = 0; i < 32; ++i) { const int kk = 2 * i + (lane >> 5); scr[kk * 33 + (lane & 31)] = W[(size_t)(k0 + kk) * ldw + n0 + (lane & 31)]; }
    asm volatile("s_waitcnt lgkmcnt(0)" ::: "memory");
    const int c = lane & 7;
#pragma unroll
    for (int j = 0; j < 4; ++j) { const int n = (lane >> 3) + 8 * j; const LAS float* s = scr + (8 * c) * 33 + n;
        u32x4 o; o.x = pk2(s[0 * 33], s[1 * 33]); o.y = pk2(s[2 * 33], s[3 * 33]); o.z = pk2(s[4 * 33], s[5 * 33]); o.w = pk2(s[6 * 33], s[7 * 33]);
        *(u32x4*)(WT + (size_t)(n0 + n) * 1024 + k0 + 8 * c) = o; }
    asm volatile("s_waitcnt lgkmcnt(0)" ::: "memory");
}
__device__ __forceinline__ void rms_row_to_bf16(const float* xrow, const float* g, bf16_t* orow, int lane) {
    const f32x4* xr = (const f32x4*)xrow + lane; const f32x4* gr = (const f32x4*)g + lane;
    f32x4 v[4]; float s = 0.f;
#pragma unroll
    for (int j = 0; j < 4; ++j) { v[j] = xr[64 * j]; s += (v[j].x * v[j].x + v[j].y * v[j].y) + (v[j].z * v[j].z + v[j].w * v[j].w); }
    const float rinv = 1.0f / sqrtf(wave_sum(s) * (1.f / 1024.f) + EPS);
    u32x2* o8 = (u32x2*)orow + lane;
#pragma unroll
    for (int j = 0; j < 4; ++j) { const f32x4 gg = gr[64 * j]; u32x2 w; w.x = pk2(v[j].x * rinv * gg.x, v[j].y * rinv * gg.y); w.y = pk2(v[j].z * rinv * gg.z, v[j].w * rinv * gg.w); o8[64 * j] = w; }
}

__device__ __forceinline__ void rms_row2_to_bf16(const float* xa, const float* xb, const float* g, bf16_t* oa, bf16_t* ob, int lane) {
    const f32x4* ra = (const f32x4*)xa + lane; const f32x4* rb = (const f32x4*)xb + lane; const f32x4* gr = (const f32x4*)g + lane;
    f32x4 va[4], vb[4]; float sa = 0.f, sb = 0.f;
#pragma unroll
    for (int j = 0; j < 4; ++j) { va[j] = ra[64 * j]; vb[j] = rb[64 * j]; }
#pragma unroll
    for (int j = 0; j < 4; ++j) { sa += (va[j].x * va[j].x + va[j].y * va[j].y) + (va[j].z * va[j].z + va[j].w * va[j].w); sb += (vb[j].x * vb[j].x + vb[j].y * vb[j].y) + (vb[j].z * vb[j].z + vb[j].w * vb[j].w); }
#pragma unroll
    for (int o = 1; o < 64; o <<= 1) { sa += __shfl_xor(sa, o); sb += __shfl_xor(sb, o); }
    const float ia = 1.0f / sqrtf(sa * (1.f / 1024.f) + EPS), ib = 1.0f / sqrtf(sb * (1.f / 1024.f) + EPS);
    u32x2* pa = (u32x2*)oa + lane; u32x2* pb = (u32x2*)ob + lane;
#pragma unroll
    for (int j = 0; j < 4; ++j) { const f32x4 gg = gr[64 * j]; u32x2 w;
        w.x = pk2(va[j].x * ia * gg.x, va[j].y * ia * gg.y); w.y = pk2(va[j].z * ia * gg.z, va[j].w * ia * gg.w); pa[64 * j] = w;
        w.x = pk2(vb[j].x * ib * gg.x, vb[j].y * ib * gg.y); w.y = pk2(vb[j].z * ib * gg.z, vb[j].w * ib * gg.w); pb[64 * j] = w; }
}

__device__ __forceinline__ void rms_row4_to_bf16(const float* x0, const float* x1, const float* x2, const float* x3, const float* g, bf16_t* o0, bf16_t* o1, bf16_t* o2, bf16_t* o3, int lane) {
    const f32x4* r[4] = {(const f32x4*)x0 + lane, (const f32x4*)x1 + lane, (const f32x4*)x2 + lane, (const f32x4*)x3 + lane}; const f32x4* gr = (const f32x4*)g + lane;
    u32x2* po[4] = {(u32x2*)o0 + lane, (u32x2*)o1 + lane, (u32x2*)o2 + lane, (u32x2*)o3 + lane};
    f32x4 v[4][4]; float sq[4] = {0.f, 0.f, 0.f, 0.f};
#pragma unroll
    for (int q = 0; q < 4; ++q)
#pragma unroll
        for (int j = 0; j < 4; ++j) v[q][j] = __builtin_nontemporal_load(r[q] + 64 * j);
#pragma unroll
    for (int q = 0; q < 4; ++q)
#pragma unroll
        for (int j = 0; j < 4; ++j) sq[q] += (v[q][j].x * v[q][j].x + v[q][j].y * v[q][j].y) + (v[q][j].z * v[q][j].z + v[q][j].w * v[q][j].w);
#pragma unroll
    for (int o = 1; o < 64; o <<= 1) { sq[0] += __shfl_xor(sq[0], o); sq[1] += __shfl_xor(sq[1], o); sq[2] += __shfl_xor(sq[2], o); sq[3] += __shfl_xor(sq[3], o); }
#pragma unroll
    for (int j = 0; j < 4; ++j) { const f32x4 gg = gr[64 * j];
#pragma unroll
        for (int q = 0; q < 4; ++q) { const float iv = 1.0f / sqrtf(sq[q] * (1.f / 1024.f) + EPS); u32x2 w;
            w.x = pk2(v[q][j].x * iv * gg.x, v[q][j].y * iv * gg.y); w.y = pk2(v[q][j].z * iv * gg.z, v[q][j].w * iv * gg.w); po[q][64 * j] = w; } }
}

struct Args { const float* in[16]; float* out; unsigned char* ws; };

__global__ void __launch_bounds__(512) fwd_megakernel(Args args) {
    extern __shared__ __attribute__((aligned(16))) unsigned char lds_raw[];
    LAS unsigned char* lds = (LAS unsigned char*)lds_raw;
    cg::grid_group grid = cg::this_grid();
    volatile LAS unsigned* xb_st = (volatile LAS unsigned*)(lds + LDS_BYTES - 16);
    if (threadIdx.x == 0) { xb_st[0] = 0u; xb_st[1] = 0u; }
    __syncthreads();
    const XcdBarrier xbar = xcd_barrier_post((unsigned*)(args.ws + WS_BAR), xb_st);
    const int tid = threadIdx.x, lane = tid & 63; const int wave = __builtin_amdgcn_readfirstlane(tid >> 6);
    const int G = gridDim.x, bx = blockIdx.x;
    const int vcu = (G % 8 == 0) ? (bx % 8) * (G / 8) + bx / 8 : bx;
    const int gw = vcu * NWAVES + wave, NGW = G * NWAVES;
    unsigned char* ws = args.ws; Ptrs P{ws};
    const float* x_prompt = args.in[0]; const float* x_sample = args.in[1]; const float* mem_prompt = args.in[2]; const float* mem_sample = args.in[3];
    const float* ln_pre = args.in[4]; const float* ln_post = args.in[5]; const float* ln_mem = args.in[6]; const float* w_in = args.in[7];
    const float* b_merge = args.in[8]; const float* q_norm = args.in[9]; const float* k_norm = args.in[10]; const float* w_pool = args.in[11];
    const float* pool_scale = args.in[12]; const float* w_mem_kv = args.in[13]; const float* w_branch = args.in[14]; const float* w_out = args.in[15];
    bf16_t* XN = (bf16_t*)(ws + WS_XN); bf16_t* ZA = (bf16_t*)(ws + WS_ZA); bf16_t* ZB = (bf16_t*)(ws + WS_ZB); bf16_t* ZC = (bf16_t*)(ws + WS_ZC);
    bf16_t* ZD = (bf16_t*)(ws + WS_ZD); bf16_t* MIX = (bf16_t*)(ws + WS_MIX); bf16_t* MEMN = (bf16_t*)(ws + WS_MEMN); bf16_t* MKV = (bf16_t*)(ws + WS_MKV);
    float* SS = (float*)(ws + WS_SS);

    {
        LAS float* scr = (LAS float*)(lds + wave * 16384);
        constexpr int I_IN = 16 * 184, I_SQ = 16 * 32, I_BR = 8 * 32;
        constexpr int NITEMS = I_IN + 2 * I_SQ + 3 * I_BR;
        for (int it = gw; it < NITEMS; it += NGW) {
            int r = it;
            if (r < I_IN) { transpose_item(w_in + 512, IN_DIM, 184, (bf16_t*)(ws + WS_WIN) + (size_t)512 * 1024, scr, r, lane); continue; } r -= I_IN;
            if (r < I_SQ) { transpose_item(w_mem_kv, 1024, 32, (bf16_t*)(ws + WS_WMKV), scr, r, lane); continue; } r -= I_SQ;
            if (r < I_SQ) { transpose_item(w_out, 1024, 32, (bf16_t*)(ws + WS_WOUT), scr, r, lane); continue; } r -= I_SQ;
            if (r < 3 * I_BR) { const int n = r / I_BR; r -= n * I_BR;
                transpose_item(w_branch + (size_t)n * 512 * 1024, 1024, 32, (bf16_t*)(ws + (n < 2 ? WS_WB01 : WS_WB2P)) + (n == 1 ? 512 : 0), scr, r, lane); continue; }
        }
        for (int it = NGW - 1 - gw; it < 128 * 4 * 2; it += NGW) {
            const int kb = it >> 3, g = (it >> 1) & 3, dh = it & 1, d = dh * 64 + lane;
            const float* wi = w_in + (size_t)(kb * 8) * IN_DIM + g * 128; const float* wp = w_pool + (size_t)g * 128 * 128 + d;
            float a8[8] = {0.f, 0.f, 0.f, 0.f, 0.f, 0.f, 0.f, 0.f};
#pragma unroll 4
            for (int c = 0; c < 128; ++c) { const float b = wp[(size_t)c * 128];
#pragma unroll
                for (int kk = 0; kk < 8; ++kk) a8[kk] += wi[(size_t)kk * IN_DIM + c] * b; }
            u32x4 o; o.x = pk2(a8[0], a8[1]); o.y = pk2(a8[2], a8[3]); o.z = pk2(a8[4], a8[5]); o.w = pk2(a8[6], a8[7]);
            *(u32x4*)((bf16_t*)(ws + WS_WIN) + (size_t)(g * 128 + d) * 1024 + kb * 8) = o;
        }
        for (int m = gw; m < T; m += 4 * NGW) {
            const float* xr[4]; int mr[4];
#pragma unroll
            for (int q = 0; q < 4; ++q) { const int mq = m + q * NGW; mr[q] = (mq < T) ? mq : m; xr[q] = (mr[q] < T_P) ? x_prompt + (size_t)mr[q] * DM : x_sample + (size_t)(mr[q] - T_P) * DM; }
            rms_row4_to_bf16(xr[0], xr[1], xr[2], xr[3], ln_pre, XN + (size_t)mr[0] * DM, XN + (size_t)mr[1] * DM, XN + (size_t)mr[2] * DM, XN + (size_t)mr[3] * DM, lane);
        }
        for (int m = gw; m < MEMROWS; m += NGW) { const float* xr = (m < 2 * NMEM) ? mem_prompt + (size_t)m * DM : mem_sample + (size_t)(m - 2 * NMEM) * DM; rms_row_to_bf16(xr, ln_mem, MEMN + (size_t)m * DM, lane); }
        for (int i = bx * 512 + tid; i < T; i += G * 512) SS[i] = 0.f;
        if (bx == 0 && tid < 320) ((unsigned*)(ws + WS_CNT))[tid] = 0u;
    }
    grid.sync();

    { SchedP1 S{P, G, bx}; EpiStore E{pool_scale}; pg8::gemm_phase(lds, S, E); }
#if DUP_MASK & 1
    __syncthreads();
    { SchedP1 S{P, G, bx}; EpiStore E{pool_scale}; pg8::gemm_phase(lds, S, E); }
#endif
    xcd_barrier(xbar);

    {
        for (int base = gw * 8; base < T * 2; base += NGW * 8 * 8) {
            u32x4 raw4[8];
#pragma unroll
            for (int uu = 0; uu < 8; ++uu) { const int it = base + uu * NGW * 8 + (lane >> 3);
                if (it < T * 2) { const int tok = it >> 1, hh = 8 + (it & 1), sub = lane & 7;
                    const bf16_t* ptr = (hh < 8) ? ZB + (size_t)tok * 1024 + hh * 64 + sub * 8 : ZD + (size_t)tok * 256 + (hh - 8) * 64 + sub * 8;
                    raw4[uu] = *(const u32x4*)ptr; } else raw4[uu] = (u32x4){0u, 0u, 0u, 0u}; }
#pragma unroll
            for (int uu = 0; uu < 8; ++uu) {
                const int it = base + uu * NGW * 8 + (lane >> 3);
                const bool ok = it < T * 2;
                const int tok = it >> 1, hh = 8 + (it & 1), sub = lane & 7;
                bf16_t* ptr = (hh < 8) ? ZB + (size_t)tok * 1024 + hh * 64 + sub * 8 : ZD + (size_t)tok * 256 + (hh - 8) * 64 + sub * 8;
                const u32x4 raw = raw4[uu];
                float v[8] = {bflo(raw.x), bfhi(raw.x), bflo(raw.y), bfhi(raw.y), bflo(raw.z), bfhi(raw.z), bflo(raw.w), bfhi(raw.w)};
                float ssq = 0.f;
#pragma unroll
                for (int j = 0; j < 8; ++j) ssq += v[j] * v[j];
                ssq += __shfl_xor(ssq, 1); ssq += __shfl_xor(ssq, 2); ssq += __shfl_xor(ssq, 4);
                const float rinv = 1.0f / sqrtf(ssq * (1.f / 64.f) + EPS);
                const float* gn = ((hh < 8) ? q_norm : k_norm) + sub * 8;
                const int tl = (tok < T_P) ? (tok & (L_P - 1)) : ((tok - T_P) & (L_S - 1));
                const float pos = (sub < 4) ? (float)(tl >> 6) : (float)(tl & 63);
                const float osc = (hh < 8) ? C2_SELF : 1.0f;
                float o[8];
#pragma unroll
                for (int jj = 0; jj < 4; ++jj) {
                    const int fi = (sub & 3) * 4 + jj;
                    const float inv = __builtin_amdgcn_exp2f(-(float)(2 * fi) * (13.287712379549449f / 32.0f));
                    const float rev = pos * inv * 0.15915494309189535f;
                    const float cs = __builtin_amdgcn_cosf(rev), sn = __builtin_amdgcn_sinf(rev);
                    const float y0 = v[2 * jj] * rinv * gn[2 * jj], y1 = v[2 * jj + 1] * rinv * gn[2 * jj + 1];
                    o[2 * jj] = (y0 * cs - y1 * sn) * osc; o[2 * jj + 1] = (y0 * sn + y1 * cs) * osc;
                }
                u32x4 w; w.x = pk2(o[0], o[1]); w.y = pk2(o[2], o[3]); w.z = pk2(o[4], o[5]); w.w = pk2(o[6], o[7]);
                if (ok) *(u32x4*)ptr = w;
            }
        }
        for (int it = gw; it < 4 * (T / 32); it += NGW) {
            const int g = (it + it / NGW) & 3, tok0 = ((it >> 2) * 4 + (lane >> 4)) * 8, col = g * 128 + (lane & 15) * 8;
            const int Lq = (tok0 < T_P) ? L_P : L_S; const int tl0 = (tok0 < T_P) ? (tok0 & (L_P - 1)) : ((tok0 - T_P) & (L_S - 1));
            const bf16_t* bp = ZA + (size_t)tok0 * 1024 + col;
            const f32x4 p0 = *(const f32x4*)(pool_scale + col), p1 = *(const f32x4*)(pool_scale + col + 4);
            u32x4 gt[4];
#pragma unroll
            for (int i = 0; i < 4; ++i) gt[i] = *(const u32x4*)(bp + (size_t)i * 1024 + 512);
#define UNP(V_, F_) { F_[0] = bflo((V_).x); F_[1] = bfhi((V_).x); F_[2] = bflo((V_).y); F_[3] = bfhi((V_).y); F_[4] = bflo((V_).z); F_[5] = bfhi((V_).z); F_[6] = bflo((V_).w); F_[7] = bfhi((V_).w); }
#define MK(j_) (((unsigned)(tl0 - W_ / 2 + (j_)) < (unsigned)Lq) ? 1.f : 0.f)
#define POOL_RUN(WW) { constexpr int W_ = WW; constexpr int NR = 8 + W_ - 1; u32x4 rw[NR]; \
                _Pragma("unroll") for (int j = 0; j < NR; ++j) { const bool ok = (unsigned)(tl0 - W_ / 2 + j) < (unsigned)Lq; rw[j] = *(const u32x4*)(bp + (ok ? (j - W_ / 2) : 0) * 1024); } \
                float sm[8] = {0.f, 0.f, 0.f, 0.f, 0.f, 0.f, 0.f, 0.f}; float cnt = 0.f; \
                _Pragma("unroll") for (int j = 0; j < W_; ++j) { float f[8]; UNP(rw[j], f); const float mk = MK(j); cnt += mk; _Pragma("unroll") for (int e = 0; e < 8; ++e) sm[e] += mk * f[e]; } \
                _Pragma("unroll") for (int i = 0; i < 8; ++i) { \
                    const float ic = 1.0f / cnt; float c[8], gg[8]; UNP(rw[i + W_ / 2], c); UNP(gt[i & 3], gg); \
                    if (i == 3) { _Pragma("unroll") for (int q = 0; q < 4; ++q) gt[q] = *(const u32x4*)(bp + (size_t)(4 + q) * 1024 + 512); } \
                    u32x4 wv; wv.x = pk2((sm[0] * ic - c[0]) * p0.x * gg[0], (sm[1] * ic - c[1]) * p0.y * gg[1]); \
                    wv.y = pk2((sm[2] * ic - c[2]) * p0.z * gg[2], (sm[3] * ic - c[3]) * p0.w * gg[3]); \
                    wv.z = pk2((sm[4] * ic - c[4]) * p1.x * gg[4], (sm[5] * ic - c[5]) * p1.y * gg[5]); \
                    wv.w = pk2((sm[6] * ic - c[6]) * p1.z * gg[6], (sm[7] * ic - c[7]) * p1.w * gg[7]); \
                    *(u32x4*)(MIX + (size_t)(tok0 + i) * 1024 + col) = wv; \
                    if (i < 7) { float fa[8], fs[8]; UNP(rw[i + W_], fa); UNP(rw[i], fs); const float ma = MK(i + W_), ms = MK(i); cnt += ma - ms; \
                        _Pragma("unroll") for (int e = 0; e < 8; ++e) sm[e] += ma * fa[e] - ms * fs[e]; } } }
            if (g == 0) POOL_RUN(2) else if (g == 1) POOL_RUN(4) else if (g == 2) POOL_RUN(8) else POOL_RUN(16)
#undef POOL_RUN
#undef MK
#undef UNP
        }
        cross_attn_phase(ZC, MKV, lds, vcu, G);
    }
    xcd_barrier(xbar);

    {
        for (int L = vcu; L < 2560; L += G) {
            int row0, Lq, kvh, hq, qb;
            if (L < 2048) { const int grp = L >> 6, ui = L & 63; const int seq = grp >> 1; kvh = grp & 1; hq = ui >> 4; qb = ui & 15; row0 = T_P + seq * L_S; Lq = L_S; }
            else { const int p = L - 2048, grp = p >> 7, ui = p & 127; const int seq = grp >> 1; kvh = grp & 1; hq = ui >> 5; qb = ui & 31; row0 = seq * L_P; Lq = L_P; }
            const int h = kvh * 4 + hq;
            bf16_t* Qp = ZB + (size_t)(row0 + qb * 256) * 1024 + h * 64;
            const bf16_t* Kp = ZD + (size_t)row0 * 256 + kvh * 64;
#if DUP_MASK & 2
            attn_body::attn_unit<8>((const attn_body::bf16*)Qp, (const attn_body::bf16*)Kp, (const attn_body::bf16*)(Kp + 128), Lq / 64, (const attn_body::bf16*)(Qp + 512), (attn_body::bf16*)(ws + WS_SCR + (size_t)bx * SCR_PER_BLOCK), (char*)lds_raw, q_norm, qb * 256);
#endif
            attn_body::attn_unit<8>((const attn_body::bf16*)Qp, (const attn_body::bf16*)Kp, (const attn_body::bf16*)(Kp + 128), Lq / 64, (const attn_body::bf16*)(Qp + 512), (attn_body::bf16*)Qp, (char*)lds_raw, q_norm, qb * 256);
        }
    }
    xcd_barrier(xbar);

    { SchedMerge S{P, G, bx}; EpiGate E{b_merge, (char*)ws + WS_SCR + (size_t)bx * SCR_PER_BLOCK}; pg8::gemm_phase(lds, S, E); }
#if DUP_MASK & 4
    __syncthreads();
    { SchedMerge S{P, G, bx}; EpiGate E{b_merge, (char*)ws + WS_SCR + (size_t)bx * SCR_PER_BLOCK}; pg8::gemm_phase(lds, S, E); }
#endif
    xcd_barrier(xbar);

    { SchedOut S{P, G, bx}; EpiOut E{SS, (unsigned*)(ws + WS_CNT), x_prompt, x_sample, ln_post, args.out}; pg8::gemm_phase(lds, S, E); }
}

extern "C" void kernel_launch(void* const* d_in, const int* in_sizes, int n_in, void* d_out, int out_size, void* d_ws, size_t ws_size, hipStream_t stream) {
    static int grid_blocks = 0;
    if (grid_blocks == 0) {
        if (n_in != 16 || out_size != T * DM || ws_size < WS_END) { fprintf(stderr, "kernel_launch: unexpected shapes (n_in %d out %d ws %zu need %zu)\n", n_in, out_size, ws_size, (size_t)WS_END); grid_blocks = -1; return; }
        int dev = 0, cus = 0, per_cu = 0;
        hipGetDevice(&dev);
        hipDeviceGetAttribute(&cus, hipDeviceAttributeMultiprocessorCount, dev);
        if (hipFuncSetAttribute((const void*)fwd_megakernel, hipFuncAttributeMaxDynamicSharedMemorySize, LDS_BYTES) != hipSuccess) { fprintf(stderr, "kernel_launch: hipFuncSetAttribute failed\n"); grid_blocks = -1; return; }
        if (hipOccupancyMaxActiveBlocksPerMultiprocessor(&per_cu, (const void*)fwd_megakernel, 512, LDS_BYTES) != hipSuccess || per_cu < 1) { fprintf(stderr, "kernel_launch: occupancy query failed (%d)\n", per_cu); (void)hipGetLastError(); per_cu = 1; }
        grid_blocks = cus * 1;
        if (grid_blocks > 256) grid_blocks = 256;
    }
    if (grid_blocks < 0) return;
    if (hipMemsetAsync((char*)d_ws + WS_BAR, 0, XCD_BAR_WORDS * 4, stream) != hipSuccess) { fprintf(stderr, "kernel_launch: hipMemsetAsync failed\n"); return; }
    Args a{};
    for (int i = 0; i < 16; ++i) a.in[i] = (const float*)d_in[i];
    a.out = (float*)d_out; a.ws = (unsigned char*)d_ws;
    void* kargs[] = {&a};
    hipError_t e = hipLaunchCooperativeKernel((const void*)fwd_megakernel, dim3(grid_blocks), dim3(512), kargs, LDS_BYTES, stream);
    if (e != hipSuccess) fprintf(stderr, "cooperative launch failed: %s (grid %d)\n", hipGetErrorString(e), grid_blocks);
}
```

```cpp
#include <hip/hip_runtime.h>
#include <hip/hip_cooperative_groups.h>
#include <cstdio>
#include <cstdint>
#include <cmath>
#include <hip/hip_bf16.h>
namespace cg = cooperative_groups;
#ifndef DUP_MASK
#define DUP_MASK 0
#endif

#define LAS __attribute__((address_space(3)))
typedef unsigned short bf16_t;
typedef short bf16x8 __attribute__((ext_vector_type(8)));
typedef short s16x4 __attribute__((ext_vector_type(4)));
typedef float f32x4 __attribute__((ext_vector_type(4)));
typedef float f32x16 __attribute__((ext_vector_type(16)));
typedef unsigned u32x4 __attribute__((ext_vector_type(4)));
typedef unsigned u32x2 __attribute__((ext_vector_type(2)));
typedef float f32x2_t __attribute__((ext_vector_type(2)));
typedef __bf16 bf16x2_t __attribute__((ext_vector_type(2)));

constexpr int DM = 1024;
constexpr int T_P = 2 * 8192, T_S = 16 * 4096, T = T_P + T_S;
constexpr int L_P = 8192, L_S = 4096;
constexpr int NMEM = 256, MEMROWS = 18 * NMEM;
constexpr int IN_DIM = 6400, ZW = 3328;
constexpr float EPS = 1e-6f;
constexpr float LOG2E = 1.4426950408889634f;
constexpr float C2_SELF = 0.125f * LOG2E;
constexpr float C2_CROSS = 0.08838834764831845f * LOG2E;

constexpr size_t MiB = 1u << 20;
constexpr size_t TB = (size_t)T * 1024 * 2;
constexpr size_t WS_SS = 0;
constexpr size_t WS_CNT = 512 * 1024;
constexpr size_t WS_BAR = 768 * 1024;
constexpr size_t WS_WIN = 1 * MiB;
constexpr size_t WS_WMKV = 14 * MiB, WS_WOUT = 16 * MiB, WS_WB01 = 18 * MiB, WS_WB2P = 20 * MiB;
constexpr size_t WS_MEMN = 22 * MiB, WS_MKV = 31 * MiB;
constexpr size_t WS_XN = 40 * MiB;
constexpr size_t WS_ZA = WS_XN + TB, WS_ZB = WS_ZA + TB, WS_ZC = WS_ZB + TB;
constexpr size_t WS_ZD = WS_ZC + TB;
constexpr size_t WS_MIX = WS_ZD + (size_t)T * 256 * 2;
constexpr size_t WS_SCR = WS_MIX + TB;
constexpr size_t SCR_PER_BLOCK = 256 * 1024;
constexpr size_t WS_END = WS_SCR + 256 * SCR_PER_BLOCK;
static_assert(WS_END <= 1024 * MiB, "workspace map");

constexpr int LDS_BYTES = 139264;
constexpr int NWAVES = 8;

__device__ __forceinline__ unsigned f2bf(float f) { unsigned u = __builtin_bit_cast(unsigned, f); return (u + 0x7fffu + ((u >> 16) & 1u)) >> 16; }
__device__ __forceinline__ unsigned pk2(float lo, float hi) { f32x2_t v = {lo, hi}; bf16x2_t b = __builtin_convertvector(v, bf16x2_t); return __builtin_bit_cast(unsigned, b); }
__device__ __forceinline__ float bflo(unsigned w) { return __builtin_bit_cast(float, w << 16); }
__device__ __forceinline__ float bfhi(unsigned w) { return __builtin_bit_cast(float, w & 0xffff0000u); }
__device__ __forceinline__ float fast_rcp(float x) { return __builtin_amdgcn_rcpf(x); }
__device__ __forceinline__ float sigmoidf_(float x) { return fast_rcp(1.0f + __builtin_amdgcn_exp2f(-x * LOG2E)); }
__device__ __forceinline__ float siluf_(float x) { return x * sigmoidf_(x); }
__device__ __forceinline__ float wave_sum(float v) {
#pragma unroll
    for (int o = 1; o < 64; o <<= 1) v += __shfl_xor(v, o);
    return v;
}
__device__ __forceinline__ int crow(int r, int hi) { return (r & 3) + 8 * (r >> 2) + 4 * hi; }

namespace pg8 {
constexpr int BM = 256, BK = 64, HALF = 128, HTB = HALF * BK * 2, STAGE_BYTES = 8 * HTB, NXCD = 8, WGM = 8;
constexpr int KP = 1024;
__device__ __forceinline__ int lds_byte(int r, int c) { const int st = (r >> 4) * 2 + (c >> 5), rr = r & 15, cc = c & 31, ob = rr * 64 + cc * 2; return st * 1024 + (ob ^ (((ob >> 9) & 1) << 5)); }
__device__ __forceinline__ void stage_rc(int b, int& R, int& C) { const int st = b / 1024, sb = b % 1024, swz = sb ^ (((sb >> 9) & 1) << 5); R = (st >> 1) * 16 + swz / 64; C = (st & 1) * 32 + (swz % 64) / 2; }
__device__ __forceinline__ int perm32(int rho) { const int n = rho >> 4, i = rho & 15; return 8 * (i >> 2) + 4 * n + (i & 3); }

struct Unit { const char* A; const char* B; int nt; int kind; int r0; int c0; int aux; char* O; int ldc; float sc; };

__device__ __forceinline__ void tile_order(int L, int nM, int nN, int& pm, int& pn) {
    const int nwg = nM * nN; int wgid = L;
    { const int q = nwg / NXCD, r = nwg % NXCD, xcd = wgid % NXCD, off = wgid / NXCD; wgid = (xcd < r ? xcd * (q + 1) : r * (q + 1) + (xcd - r) * q) + off; }
    const int nig = WGM * nN, gid = wgid / nig, fm = gid * WGM, gsz = (nM - fm) < WGM ? (nM - fm) : WGM;
    pm = fm + ((wgid % nig) % gsz); pn = (wgid % nig) / gsz;
}

template <class Epi, class Sched>
__device__ __forceinline__ void gemm_phase(LAS unsigned char* lds, const Sched& S, const Epi& E) {
    constexpr bool ALIGN_EPI = true;
    int tid = threadIdx.x; asm volatile("" : "+v"(tid));
    const int wid = __builtin_amdgcn_readfirstlane(tid >> 6), lane = tid & 63, wr = wid >> 2, wc = wid & 3, fr = lane & 15, fq = lane >> 4;
    const int K = KP;
    unsigned voffA[2], voffB[2];
#pragma unroll
    for (int i = 0; i < 2; ++i) { int R, C; stage_rc(tid * 16 + i * 8192, R, C); const int Rb = (R & ~31) + perm32(R & 31);
        voffA[i] = (unsigned)(R * K + C) * 2u; voffB[i] = (unsigned)(Rb * K + C) * 2u; }
    const size_t kstep = (size_t)(BK * 2);
    const size_t hstep = (size_t)HALF * K * 2;
    const unsigned ldsw = (unsigned)wid * 1024u;
    const int aoff = lds_byte(wr * 64 + fr, fq * 8), boff = lds_byte(wc * 32 + fr, fq * 8);
#define PG8_SA(b, h) (((b) * 2 + (h)) * HTB)
#define PG8_SB(b, h) ((4 + (b) * 2 + (h)) * HTB)
#define PG8_STAGE(bufoff, gbase, voff) do { _Pragma("unroll") for (int _i = 0; _i < 2; ++_i) \
        __builtin_amdgcn_global_load_lds((const unsigned*)((const char*)(gbase) + (voff)[_i]), (LAS unsigned*)(lds + (bufoff) + ldsw + _i * 8192), 16, 0, 0); } while (0)
#define PG8_LDA(dst, b, h) do { _Pragma("unroll") for (int m = 0; m < 4; ++m) _Pragma("unroll") for (int k = 0; k < 2; ++k) dst[m][k] = *(const LAS bf16x8*)(lds + PG8_SA(b, h) + aoff + m * 2048 + k * 1024); } while (0)
#define PG8_LDB(dst, b, h) do { _Pragma("unroll") for (int n = 0; n < 2; ++n) _Pragma("unroll") for (int k = 0; k < 2; ++k) dst[n][k] = *(const LAS bf16x8*)(lds + PG8_SB(b, h) + boff + n * 2048 + k * 1024); } while (0)
#define PG8_MMA(ai, bj, At, Bt) do { __builtin_amdgcn_s_setprio(1); _Pragma("unroll") for (int m = 0; m < 4; ++m) _Pragma("unroll") for (int n = 0; n < 2; ++n) _Pragma("unroll") for (int k = 0; k < 2; ++k) \
        acc[ai][bj][m][n] = __builtin_amdgcn_mfma_f32_16x16x32_bf16(Bt[n][k], At[m][k], acc[ai][bj][m][n], 0, 0, 0); __builtin_amdgcn_s_setprio(0); } while (0)
#define PG8_WAIT_V(n) asm volatile("s_waitcnt vmcnt(" #n ")" ::: "memory")
#define PG8_WAIT_L(n) asm volatile("s_waitcnt lgkmcnt(" #n ")" ::: "memory")
#define PG8_BAR __builtin_amdgcn_s_barrier()
#define PG8_SCHED __builtin_amdgcn_sched_barrier(0)
    Unit cur, nxt; int ui = 0;
    if (!S.next(0, cur)) return;
    f32x4 acc[2][2][4][2];
#pragma unroll
    for (int a = 0; a < 2; ++a)
#pragma unroll
        for (int b = 0; b < 2; ++b)
#pragma unroll
            for (int m = 0; m < 4; ++m)
#pragma unroll
                for (int n = 0; n < 2; ++n) acc[a][b][m][n] = (f32x4){0.f, 0.f, 0.f, 0.f};
    bf16x8 At[4][2], B0[2][2], B1[2][2];
    const char* cA = cur.A; const char* cB = cur.B;
    PG8_STAGE(PG8_SB(0, 0), cB, voffB); PG8_STAGE(PG8_SB(0, 1), cB + hstep, voffB); PG8_STAGE(PG8_SA(0, 0), cA, voffA); PG8_STAGE(PG8_SA(0, 1), cA + hstep, voffA);
    if (wr == 1) PG8_BAR;
    PG8_WAIT_V(2); PG8_BAR;
    PG8_STAGE(PG8_SB(1, 0), cB + kstep, voffB); PG8_STAGE(PG8_SA(1, 0), cA + kstep, voffA); PG8_STAGE(PG8_SB(1, 1), cB + hstep + kstep, voffB);
    PG8_WAIT_V(6); PG8_BAR;
    for (;;) {
        const bool has_next = S.next(ui + 1, nxt);
        const char* nA = has_next ? nxt.A : cA; const char* nB = has_next ? nxt.B : cB;
        const int nt = cur.nt;
        for (int t = 0; t < nt; t += 2) {
            const bool last = (t == nt - 2);
            const char* a1 = cA + (size_t)(t + 1) * kstep;
            const char* a2 = last ? nA : cA + (size_t)(t + 2) * kstep; const char* b2 = last ? nB : cB + (size_t)(t + 2) * kstep;
            const char* a3 = a2 + kstep; const char* b3 = b2 + kstep;
            PG8_LDB(B0, 0, 0); PG8_LDB(B1, 0, 1); PG8_SCHED; PG8_LDA(At, 0, 0); PG8_STAGE(PG8_SA(1, 1), a1 + hstep, voffA);
            PG8_WAIT_V(8); PG8_WAIT_L(0); PG8_BAR; PG8_MMA(0, 0, At, B0); PG8_MMA(0, 1, At, B1); PG8_BAR; PG8_SCHED;
            PG8_LDA(At, 0, 1); PG8_STAGE(PG8_SB(0, 0), b2, voffB); PG8_STAGE(PG8_SB(0, 1), b2 + hstep, voffB); PG8_STAGE(PG8_SA(0, 0), a2, voffA);
            PG8_WAIT_V(8); PG8_WAIT_L(0); PG8_BAR; PG8_MMA(1, 0, At, B0); PG8_MMA(1, 1, At, B1); PG8_BAR; PG8_SCHED;
            PG8_LDB(B0, 1, 0); PG8_LDB(B1, 1, 1); PG8_SCHED; PG8_LDA(At, 1, 0); PG8_STAGE(PG8_SA(0, 1), a2 + hstep, voffA);
            PG8_WAIT_V(8); PG8_WAIT_L(0); PG8_BAR; PG8_MMA(0, 0, At, B0); PG8_MMA(0, 1, At, B1); PG8_BAR; PG8_SCHED;
            PG8_LDA(At, 1, 1); PG8_STAGE(PG8_SB(1, 0), b3, voffB); PG8_STAGE(PG8_SB(1, 1), b3 + hstep, voffB); PG8_STAGE(PG8_SA(1, 0), a3, voffA);
            PG8_WAIT_V(8); PG8_WAIT_L(0); PG8_BAR; PG8_MMA(1, 0, At, B0); PG8_MMA(1, 1, At, B1); PG8_BAR; PG8_SCHED;
        }
        if constexpr (ALIGN_EPI) { if (wr == 0) PG8_BAR; }
        E(acc, cur, wr, wc, fr, fq);
        if (!has_next) break;
#pragma unroll
        for (int a = 0; a < 2; ++a)
#pragma unroll
            for (int b = 0; b < 2; ++b)
#pragma unroll
                for (int m = 0; m < 4; ++m)
#pragma unroll
                    for (int n = 0; n < 2; ++n) acc[a][b][m][n] = (f32x4){0.f, 0.f, 0.f, 0.f};
        cur = nxt; cA = nA; cB = nB; ++ui;
        if constexpr (ALIGN_EPI) { if (wr == 1) PG8_BAR; }
    }
    PG8_WAIT_V(0);
    if constexpr (!ALIGN_EPI) { if (wr == 0) PG8_BAR; }
    PG8_BAR;
#undef PG8_SA
#undef PG8_SB
#undef PG8_STAGE
#undef PG8_LDA
#undef PG8_LDB
#undef PG8_MMA
#undef PG8_WAIT_V
#undef PG8_WAIT_L
#undef PG8_BAR
#undef PG8_SCHED
}
}

namespace attn_body {
using bf16=__hip_bfloat16;
using bf16x8=__attribute__((ext_vector_type(8)))short;
using s16x4=__attribute__((ext_vector_type(4)))short;
using f32x16=__attribute__((ext_vector_type(16)))float;
using u32x4=__attribute__((ext_vector_type(4)))unsigned;
constexpr int D=64,QP=1024,KVP=256;
constexpr int NW=8,QBLK=32,QB=QBLK*NW,KVBLK=64;
__device__ __forceinline__ int crow(int r,int hi){return (r&3)+8*(r>>2)+4*hi;}
#define SBAR() __builtin_amdgcn_sched_barrier(0)
__device__ __forceinline__ void cmask(f32x16&p0,f32x16&p1,int jb,int qrel,int hi){
  const float NEG=-INFINITY; int kb=64*jb+4*hi;
  #pragma unroll
  for(int r=0;r<16;++r){int kv=kb+(r&3)+8*(r>>2); if(kv>qrel)p0[r]=NEG; if(kv+32>qrel)p1[r]=NEG;}
}

constexpr int NSLOT=3, SLOTB=8192;
constexpr int LDS_K=0, LDS_V=NSLOT*SLOTB, LDS_WS=2*NSLOT*SLOTB, LDS_OST=LDS_WS+NW*64*4, LDS_BYTES=LDS_OST+NW*4096;
constexpr float C2=0.125f*1.4426950408889634f;
__device__ __forceinline__ void glds16(const void*gsrc,unsigned lds_dst){unsigned keep;
  asm volatile("s_mov_b32 %0, m0\n\ts_mov_b32 m0, %2\n\ts_nop 0\n\tglobal_load_lds_dwordx4 %1, off\n\ts_mov_b32 m0, %0":"=&s"(keep):"v"(gsrc),"s"(lds_dst):"memory");}
__device__ __forceinline__ float max3f(float a,float b,float c){float r;asm("v_max3_f32 %0, %1, %2, %3":"=v"(r):"v"(a),"v"(b),"v"(c));return r;}
__device__ __forceinline__ float max2f(float a,float b){float r;asm("v_max_f32_e32 %0, %1, %2":"=v"(r):"v"(a),"v"(b));return r;}
__device__ __forceinline__ float fadd_s(float a,float b){float r;asm("v_add_f32_e32 %0, %1, %2":"=v"(r):"v"(a),"v"(b));return r;}
__device__ __forceinline__ float fsub_s(float a,float b){float r;asm("v_sub_f32_e32 %0, %1, %2":"=v"(r):"v"(a),"v"(b));return r;}
typedef float f32x2_t __attribute__((ext_vector_type(2))); typedef __bf16 bf16x2_t __attribute__((ext_vector_type(2)));
__device__ __forceinline__ unsigned cvtpk_s(float lo,float hi){f32x2_t v={lo,hi};bf16x2_t b=__builtin_convertvector(v,bf16x2_t);return __builtin_bit_cast(unsigned,b);}
#define WAIT_BAR(N) asm volatile("s_waitcnt vmcnt(" #N ") lgkmcnt(0)\n\ts_barrier":::"memory")

__device__ __forceinline__ void qkt(f32x16&p0,f32x16&p1,const char*Kslot,const bf16x8*qr,const f32x16&negm,int r32,int hi){
  const char*kb=Kslot+hi*1024+r32*16;
  #pragma unroll
  for(int d0=0;d0<4;++d0){
    const bf16x8 b0=*reinterpret_cast<const bf16x8*>(kb+d0*2048);
    const bf16x8 b1=*reinterpret_cast<const bf16x8*>(kb+d0*2048+512);
    if(d0==0){p0=__builtin_amdgcn_mfma_f32_32x32x16_bf16(b0,qr[0],negm,0,0,0);p1=__builtin_amdgcn_mfma_f32_32x32x16_bf16(b1,qr[0],negm,0,0,0);}
    else{p0=__builtin_amdgcn_mfma_f32_32x32x16_bf16(b0,qr[d0],p0,0,0,0);p1=__builtin_amdgcn_mfma_f32_32x32x16_bf16(b1,qr[d0],p1,0,0,0);}}
}
typedef __attribute__((address_space(3))) const char* lds_cptr;
typedef short v4i16_t __attribute__((ext_vector_type(4)));
__device__ __forceinline__ void kload8(bf16x8*kf,lds_cptr kp){
  kf[0]=*(const __attribute__((address_space(3))) bf16x8*)(kp);      kf[1]=*(const __attribute__((address_space(3))) bf16x8*)(kp+512);
  kf[2]=*(const __attribute__((address_space(3))) bf16x8*)(kp+2048); kf[3]=*(const __attribute__((address_space(3))) bf16x8*)(kp+2560);
  kf[4]=*(const __attribute__((address_space(3))) bf16x8*)(kp+4096); kf[5]=*(const __attribute__((address_space(3))) bf16x8*)(kp+4608);
  kf[6]=*(const __attribute__((address_space(3))) bf16x8*)(kp+6144); kf[7]=*(const __attribute__((address_space(3))) bf16x8*)(kp+6656);
}
__device__ __forceinline__ void kload2(bf16x8*kf,lds_cptr kp,int j){ kf[2*j]=*(const __attribute__((address_space(3))) bf16x8*)(kp+j*2048); kf[2*j+1]=*(const __attribute__((address_space(3))) bf16x8*)(kp+j*2048+512); }
__device__ __forceinline__ s16x4 vtr(lds_cptr p){ return __builtin_bit_cast(s16x4,__builtin_amdgcn_ds_read_tr16_b64_v4i16((__attribute__((address_space(3))) v4i16_t*)p)); }
__device__ __forceinline__ float rowmax(const f32x16&p0,const f32x16&p1){
  float a=max3f(p0[0],p0[1],p1[0]),b=max3f(p0[2],p0[3],p1[1]);a=max3f(a,p1[2],p1[3]);
  #pragma unroll
  for(int r=4;r<16;r+=4){a=max3f(a,p0[r],p0[r+1]);b=max3f(b,p0[r+2],p0[r+3]);a=max3f(a,p1[r],p1[r+1]);b=max3f(b,p1[r+2],p1[r+3]);}
  const float m=max2f(a,b);
  auto rr=__builtin_amdgcn_permlane32_swap(__float_as_uint(m),__float_as_uint(m),false,false);
  return max2f(__uint_as_float(rr[0]),__uint_as_float(rr[1]));
}
__device__ __forceinline__ void pv(f32x16*o,int vb,bf16x8 pa0,bf16x8 pa1,bf16x8 pa2,bf16x8 pa3){
  #pragma unroll
  for(int d0=0;d0<2;++d0){s16x4 lo[4],hi[4];
    #pragma unroll
    for(int ks=0;ks<4;++ks){
      asm volatile("ds_read_b64_tr_b16 %0,%1 offset:%c2":"=&v"(lo[ks]):"v"(vb),"i"(d0*4096+ks*1024):"memory");
      asm volatile("ds_read_b64_tr_b16 %0,%1 offset:%c2":"=&v"(hi[ks]):"v"(vb),"i"(d0*4096+ks*1024+512):"memory");}
    asm volatile("s_waitcnt lgkmcnt(0)":::"memory");SBAR();
    #define PK(k) (bf16x8){lo[k][0],lo[k][1],lo[k][2],lo[k][3],hi[k][0],hi[k][1],hi[k][2],hi[k][3]}
    o[d0]=__builtin_amdgcn_mfma_f32_32x32x16_bf16(pa0,PK(0),o[d0],0,0,0);
    o[d0]=__builtin_amdgcn_mfma_f32_32x32x16_bf16(pa1,PK(1),o[d0],0,0,0);
    o[d0]=__builtin_amdgcn_mfma_f32_32x32x16_bf16(pa2,PK(2),o[d0],0,0,0);
    o[d0]=__builtin_amdgcn_mfma_f32_32x32x16_bf16(pa3,PK(3),o[d0],0,0,0);
    #undef PK
  }
}

#ifndef ATTN_STORE16
#define ATTN_STORE16(p,v) (*(u32x4*)(p)=(v))
#endif
template<int THRL> __device__ __forceinline__ void attn_unit(const bf16*Qb,const bf16*__restrict__ Kh,const bf16*__restrict__ Vh,const int NT,const bf16*Gb,bf16*Ob,char*shm,const float*qn,const int tl0){
  const int tid=threadIdx.x,lane=tid&63,r32=lane&31,hi=lane>>5; const int wid=__builtin_amdgcn_readfirstlane(tid>>6);
  const bf16*Qw=Qb+(long)(wid*QBLK)*QP;
  const unsigned lds0=(unsigned)(uintptr_t)shm;
  float*wsf=(float*)(shm+LDS_WS)+wid*64;
  const bf16*ksrc=Kh+(long)lane*KVP+wid*8;
  const bf16*vsrc=Vh+(long)(16*(wid&3)+(lane>>2))*KVP+(wid>>2)*32+(lane&3)*8;
  const unsigned kdst=lds0+LDS_K+wid*1024, vdst=lds0+LDS_V+wid*1024;
  #define DMA_K(t,slot) glds16(ksrc+(long)(t)*KVBLK*KVP,(unsigned)__builtin_amdgcn_readfirstlane(kdst+(slot)))
  #define DMA_V(t,slot) glds16(vsrc+(long)(t)*KVBLK*KVP,(unsigned)__builtin_amdgcn_readfirstlane(vdst+(slot)))
  const int vb0=(int)(lds0+LDS_V)+((lane>>4)&1)*32+(lane&3)*8+(4*hi+((lane&15)>>2))*64;
  const char*Kbase=shm+LDS_K; bf16x8 kf[8];
  const lds_cptr shm3=(lds_cptr)shm; const lds_cptr kp0=shm3+LDS_K+hi*1024+r32*16; const lds_cptr vp0=shm3+LDS_V+((lane>>4)&1)*32+(lane&3)*8+(4*hi+((lane&15)>>2))*64;
  DMA_K(0,0);DMA_V(0,0);DMA_K(1,SLOTB);
  bf16x8 qr[4];
  #pragma unroll
  for(int d0=0;d0<4;++d0)qr[d0]=*reinterpret_cast<const bf16x8*>(&Qw[(long)r32*QP+d0*16+hi*8]);
  { float qv[4][8]; float ssq=0.f;
    #pragma unroll
    for(int d0=0;d0<4;++d0){
      #pragma unroll
      for(int j=0;j<8;++j){qv[d0][j]=__uint_as_float(((unsigned)(unsigned short)qr[d0][j])<<16);ssq+=qv[d0][j]*qv[d0][j];}}
    {auto rr=__builtin_amdgcn_permlane32_swap(__float_as_uint(ssq),__float_as_uint(ssq),false,false);ssq=__uint_as_float(rr[0])+__uint_as_float(rr[1]);}
    const float rinv=1.0f/sqrtf(ssq*(1.f/64.f)+1e-6f);
    const int tl=tl0+wid*QBLK+r32;
    #pragma unroll
    for(int d0=0;d0<4;++d0){
      const float pos=(d0<2)?(float)(tl>>6):(float)(tl&63);
      const float*gp=qn+d0*16+hi*8;
      const float gq[8]={gp[0],gp[1],gp[2],gp[3],gp[4],gp[5],gp[6],gp[7]};
      u32x4 pk;
      #pragma unroll
      for(int jj=0;jj<4;++jj){
        const float inv=__builtin_amdgcn_exp2f(-(float)(2*(8*(d0&1)+4*hi+jj))*(13.287712379549449f/32.0f));
        const float rev=pos*inv*0.15915494309189535f;
        const float cs=__builtin_amdgcn_cosf(rev),sn=__builtin_amdgcn_sinf(rev);
        const float y0=qv[d0][2*jj]*rinv*gq[2*jj],y1=qv[d0][2*jj+1]*rinv*gq[2*jj+1];
        pk[jj]=cvtpk_s((y0*cs-y1*sn)*C2,(y0*sn+y1*cs)*C2);}
      qr[d0]=__builtin_bit_cast(bf16x8,pk);}
  }
  float mhat=0.f,l_reg=0.f;f32x16 o[2];o[0]=f32x16{};o[1]=f32x16{};f32x16 negm=f32x16{};asm volatile("":"+v"(negm));
  #define CMASK(P0,P1,t) do{}while(0)
  bool resc=false;
  #define START(P0,P1) do{ const float rm=rowmax(P0,P1); resc=false; \
    { const float dl=rm; mhat=fadd_s(mhat,dl); \
      _Pragma("unroll") for(int r=0;r<16;++r){P0[r]=fsub_s(P0[r],dl);P1[r]=fsub_s(P1[r],dl);} \
      _Pragma("unroll") for(int r=0;r<16;++r)negm[r]=-mhat; asm volatile("":"+v"(negm)); } \
    _Pragma("unroll") for(int r=0;r<16;++r)P0[r]=__builtin_amdgcn_exp2f(P0[r]); }while(0)
  #define RESC() do{ if(resc){ asm volatile("s_waitcnt lgkmcnt(0)":::"memory"); \
      _Pragma("unroll") for(int d_=0;d_<2;++d_) _Pragma("unroll") for(int r=0;r<16;++r)o[d_][r]*=wsf[crow(r,hi)]; } }while(0)
  f32x16 pA0,pA1,pB0,pB1;
  int sl_prev=0,sl_cur=0,sl_next=SLOTB;
  #define ROT() do{sl_prev=sl_cur;sl_cur=sl_next;sl_next=(sl_next==(NSLOT-1)*SLOTB)?0:sl_next+SLOTB;}while(0)
  DMA_K(2,2*SLOTB);
  WAIT_BAR(3);
  qkt(pA0,pA1,Kbase,qr,negm,r32,hi);asm volatile("s_nop 15\n\ts_nop 7":"+v"(pA0),"+v"(pA1));CMASK(pA0,pA1,0);
  START(pA0,pA1);
  _Pragma("unroll") for(int r=0;r<16;++r)pA1[r]=__builtin_amdgcn_exp2f(pA1[r]);
  WAIT_BAR(0);
  DMA_K(3,0);DMA_V(1,SLOTB);
  ROT();
  kload8(kf,kp0+sl_cur);
  WAIT_BAR(2);
  s16x4 vlo[8],vhi[8]; u32x4 pw0,pw1,pw2,pw3;
  #define PKW(P,B) cvtpk_s(P[B],P[B+1])
  #define PAF(k) __builtin_bit_cast(bf16x8,pw##k)
  #define VFR(i) (bf16x8){vlo[i][0],vlo[i][1],vlo[i][2],vlo[i][3],vhi[i][0],vhi[i][1],vhi[i][2],vhi[i][3]}
  #define PIN(x) asm volatile("":"+v"(x))
  #define MX3(a,b,c) __builtin_fmaxf(__builtin_fmaxf((a),(b)),(c))
  #define GAPA(MF,A0,A1,A2,A3,W0,W1,PW) do{ MF; sacc+=A0; sacc+=A1; sacc+=A2; sacc+=A3; PIN(sacc); W0; W1; PIN(PW); SBAR(); }while(0)
  #define EX(v) __builtin_amdgcn_exp2f(v)
  #define GAPB(MF,X,B) do{ MF; X[B]=EX(X[B]); X[B+1]=EX(X[B+1]); X[B+2]=EX(X[B+2]); X[B+3]=EX(X[B+3]); PIN(X); SBAR(); }while(0)
  #define VRD(i) do{ vlo[i]=vtr(vp_+(((i)>>2)*4096+((i)&3)*1024)); vhi[i]=vtr(vp_+(((i)>>2)*4096+((i)&3)*1024+512)); }while(0)
  #define KRD(G,j) do{ if(G){ kload2(kf,kp0+sl_next,j); SBAR(); } }while(0)
  #define STEP(C0,C1,P0,P1,t,GK,GV,GL) do{ SBAR(); \
    const lds_cptr vp_=vp0+sl_prev; \
    VRD(0); SBAR(); float sacc=(P0[0]+P0[1]); \
    GAPA(C0=__builtin_amdgcn_mfma_f32_32x32x16_bf16(kf[0],qr[0],negm,0,0,0), P0[2],P0[3],P0[4],P0[5],     pw0[0]=PKW(P0,0), pw0[1]=PKW(P0,2), pw0); \
    VRD(4); SBAR(); GAPA(C1=__builtin_amdgcn_mfma_f32_32x32x16_bf16(kf[1],qr[0],negm,0,0,0), P0[6],P0[7],P0[8],P0[9],     pw0[2]=PKW(P0,4), pw0[3]=PKW(P0,6), pw0); \
    VRD(1); SBAR(); GAPA(C0=__builtin_amdgcn_mfma_f32_32x32x16_bf16(kf[2],qr[1],C0,0,0,0),   P0[10],P0[11],P0[12],P0[13], pw1[0]=PKW(P0,8), pw1[1]=PKW(P0,10), pw1); \
    VRD(5); SBAR(); GAPA(C1=__builtin_amdgcn_mfma_f32_32x32x16_bf16(kf[3],qr[1],C1,0,0,0),   P0[14],P0[15],P1[0],P1[1],   pw1[2]=PKW(P0,12),pw1[3]=PKW(P0,14), pw1); \
    VRD(2); SBAR(); GAPA(C0=__builtin_amdgcn_mfma_f32_32x32x16_bf16(kf[4],qr[2],C0,0,0,0),   P1[2],P1[3],P1[4],P1[5],     pw2[0]=PKW(P1,0), pw2[1]=PKW(P1,2), pw2); \
    VRD(6); SBAR(); GAPA(C1=__builtin_amdgcn_mfma_f32_32x32x16_bf16(kf[5],qr[2],C1,0,0,0),   P1[6],P1[7],P1[8],P1[9],     pw2[2]=PKW(P1,4), pw2[3]=PKW(P1,6), pw2); \
    VRD(3); SBAR(); GAPA(C0=__builtin_amdgcn_mfma_f32_32x32x16_bf16(kf[6],qr[3],C0,0,0,0),   P1[10],P1[11],P1[12],P1[13], pw3[0]=PKW(P1,8), pw3[1]=PKW(P1,10), pw3); \
    VRD(7); SBAR(); GAPA(C1=__builtin_amdgcn_mfma_f32_32x32x16_bf16(kf[7],qr[3],C1,0,0,0),   P1[14],P1[15],0.f,0.f,       pw3[2]=PKW(P1,12),pw3[3]=PKW(P1,14), pw3); \
    l_reg+=sacc; \
    if(GK){DMA_K((t)+3,sl_cur);} if(GV){DMA_V((t)+1,sl_next);} \
    CMASK(C0,C1,t); \
    { float a=MX3(C0[0],C0[1],C1[0]),b=MX3(C0[2],C0[3],C1[1]); a=MX3(a,C1[2],C1[3]); \
      _Pragma("unroll") for(int r=4;r<16;r+=4){a=MX3(a,C0[r],C0[r+1]);b=MX3(b,C0[r+2],C0[r+3]);a=MX3(a,C1[r],C1[r+1]);b=MX3(b,C1[r+2],C1[r+3]);} \
      float rm=__builtin_fmaxf(a,b); { auto rr=__builtin_amdgcn_permlane32_swap(__float_as_uint(rm),__float_as_uint(rm),false,false); rm=__builtin_fmaxf(__uint_as_float(rr[0]),__uint_as_float(rr[1])); } \
      resc=false; \
      if(__builtin_expect(__any(rm>(float)THRL),0)){ const float dl=__builtin_fmaxf(rm,0.f); mhat+=dl; \
        _Pragma("unroll") for(int r=0;r<16;++r){C0[r]-=dl;C1[r]-=dl;} \
        _Pragma("unroll") for(int r=0;r<16;++r)negm[r]=-mhat; asm volatile("":"+v"(negm)); \
        const float f=__builtin_amdgcn_exp2f(-dl); l_reg*=f; if(hi==0)wsf[r32]=f; resc=true; } } \
    SBAR(); \
    GAPB(o[0]=__builtin_amdgcn_mfma_f32_32x32x16_bf16(PAF(0),VFR(0),o[0],0,0,0), C0,0); \
    GAPB(o[1]=__builtin_amdgcn_mfma_f32_32x32x16_bf16(PAF(0),VFR(4),o[1],0,0,0), C0,4); \
    KRD(GL,0); GAPB(o[0]=__builtin_amdgcn_mfma_f32_32x32x16_bf16(PAF(1),VFR(1),o[0],0,0,0), C0,8); \
    KRD(GL,1); GAPB(o[1]=__builtin_amdgcn_mfma_f32_32x32x16_bf16(PAF(1),VFR(5),o[1],0,0,0), C0,12); \
    KRD(GL,2); GAPB(o[0]=__builtin_amdgcn_mfma_f32_32x32x16_bf16(PAF(2),VFR(2),o[0],0,0,0), C1,0); \
    KRD(GL,3); GAPB(o[1]=__builtin_amdgcn_mfma_f32_32x32x16_bf16(PAF(2),VFR(6),o[1],0,0,0), C1,4); \
    GAPB(o[0]=__builtin_amdgcn_mfma_f32_32x32x16_bf16(PAF(3),VFR(3),o[0],0,0,0), C1,8); \
    GAPB(o[1]=__builtin_amdgcn_mfma_f32_32x32x16_bf16(PAF(3),VFR(7),o[1],0,0,0), C1,12); \
    }while(0)
  int t=1;
  #undef CMASK
  #define CMASK(P0,P1,t) do{}while(0)
  for(;t+5<NT;t+=2){
    STEP(pB0,pB1,pA0,pA1,t,true,true,true);     WAIT_BAR(2); RESC(); ROT();
    STEP(pA0,pA1,pB0,pB1,t+1,true,true,true);   WAIT_BAR(2); RESC(); ROT();
  }
  #undef CMASK
  #define CMASK(P0,P1,t) do{}while(0)
  #define ENDW(tt) do{ if((tt)+3<NT){WAIT_BAR(2);} else if((tt)+2<NT){WAIT_BAR(1);} else {WAIT_BAR(0);} }while(0)
  for(;t+1<NT;t+=2){
    STEP(pB0,pB1,pA0,pA1,t,(t+3<NT),(t+1<NT),(t+1<NT));       ENDW(t);   RESC(); ROT();
    STEP(pA0,pA1,pB0,pB1,t+1,(t+4<NT),(t+2<NT),(t+2<NT));     ENDW(t+1); RESC(); ROT();
  }
  STEP(pB0,pB1,pA0,pA1,NT-1,false,false,false); RESC();
  { float sacc=pB0[0]+pB0[1]; _Pragma("unroll") for(int r=2;r<16;++r)sacc+=pB0[r]; _Pragma("unroll") for(int r=0;r<16;++r)sacc+=pB1[r]; l_reg+=sacc;
    pw0=(u32x4){PKW(pB0,0),PKW(pB0,2),PKW(pB0,4),PKW(pB0,6)};pw1=(u32x4){PKW(pB0,8),PKW(pB0,10),PKW(pB0,12),PKW(pB0,14)};pw2=(u32x4){PKW(pB1,0),PKW(pB1,2),PKW(pB1,4),PKW(pB1,6)};pw3=(u32x4){PKW(pB1,8),PKW(pB1,10),PKW(pB1,12),PKW(pB1,14)};
    SBAR(); pv(o,vb0+sl_cur,PAF(0),PAF(1),PAF(2),PAF(3)); }
  #undef PKW
  #undef PAF
  #undef VFR
  #undef PIN
  #undef MX3
  #undef GAPA
  #undef GAPB
  #undef EX
  #undef VRD
  #undef KRD
  #undef STEP
  #undef ENDW
  u32x4 gpre[4];
  { const bf16*Gw0=Gb+(long)(wid*QBLK)*QP;
    #pragma unroll
    for(int i=0;i<4;++i)gpre[i]=*(const u32x4*)(Gw0+(long)(i*8+(lane>>3))*QP+(lane&7)*8); }
  {auto rr=__builtin_amdgcn_permlane32_swap(__float_as_uint(l_reg),__float_as_uint(l_reg),false,false);l_reg=__uint_as_float(rr[0])+__uint_as_float(rr[1]);}
  if(hi==0)wsf[32+r32]=l_reg;asm volatile("s_waitcnt lgkmcnt(0)":::"memory");
  float rli[16];
  #pragma unroll
  for(int r=0;r<16;++r)rli[r]=__builtin_amdgcn_rcpf(wsf[32+crow(r,hi)]);
  bf16*Ow=Ob+(long)(wid*QBLK)*QP; const bf16*Gw=Gb+(long)(wid*QBLK)*QP;
  { bf16*stg=(bf16*)(shm+LDS_OST)+wid*2048;
    #pragma unroll
    for(int r=0;r<16;++r){const int orow=crow(r,hi);
      #pragma unroll
      for(int d0=0;d0<2;++d0)stg[orow*64+d0*32+r32]=__float2bfloat16(o[d0][r]*rli[r]);}
    asm volatile("s_waitcnt lgkmcnt(0)":::"memory");
    #pragma unroll
    for(int i=0;i<4;++i){const int row=i*8+(lane>>3),ch=lane&7; const u32x4 v=*(const u32x4*)(stg+row*64+ch*8); const u32x4 g=gpre[i]; u32x4 w;
      #define GM(a,b) cvtpk_s(__uint_as_float((a)<<16)*__uint_as_float((b)<<16),__uint_as_float((a)&0xffff0000u)*__uint_as_float((b)&0xffff0000u))
      w.x=GM(v.x,g.x);w.y=GM(v.y,g.y);w.z=GM(v.z,g.z);w.w=GM(v.w,g.w);
      #undef GM
      ATTN_STORE16(Ow+(long)row*QP+ch*8,w);} }
  asm volatile("s_waitcnt lgkmcnt(0)\n\ts_barrier":::"memory");
  #undef DMA_K
  #undef DMA_V
  #undef CMASK
  #undef START
  #undef RESC
  #undef ROT
}
constexpr int ATTN_LDS_BYTES=LDS_BYTES;
#undef SBAR
#undef WAIT_BAR
}

__device__ __forceinline__ unsigned xb_ld(unsigned* p)              { return __hip_atomic_load(p, __ATOMIC_RELAXED, __HIP_MEMORY_SCOPE_AGENT); }
__device__ __forceinline__ unsigned xb_add(unsigned* p, unsigned v) { return __hip_atomic_fetch_add(p, v, __ATOMIC_RELAXED, __HIP_MEMORY_SCOPE_AGENT); }
#define XB_TMO      128
#define XB_XCNT(j)  (256  + 64 * (j))
#define XB_XSUB(j)  (1280 + 64 * (j))
#define XB_XGEN(j)  (2304 + 64 * (j))
#define XB_TOP      3328
#define XB_TOPGEN   3392
#define XCD_BAR_WORDS 3456
#define XB_SPIN_CAP (1u << 18)

__device__ __forceinline__ unsigned xb_xcc_id() { return (unsigned)__builtin_amdgcn_s_getreg((3 << 11) | 20) & 0xFu; }
#define XB_SPIN(cond, bar) do { unsigned _sp = 0; while (cond) { __builtin_amdgcn_s_sleep(1); \
    if ((++_sp & 255u) == 0u) { if (xb_ld(&(bar)[XB_TMO])) break; if (_sp > XB_SPIN_CAP) { atomicAdd(&(bar)[XB_TMO], 1u); break; } } } } while (0)

struct XcdBarrier {
    unsigned* bar; unsigned x;
    volatile LAS unsigned* st;
};

__device__ __forceinline__ XcdBarrier xcd_barrier_post(unsigned* bar, volatile LAS unsigned* st) {
    XcdBarrier b; b.bar = bar; b.x = xb_xcc_id(); b.st = st;
    if (threadIdx.x == 0) (void)xb_add(&bar[XB_XCNT(b.x)], 1u);
    return b;
}
__device__ __forceinline__ void xcd_barrier_complete(unsigned* bar, unsigned x, unsigned& nloc, unsigned& nx) {
    const unsigned G = gridDim.x * gridDim.y * gridDim.z;
    unsigned sum, cnt, mine, sp = 0u;
    for (;;) {
        sum = 0u; cnt = 0u; mine = 0u;
#pragma unroll
        for (unsigned j = 0; j < 16; ++j) { const unsigned c = xb_ld(&bar[XB_XCNT(j)]); sum += c; cnt += (c > 0u) ? 1u : 0u; mine = (j == x) ? c : mine; }
        if (sum == G) break;
        __builtin_amdgcn_s_sleep(1);
        if ((++sp & 255u) == 0u) { if (xb_ld(&bar[XB_TMO])) break; if (sp > XB_SPIN_CAP) { atomicAdd(&bar[XB_TMO], 1u); break; } }
    }
    nloc = mine > 0u ? mine : 1u; nx = cnt > 0u ? cnt : 1u;
}

__device__ __forceinline__ void xcd_barrier(const XcdBarrier& b) {
    asm volatile("s_waitcnt vmcnt(0)" ::: "memory");
    __syncthreads();
    if (threadIdx.x == 0) {
        unsigned* bar = b.bar;
        __builtin_amdgcn_s_waitcnt(0);
        unsigned nloc = b.st[0], nx = b.st[1];
        if (nloc == 0u) { xcd_barrier_complete(bar, b.x, nloc, nx); b.st[0] = nloc; b.st[1] = nx; }
        const unsigned old = xb_add(&bar[XB_XSUB(b.x)], 1u);
        const unsigned gen = old / nloc;
        if (old + 1u == (gen + 1u) * nloc) {
            __builtin_amdgcn_fence(__ATOMIC_RELEASE, "agent");
            asm volatile("s_waitcnt vmcnt(0)" ::: "memory");
            const unsigned og = xb_add(&bar[XB_TOP], 1u);
            const unsigned tg = og / nx;
            if (og + 1u == (tg + 1u) * nx) xb_add(&bar[XB_TOPGEN], 1u);
            else XB_SPIN(xb_ld(&bar[XB_TOPGEN]) == tg, bar);
            __builtin_amdgcn_fence(__ATOMIC_ACQUIRE, "agent");
            xb_add(&bar[XB_XGEN(b.x)], 1u);
            asm volatile("s_waitcnt vmcnt(0)" ::: "memory");
        } else {
            XB_SPIN(xb_ld(&bar[XB_XGEN(b.x)]) == gen, bar);
            __builtin_amdgcn_fence(__ATOMIC_ACQUIRE, "agent");
            asm volatile("s_waitcnt vmcnt(0)" ::: "memory");
        }
    }
    __syncthreads();
}

using pg8::Unit;
typedef f32x4 AccT[2][2][4][2];

struct EpiStore {
    const float* pscale; const float* kn; LAS float* xl;
    __device__ __forceinline__ void operator()(const AccT& acc, const Unit& u, int wr, int wc, int fr, int fq) const {
        asm volatile("" : "+v"(fr), "+v"(fq));
        bf16_t* base = (bf16_t*)u.O; const int ldc = u.ldc, kind = u.kind; const float sc = u.sc;
        if (kind == 5) {
            const int wid = wr * 4 + wc;
#pragma unroll
            for (int ai = 0; ai < 2; ++ai)
#pragma unroll
                for (int m = 0; m < 4; ++m) {
                    const f32x4 v0 = acc[ai][0][m][0], v1 = acc[ai][0][m][1];
                    float sq = (v0[0] * v0[0] + v0[1] * v0[1]) + (v0[2] * v0[2] + v0[3] * v0[3]) + (v1[0] * v1[0] + v1[1] * v1[1]) + (v1[2] * v1[2] + v1[3] * v1[3]);
                    sq += __shfl_xor(sq, 16); sq += __shfl_xor(sq, 32);
                    if (fq == 0) xl[((wid * 2 + ai) * 4 + m) * 16 + fr] = sq;
                }
            asm volatile("s_waitcnt lgkmcnt(0)" ::: "memory"); __builtin_amdgcn_s_barrier(); asm volatile("" ::: "memory");
            const float* gp = kn + 32 * (wc & 1) + 8 * fq;
            const f32x4 g0 = *(const f32x4*)gp, g1 = *(const f32x4*)(gp + 4);
            float inv[4];
#pragma unroll
            for (int jj = 0; jj < 4; ++jj) inv[jj] = __builtin_amdgcn_exp2f(-(float)(2 * (4 * fq + jj)) * (13.287712379549449f / 32.0f)) * 0.15915494309189535f;
#pragma unroll
            for (int ai = 0; ai < 2; ++ai)
#pragma unroll
                for (int m = 0; m < 4; ++m) {
                    const int row = ai * 128 + wr * 64 + m * 16 + fr, tok = u.r0 + row;
                    const int tl = (tok < T_P) ? (tok & (L_P - 1)) : ((tok - T_P) & (L_S - 1));
                    const float pos = (wc & 1) ? (float)(tl & 63) : (float)(tl >> 6);
                    const int xi = ((wid * 2 + ai) * 4 + m) * 16 + fr;
                    const float rinv = 1.0f / sqrtf((xl[xi] + xl[xi ^ 128]) * (1.f / 64.f) + EPS);
                    f32x4 v0 = acc[ai][0][m][0] * rinv * g0, v1 = acc[ai][0][m][1] * rinv * g1;
                    float c4[4], s4[4];
#pragma unroll
                    for (int jj = 0; jj < 4; ++jj) { const float rev = pos * inv[jj]; c4[jj] = __builtin_amdgcn_cosf(rev); s4[jj] = __builtin_amdgcn_sinf(rev); }
                    bf16_t* rowp = base + (size_t)row * 256 + wc * 32 + 8 * fq;
                    u32x4 w;
                    w.x = pk2(v0[0] * c4[0] - v0[1] * s4[0], v0[0] * s4[0] + v0[1] * c4[0]); w.y = pk2(v0[2] * c4[1] - v0[3] * s4[1], v0[2] * s4[1] + v0[3] * c4[1]);
                    w.z = pk2(v1[0] * c4[2] - v1[1] * s4[2], v1[0] * s4[2] + v1[1] * c4[2]); w.w = pk2(v1[2] * c4[3] - v1[3] * s4[3], v1[2] * s4[3] + v1[3] * c4[3]);
                    *(u32x4*)rowp = w;
                    const f32x4 a0 = acc[ai][1][m][0], a1 = acc[ai][1][m][1];
                    w.x = pk2(a0[0], a0[1]); w.y = pk2(a0[2], a0[3]); w.z = pk2(a1[0], a1[1]); w.w = pk2(a1[2], a1[3]);
                    *(u32x4*)(rowp + 128) = w;
                }
            return;
        }
#pragma unroll
        for (int ai = 0; ai < 2; ++ai)
#pragma unroll
            for (int m = 0; m < 4; ++m) {
                bf16_t* rowp = base + (size_t)(ai * 128 + wr * 64 + m * 16 + fr) * ldc + wc * 32 + 8 * fq;
#pragma unroll
                for (int bj = 0; bj < 2; ++bj) {
                    f32x4 v0 = acc[ai][bj][m][0], v1 = acc[ai][bj][m][1];
                    if (kind == 1) {
#pragma unroll
                        for (int e = 0; e < 4; ++e) { v0[e] = siluf_(v0[e]); v1[e] = siluf_(v1[e]); }
                    } else if (kind == 2) { v0 = v0 * sc; v1 = v1 * sc; }
                    u32x4 w; w.x = pk2(v0[0], v0[1]); w.y = pk2(v0[2], v0[3]); w.z = pk2(v1[0], v1[1]); w.w = pk2(v1[2], v1[3]);
                    *(u32x4*)(rowp + bj * 128) = w;
                }
            }
    }
};
struct EpiGate {
    const float* bmerge; char* scr;
    __device__ __forceinline__ void operator()(const AccT& acc, const Unit& u, int wr, int wc, int fr, int fq) const {
        asm volatile("" : "+v"(fr), "+v"(fq));
        int tid = threadIdx.x; const int n = u.aux; asm volatile("" : "+v"(tid));
        u32x4* gst = (u32x4*)scr;
        if (u.kind == 0) {
            const float* bp = bmerge + n * 1024 + u.c0 + wc * 32 + 8 * fq;
            f32x4 bb[2][2];
#pragma unroll
            for (int bj = 0; bj < 2; ++bj) { bb[bj][0] = *(const f32x4*)(bp + bj * 128); bb[bj][1] = *(const f32x4*)(bp + bj * 128 + 4); }
#pragma unroll
            for (int bj = 0; bj < 2; ++bj) {
#pragma unroll
                for (int ai = 0; ai < 2; ++ai)
#pragma unroll
                    for (int m = 0; m < 4; ++m) {
                        const f32x4 v0 = (acc[ai][bj][m][0] + bb[bj][0]) * (-LOG2E), v1 = (acc[ai][bj][m][1] + bb[bj][1]) * (-LOG2E);
                        u32x4 w; w.x = pk2(__builtin_amdgcn_exp2f(v0[0]), __builtin_amdgcn_exp2f(v0[1])); w.y = pk2(__builtin_amdgcn_exp2f(v0[2]), __builtin_amdgcn_exp2f(v0[3]));
                        w.z = pk2(__builtin_amdgcn_exp2f(v1[0]), __builtin_amdgcn_exp2f(v1[1])); w.w = pk2(__builtin_amdgcn_exp2f(v1[2]), __builtin_amdgcn_exp2f(v1[3]));
                        gst[((ai * 2 + bj) * 4 + m) * 512 + tid] = w;
                    }
                asm volatile("" ::: "memory");
            }
        } else {
            bf16_t* base = (bf16_t*)u.O;
            u32x4* mst = (u32x4*)(scr + 131072);
#pragma unroll
            for (int ai = 0; ai < 2; ++ai) {
                u32x4 g[8], pm[8];
#pragma unroll
                for (int e = 0; e < 8; ++e) { const int si = (ai * 2 + (e & 1)) * 4 + (e >> 1); g[e] = gst[si * 512 + tid]; if (n > 0) pm[e] = mst[si * 512 + tid]; }
#pragma unroll
                for (int e = 0; e < 8; ++e) {
                    const int bj = e & 1, m = e >> 1, si = (ai * 2 + bj) * 4 + m;
                    f32x4 v0 = acc[ai][bj][m][0], v1 = acc[ai][bj][m][1];
#define GSIG(x_) fast_rcp(1.0f + (x_))
                    v0[0] *= GSIG(bflo(g[e].x)); v0[1] *= GSIG(bfhi(g[e].x)); v0[2] *= GSIG(bflo(g[e].y)); v0[3] *= GSIG(bfhi(g[e].y));
                    v1[0] *= GSIG(bflo(g[e].z)); v1[1] *= GSIG(bfhi(g[e].z)); v1[2] *= GSIG(bflo(g[e].w)); v1[3] *= GSIG(bfhi(g[e].w));
#undef GSIG
                    if (n > 0) { v0[0] += bflo(pm[e].x); v0[1] += bfhi(pm[e].x); v0[2] += bflo(pm[e].y); v0[3] += bfhi(pm[e].y);
                                 v1[0] += bflo(pm[e].z); v1[1] += bfhi(pm[e].z); v1[2] += bflo(pm[e].w); v1[3] += bfhi(pm[e].w); }
                    u32x4 w; w.x = pk2(v0[0], v0[1]); w.y = pk2(v0[2], v0[3]); w.z = pk2(v1[0], v1[1]); w.w = pk2(v1[2], v1[3]);
                    if (n < 2) mst[si * 512 + tid] = w;
                    else *(u32x4*)(base + (size_t)(ai * 128 + wr * 64 + m * 16 + fr) * 1024 + wc * 32 + 8 * fq + bj * 128) = w;
                }
                asm volatile("" ::: "memory");
            }
        }
    }
};
struct EpiOut {
    float* ss; unsigned* cnt; const float* xp; const float* xs; const float* gpost; float* out;
    __device__ __forceinline__ void operator()(const AccT& acc, const Unit& u, int wr, int wc, int fr, int fq) const {
        asm volatile("" : "+v"(fr), "+v"(fq));
        const int pm = u.r0 >> 8;
        const float* xb = (u.r0 < T_P) ? xp + (size_t)u.r0 * DM : xs + (size_t)(u.r0 - T_P) * DM;
        float* ob = out + (size_t)u.r0 * DM;
        const int colb = u.c0 + wc * 32 + 8 * fq;
        f32x4 gg[2][2], xv[4][2][2];
#pragma unroll
        for (int bj = 0; bj < 2; ++bj) { gg[bj][0] = *(const f32x4*)(gpost + colb + bj * 128); gg[bj][1] = *(const f32x4*)(gpost + colb + bj * 128 + 4); }
#pragma unroll
        for (int m = 0; m < 4; ++m) { const int row = wr * 64 + m * 16 + fr;
#pragma unroll
            for (int bj = 0; bj < 2; ++bj) { const size_t off = (size_t)row * DM + colb + bj * 128; xv[m][bj][0] = *(const f32x4*)(xb + off); xv[m][bj][1] = *(const f32x4*)(xb + off + 4); } }
#pragma unroll
        for (int ai = 0; ai < 2; ++ai)
#pragma unroll
            for (int m = 0; m < 4; ++m) {
                float s = 0.f;
#pragma unroll
                for (int bj = 0; bj < 2; ++bj) {
                    const f32x4 v0 = acc[ai][bj][m][0], v1 = acc[ai][bj][m][1];
                    s += (v0[0] * v0[0] + v0[1] * v0[1]) + (v0[2] * v0[2] + v0[3] * v0[3]) + (v1[0] * v1[0] + v1[1] * v1[1]) + (v1[2] * v1[2] + v1[3] * v1[3]);
                }
                s += __shfl_xor(s, 16); s += __shfl_xor(s, 32);
                if (fq == 0) __hip_atomic_fetch_add(ss + u.r0 + ai * 128 + wr * 64 + m * 16 + fr, s, __ATOMIC_RELAXED, __HIP_MEMORY_SCOPE_AGENT);
            }
        asm volatile("s_waitcnt vmcnt(0)" ::: "memory");
        __builtin_amdgcn_s_barrier();
        if (threadIdx.x == 0) __hip_atomic_fetch_add(cnt + pm, 1u, __ATOMIC_RELAXED, __HIP_MEMORY_SCOPE_AGENT);
        { unsigned sp = 0;
          while ((unsigned)__builtin_amdgcn_readfirstlane(__hip_atomic_load(cnt + pm, __ATOMIC_RELAXED, __HIP_MEMORY_SCOPE_AGENT)) < 4u && sp < (1u << 22)) { __builtin_amdgcn_s_sleep(2); ++sp; } }
        asm volatile("" ::: "memory");
        float sv[2][4];
#pragma unroll
        for (int ai = 0; ai < 2; ++ai)
#pragma unroll
            for (int m = 0; m < 4; ++m) sv[ai][m] = __hip_atomic_load(ss + u.r0 + ai * 128 + wr * 64 + m * 16 + fr, __ATOMIC_RELAXED, __HIP_MEMORY_SCOPE_AGENT);
#pragma unroll
        for (int ai = 0; ai < 2; ++ai) {
            if (ai == 1) {
#pragma unroll
                for (int m = 0; m < 4; ++m) { const int row = 128 + wr * 64 + m * 16 + fr;
#pragma unroll
                    for (int bj = 0; bj < 2; ++bj) { const size_t off = (size_t)row * DM + colb + bj * 128; xv[m][bj][0] = *(const f32x4*)(xb + off); xv[m][bj][1] = *(const f32x4*)(xb + off + 4); } }
            }
#pragma unroll
            for (int m = 0; m < 4; ++m) { const int row = ai * 128 + wr * 64 + m * 16 + fr;
                const float rinv = 1.0f / sqrtf(sv[ai][m] * (1.f / 1024.f) + EPS);
#pragma unroll
                for (int bj = 0; bj < 2; ++bj) { const size_t off = (size_t)row * DM + colb + bj * 128;
                    *(f32x4*)(ob + off) = xv[m][bj][0] + acc[ai][bj][m][0] * rinv * gg[bj][0];
                    *(f32x4*)(ob + off + 4) = xv[m][bj][1] + acc[ai][bj][m][1] * rinv * gg[bj][1]; } }
            asm volatile("" ::: "memory");
        }
    }
};

struct Ptrs {
    unsigned char* ws;
    __device__ __forceinline__ char* at(size_t off) const { return (char*)ws + off; }
};
struct SchedP1 {
    Ptrs P; int G, c;
    __device__ __forceinline__ bool next(int i, Unit& u) const {
        const int L = i * G + c; constexpr int N1 = 320 * 13, N2 = 18 * 4;
        if (L >= N1 + N2) return false;
        u.nt = 16; u.aux = 0; u.sc = 1.f;
        if (L < N1) {
            int pm, pn; pg8::tile_order(L, 320, 13, pm, pn);
            u.A = P.at(WS_XN) + (size_t)pm * 256 * 2048; u.B = P.at(WS_WIN) + (size_t)pn * 256 * 2048; u.r0 = pm * 256;
            size_t dst; int col, ldc = 1024, kind = 0;
            if (pn < 2) { dst = WS_ZA; col = pn * 256; }
            else if (pn < 4) { dst = WS_ZA; col = 512 + (pn - 2) * 256; kind = 1; }
            else if (pn < 6) { dst = WS_ZB; col = (pn - 4) * 256; }
            else if (pn == 6) { dst = WS_ZD; col = 0; ldc = 256; kind = 5; }
            else if (pn < 9) { dst = WS_ZB; col = 512 + (pn - 7) * 256; kind = 1; }
            else if (pn < 11) { dst = WS_ZC; col = (pn - 9) * 256; kind = 2; u.sc = C2_CROSS; }
            else { dst = WS_ZC; col = 512 + (pn - 11) * 256; kind = 1; }
            u.kind = kind; u.ldc = ldc; u.c0 = col; u.O = P.at(dst) + ((size_t)pm * 256 * ldc + col) * 2;
        } else {
            const int l = L - N1, pm = l >> 2, pn = l & 3;
            u.A = P.at(WS_MEMN) + (size_t)pm * 256 * 2048; u.B = P.at(WS_WMKV) + (size_t)pn * 256 * 2048; u.r0 = pm * 256; u.c0 = pn * 256;
            u.kind = 0; u.ldc = 1024; u.O = P.at(WS_MKV) + ((size_t)pm * 256 * 1024 + pn * 256) * 2;
        }
        return true;
    }
};
struct SchedMerge {
    Ptrs P; int G, c;
    __device__ __forceinline__ bool next(int i, Unit& u) const {
        const int ti = i / 6, sub = i - ti * 6; const int L = ti * G + c; if (L >= 1280) return false;
        int pm, pn; pg8::tile_order(L, 320, 4, pm, pn);
        const int n = sub >> 1; u.aux = n; u.r0 = pm * 256; u.c0 = pn * 256; u.ldc = 1024; u.sc = 1.f;
        u.O = P.at(WS_ZA) + ((size_t)pm * 256 * 1024 + pn * 256) * 2;
        if ((sub & 1) == 0) { u.kind = 0; u.nt = 16; u.A = P.at(WS_XN) + (size_t)pm * 256 * 2048; u.B = P.at(WS_WIN) + (size_t)(ZW + n * 1024 + pn * 256) * 2048; }
        else { u.kind = 1; u.nt = 8;
            u.A = P.at(n == 0 ? WS_MIX : (n == 1 ? WS_ZB : WS_ZC)) + (size_t)pm * 256 * 2048;
            u.B = P.at(n < 2 ? WS_WB01 : WS_WB2P) + ((size_t)pn * 256 * 1024 + (n == 1 ? 512 : 0)) * 2; }
        return true;
    }
};
struct SchedOut {
    Ptrs P; int G, c;
    __device__ __forceinline__ bool next(int i, Unit& u) const {
        const int L = i * G + c; if (L >= 1280) return false;
        int pm, pn; pg8::tile_order(L, 320, 4, pm, pn);
        u.A = P.at(WS_ZA) + (size_t)pm * 256 * 2048; u.B = P.at(WS_WOUT) + (size_t)pn * 256 * 2048;
        u.nt = 16; u.kind = 0; u.r0 = pm * 256; u.c0 = pn * 256; u.aux = 0; u.ldc = 1024; u.sc = 1.f;
        u.O = P.at(WS_XN) + ((size_t)pm * 256 * 1024 + pn * 256) * 2;
        return true;
    }
};

__device__ __forceinline__ void cross_attn_phase(bf16_t* ZC, const bf16_t* MKV, LAS unsigned char* lds, int vcu, int G) {
    constexpr int D = 128, KPL = 136, VPL = 260;
    const int tid = threadIdx.x, lane = tid & 63, r32 = lane & 31, hi = lane >> 5; const int wid = __builtin_amdgcn_readfirstlane(tid >> 6);
    LAS bf16_t* Ks = (LAS bf16_t*)lds;
    LAS bf16_t* Vt = (LAS bf16_t*)(lds + 256 * KPL * 2);
    LAS float* wsf = (LAS float*)(lds + 256 * KPL * 2 + D * VPL * 2) + wid * 32;
    const int i_lo = (int)((long)vcu * 1280 / G), i_hi = (int)((long)(vcu + 1) * 1280 / G);
    int loaded = -1;
    for (int I = i_lo; I < i_hi; ++I) {
        int bh, qt, row0;
        if (I < 256) { bh = I >> 5; qt = I & 31; row0 = (bh >> 2) * L_P + qt * 256; }
        else { const int J = I - 256; bh = 8 + (J >> 4); qt = J & 15; row0 = T_P + ((bh >> 2) - 2) * L_S + qt * 256; }
        const int b = bh >> 2, h = bh & 3;
        if (bh != loaded) {
            __syncthreads();
            const bf16_t* Kg = MKV + (size_t)b * NMEM * 1024 + h * 128; const bf16_t* Vg = Kg + 512;
#pragma unroll
            for (int c = 0; c < 8; ++c) { const int idx = tid + c * 512, key = idx >> 4, ch = idx & 15;
                const u32x4 kv = *(const u32x4*)(Kg + (size_t)key * 1024 + ch * 8), vv = *(const u32x4*)(Vg + (size_t)key * 1024 + ch * 8);
                *(LAS u32x4*)(Ks + key * KPL + ch * 8) = kv;
                const unsigned w[4] = {vv.x, vv.y, vv.z, vv.w};
#pragma unroll
                for (int j = 0; j < 4; ++j) { Vt[(ch * 8 + 2 * j) * VPL + key] = (bf16_t)(w[j] & 0xffffu); Vt[(ch * 8 + 2 * j + 1) * VPL + key] = (bf16_t)(w[j] >> 16); } }
            __syncthreads();
            loaded = bh;
        }
        bf16_t* Q = ZC + (size_t)(row0 + wid * 32) * 1024 + h * 128;
        bf16x8 qf[D / 16];
#pragma unroll
        for (int d0 = 0; d0 < D / 16; ++d0) qf[d0] = *(const bf16x8*)(Q + (size_t)r32 * 1024 + d0 * 16 + hi * 8);
        f32x16 o[D / 32];
#pragma unroll
        for (int dt = 0; dt < D / 32; ++dt)
#pragma unroll
            for (int r = 0; r < 16; ++r) o[dt][r] = 0.f;
        float m_run = -1e30f, l_run = 0.f;
#pragma unroll 1
        for (int kt = 0; kt < 4; ++kt) {
            f32x16 s0, s1;
#pragma unroll
            for (int r = 0; r < 16; ++r) { s0[r] = 0.f; s1[r] = 0.f; }
#pragma unroll
            for (int d0 = 0; d0 < D / 16; ++d0) {
                const bf16x8 a0 = *(const LAS bf16x8*)(Ks + (kt * 64 + r32) * KPL + d0 * 16 + hi * 8);
                const bf16x8 a1 = *(const LAS bf16x8*)(Ks + (kt * 64 + 32 + r32) * KPL + d0 * 16 + hi * 8);
                s0 = __builtin_amdgcn_mfma_f32_32x32x16_bf16(a0, qf[d0], s0, 0, 0, 0);
                s1 = __builtin_amdgcn_mfma_f32_32x32x16_bf16(a1, qf[d0], s1, 0, 0, 0);
            }
            float mx = s0[0];
#pragma unroll
            for (int r = 0; r < 16; ++r) { mx = fmaxf(mx, s0[r]); mx = fmaxf(mx, s1[r]); }
            mx = fmaxf(mx, __shfl_xor(mx, 32));
            const float m_new = fmaxf(m_run, mx);
            const float alpha = __builtin_amdgcn_exp2f(m_run - m_new);
            m_run = m_new;
            float rs = 0.f;
#pragma unroll
            for (int r = 0; r < 16; ++r) { s0[r] = __builtin_amdgcn_exp2f(s0[r] - m_new); s1[r] = __builtin_amdgcn_exp2f(s1[r] - m_new); rs += s0[r] + s1[r]; }
            l_run = l_run * alpha + rs;
            if (kt > 0) {
                __builtin_amdgcn_wave_barrier();
                if (hi == 0) wsf[r32] = alpha;
                __builtin_amdgcn_fence(__ATOMIC_RELEASE, "wavefront"); __builtin_amdgcn_wave_barrier(); __builtin_amdgcn_fence(__ATOMIC_ACQUIRE, "wavefront");
#pragma unroll
                for (int r = 0; r < 16; ++r) { const float a = wsf[crow(r, hi)];
#pragma unroll
                    for (int dt = 0; dt < D / 32; ++dt) o[dt][r] *= a; }
            }
            bf16x8 pw[4];
            { u32x4 p;
              p.x = pk2(s0[0], s0[1]); p.y = pk2(s0[2], s0[3]); p.z = pk2(s0[4], s0[5]); p.w = pk2(s0[6], s0[7]); pw[0] = __builtin_bit_cast(bf16x8, p);
              p.x = pk2(s0[8], s0[9]); p.y = pk2(s0[10], s0[11]); p.z = pk2(s0[12], s0[13]); p.w = pk2(s0[14], s0[15]); pw[1] = __builtin_bit_cast(bf16x8, p);
              p.x = pk2(s1[0], s1[1]); p.y = pk2(s1[2], s1[3]); p.z = pk2(s1[4], s1[5]); p.w = pk2(s1[6], s1[7]); pw[2] = __builtin_bit_cast(bf16x8, p);
              p.x = pk2(s1[8], s1[9]); p.y = pk2(s1[10], s1[11]); p.z = pk2(s1[12], s1[13]); p.w = pk2(s1[14], s1[15]); pw[3] = __builtin_bit_cast(bf16x8, p); }
#pragma unroll
            for (int dt = 0; dt < D / 32; ++dt)
#pragma unroll
                for (int ks = 0; ks < 4; ++ks) {
                    const LAS bf16_t* vp = Vt + (dt * 32 + r32) * VPL + kt * 64 + 16 * ks + 4 * hi;
                    const s16x4 lo = *(const LAS s16x4*)vp, hh = *(const LAS s16x4*)(vp + 8);
                    const bf16x8 bb = __builtin_shufflevector(lo, hh, 0, 1, 2, 3, 4, 5, 6, 7);
                    o[dt] = __builtin_amdgcn_mfma_f32_32x32x16_bf16(pw[ks], bb, o[dt], 0, 0, 0);
                }
        }
        l_run += __shfl_xor(l_run, 32);
        __builtin_amdgcn_wave_barrier();
        if (hi == 0) wsf[r32] = fast_rcp(l_run);
        __builtin_amdgcn_fence(__ATOMIC_RELEASE, "wavefront"); __builtin_amdgcn_wave_barrier(); __builtin_amdgcn_fence(__ATOMIC_ACQUIRE, "wavefront");
#pragma unroll
        for (int r = 0; r < 16; ++r) {
            const int row = crow(r, hi); const float inv = wsf[row];
#pragma unroll
            for (int dt = 0; dt < D / 32; ++dt) {
                const int col = dt * 32 + r32;
                const float g = __builtin_bit_cast(float, (unsigned)Q[(size_t)row * 1024 + 512 + col] << 16);
                Q[(size_t)row * 1024 + col] = (bf16_t)f2bf(o[dt][r] * inv * g);
            }
        }
        __builtin_amdgcn_wave_barrier();
    }
    __syncthreads();
}

__device__ __forceinline__ void transpose_item(const float* W, int ldw, int nblk, bf16_t* WT, LAS float* scr, int item, int lane) {
    const int kb = item / nblk, nb = item % nblk, k0 = 64 * kb, n0 = 32 * nb;
#pragma unroll 8
    for (int i = 0; i < 32; ++i) { const int kk = 2 * i + (lane >> 5); scr[kk * 33 + (lane & 31)] = W[(size_t)(k0 + kk) * ldw + n0 + (lane & 31)]; }
    asm volatile("s_waitcnt lgkmcnt(0)" ::: "memory");
    const int c = lane & 7;
#pragma unroll
    for (int j = 0; j < 4; ++j) { const int n = (lane >> 3) + 8 * j; const LAS float* s = scr + (8 * c) * 33 + n;
        u32x4 o; o.x = pk2(s[0 * 33], s[1 * 33]); o.y = pk2(s[2 * 33], s[3 * 33]); o.z = pk2(s[4 * 33], s[5 * 33]); o.w = pk2(s[6 * 33], s[7 * 33]);
        *(u32x4*)(WT + (size_t)(n0 + n) * 1024 + k0 + 8 * c) = o; }
    asm volatile("s_waitcnt lgkmcnt(0)" ::: "memory");
}
__device__ __forceinline__ void rms_row_to_bf16(const float* xrow, const float* g, bf16_t* orow, int lane) {
    const f32x4* xr = (const f32x4*)xrow + lane; const f32x4* gr = (const f32x4*)g + lane;
    f32x4 v[4]; float s = 0.f;
#pragma unroll
    for (int j = 0; j < 4; ++j) { v[j] = xr[64 * j]; s += (v[j].x * v[j].x + v[j].y * v[j].y) + (v[j].z * v[j].z + v[j].w * v[j].w); }
    const float rinv = 1.0f / sqrtf(wave_sum(s) * (1.f / 1024.f) + EPS);
    u32x2* o8 = (u32x2*)orow + lane;
#pragma unroll
    for (int j = 0; j < 4; ++j) { const f32x4 gg = gr[64 * j]; u32x2 w; w.x = pk2(v[j].x * rinv * gg.x, v[j].y * rinv * gg.y); w.y = pk2(v[j].z * rinv * gg.z, v[j].w * rinv * gg.w); o8[64 * j] = w; }
}

__device__ __forceinline__ void rms_row2_to_bf16(const float* xa, const float* xb, const float* g, bf16_t* oa, bf16_t* ob, int lane) {
    const f32x4* ra = (const f32x4*)xa + lane; const f32x4* rb = (const f32x4*)xb + lane; const f32x4* gr = (const f32x4*)g + lane;
    f32x4 va[4], vb[4]; float sa = 0.f, sb = 0.f;
#pragma unroll
    for (int j = 0; j < 4; ++j) { va[j] = ra[64 * j]; vb[j] = rb[64 * j]; }
#pragma unroll
    for (int j = 0; j < 4; ++j) { sa += (va[j].x * va[j].x + va[j].y * va[j].y) + (va[j].z * va[j].z + va[j].w * va[j].w); sb += (vb[j].x * vb[j].x + vb[j].y * vb[j].y) + (vb[j].z * vb[j].z + vb[j].w * vb[j].w); }
#pragma unroll
    for (int o = 1; o < 64; o <<= 1) { sa += __shfl_xor(sa, o); sb += __shfl_xor(sb, o); }
    const float ia = 1.0f / sqrtf(sa * (1.f / 1024.f) + EPS), ib = 1.0f / sqrtf(sb * (1.f / 1024.f) + EPS);
    u32x2* pa = (u32x2*)oa + lane; u32x2* pb = (u32x2*)ob + lane;
#pragma unroll
    for (int j = 0; j < 4; ++j) { const f32x4 gg = gr[64 * j]; u32x2 w;
        w.x = pk2(va[j].x * ia * gg.x, va[j].y * ia * gg.y); w.y = pk2(va[j].z * ia * gg.z, va[j].w * ia * gg.w); pa[64 * j] = w;
        w.x = pk2(vb[j].x * ib * gg.x, vb[j].y * ib * gg.y); w.y = pk2(vb[j].z * ib * gg.z, vb[j].w * ib * gg.w); pb[64 * j] = w; }
}

__device__ __forceinline__ void rms_row4_to_bf16(const float* x0, const float* x1, const float* x2, const float* x3, const float* g, bf16_t* o0, bf16_t* o1, bf16_t* o2, bf16_t* o3, int lane) {
    const f32x4* r[4] = {(const f32x4*)x0 + lane, (const f32x4*)x1 + lane, (const f32x4*)x2 + lane, (const f32x4*)x3 + lane}; const f32x4* gr = (const f32x4*)g + lane;
    u32x2* po[4] = {(u32x2*)o0 + lane, (u32x2*)o1 + lane, (u32x2*)o2 + lane, (u32x2*)o3 + lane};
    f32x4 v[4][4]; float sq[4] = {0.f, 0.f, 0.f, 0.f};
#pragma unroll
    for (int q = 0; q < 4; ++q)
#pragma unroll
        for (int j = 0; j < 4; ++j) v[q][j] = __builtin_nontemporal_load(r[q] + 64 * j);
#pragma unroll
    for (int q = 0; q < 4; ++q)
#pragma unroll
        for (int j = 0; j < 4; ++j) sq[q] += (v[q][j].x * v[q][j].x + v[q][j].y * v[q][j].y) + (v[q][j].z * v[q][j].z + v[q][j].w * v[q][j].w);
#pragma unroll
    for (int o = 1; o < 64; o <<= 1) { sq[0] += __shfl_xor(sq[0], o); sq[1] += __shfl_xor(sq[1], o); sq[2] += __shfl_xor(sq[2], o); sq[3] += __shfl_xor(sq[3], o); }
#pragma unroll
    for (int j = 0; j < 4; ++j) { const f32x4 gg = gr[64 * j];
#pragma unroll
        for (int q = 0; q < 4; ++q) { const float iv = 1.0f / sqrtf(sq[q] * (1.f / 1024.f) + EPS); u32x2 w;
            w.x = pk2(v[q][j].x * iv * gg.x, v[q][j].y * iv * gg.y); w.y = pk2(v[q][j].z * iv * gg.z, v[q][j].w * iv * gg.w); po[q][64 * j] = w; } }
}

struct Args { const float* in[16]; float* out; unsigned char* ws; };

__global__ void __launch_bounds__(512) fwd_megakernel(Args args) {
    extern __shared__ __attribute__((aligned(16))) unsigned char lds_raw[];
    LAS unsigned char* lds = (LAS unsigned char*)lds_raw;
    cg::grid_group grid = cg::this_grid();
    volatile LAS unsigned* xb_st = (volatile LAS unsigned*)(lds + LDS_BYTES - 16);
    if (threadIdx.x == 0) { xb_st[0] = 0u; xb_st[1] = 0u; }
    __syncthreads();
    const XcdBarrier xbar = xcd_barrier_post((unsigned*)(args.ws + WS_BAR), xb_st);
    const int tid = threadIdx.x, lane = tid & 63; const int wave = __builtin_amdgcn_readfirstlane(tid >> 6);
    const int G = gridDim.x, bx = blockIdx.x;
    const int vcu = (G % 8 == 0) ? (bx % 8) * (G / 8) + bx / 8 : bx;
    const int gw = vcu * NWAVES + wave, NGW = G * NWAVES;
    unsigned char* ws = args.ws; Ptrs P{ws};
    const float* x_prompt = args.in[0]; const float* x_sample = args.in[1]; const float* mem_prompt = args.in[2]; const float* mem_sample = args.in[3];
    const float* ln_pre = args.in[4]; const float* ln_post = args.in[5]; const float* ln_mem = args.in[6]; const float* w_in = args.in[7];
    const float* b_merge = args.in[8]; const float* q_norm = args.in[9]; const float* k_norm = args.in[10]; const float* w_pool = args.in[11];
    const float* pool_scale = args.in[12]; const float* w_mem_kv = args.in[13]; const float* w_branch = args.in[14]; const float* w_out = args.in[15];
    bf16_t* XN = (bf16_t*)(ws + WS_XN); bf16_t* ZA = (bf16_t*)(ws + WS_ZA); bf16_t* ZB = (bf16_t*)(ws + WS_ZB); bf16_t* ZC = (bf16_t*)(ws + WS_ZC);
    bf16_t* ZD = (bf16_t*)(ws + WS_ZD); bf16_t* MIX = (bf16_t*)(ws + WS_MIX); bf16_t* MEMN = (bf16_t*)(ws + WS_MEMN); bf16_t* MKV = (bf16_t*)(ws + WS_MKV);
    float* SS = (float*)(ws + WS_SS);

    {
        LAS float* scr = (LAS float*)(lds + wave * 16384);
        constexpr int I_IN = 16 * 184, I_SQ = 16 * 32, I_BR = 8 * 32;
        constexpr int NITEMS = I_IN + 2 * I_SQ + 3 * I_BR;
        for (int it = gw; it < NITEMS; it += NGW) {
            int r = it;
            if (r < I_IN) { transpose_item(w_in + 512, IN_DIM, 184, (bf16_t*)(ws + WS_WIN) + (size_t)512 * 1024, scr, r, lane); continue; } r -= I_IN;
            if (r < I_SQ) { transpose_item(w_mem_kv, 1024, 32, (bf16_t*)(ws + WS_WMKV), scr, r, lane); continue; } r -= I_SQ;
            if (r < I_SQ) { transpose_item(w_out, 1024, 32, (bf16_t*)(ws + WS_WOUT), scr, r, lane); continue; } r -= I_SQ;
            if (r < 3 * I_BR) { const int n = r / I_BR; r -= n * I_BR;
                transpose_item(w_branch + (size_t)n * 512 * 1024, 1024, 32, (bf16_t*)(ws + (n < 2 ? WS_WB01 : WS_WB2P)) + (n == 1 ? 512 : 0), scr, r, lane); continue; }
        }
        for (int it = NGW - 1 - gw; it < 128 * 4 * 2; it += NGW) {
            const int kb = it >> 3, g = (it >> 1) & 3, dh = it & 1, d = dh * 64 + lane;
            const float* wi = w_in + (size_t)(kb * 8) * IN_DIM + g * 128; const float* wp = w_pool + (size_t)g * 128 * 128 + d;
            float a8[8] = {0.f, 0.f, 0.f, 0.f, 0.f, 0.f, 0.f, 0.f};
#pragma unroll 4
            for (int c = 0; c < 128; ++c) { const float b = wp[(size_t)c * 128];
#pragma unroll
                for (int kk = 0; kk < 8; ++kk) a8[kk] += wi[(size_t)kk * IN_DIM + c] * b; }
            u32x4 o; o.x = pk2(a8[0], a8[1]); o.y = pk2(a8[2], a8[3]); o.z = pk2(a8[4], a8[5]); o.w = pk2(a8[6], a8[7]);
            *(u32x4*)((bf16_t*)(ws + WS_WIN) + (size_t)(g * 128 + d) * 1024 + kb * 8) = o;
        }
        for (int m = gw; m < T; m += 4 * NGW) {
            const float* xr[4]; int mr[4];
#pragma unroll
            for (int q = 0; q < 4; ++q) { const int mq = m + q * NGW; mr[q] = (mq < T) ? mq : m; xr[q] = (mr[q] < T_P) ? x_prompt + (size_t)mr[q] * DM : x_sample + (size_t)(mr[q] - T_P) * DM; }
            rms_row4_to_bf16(xr[0], xr[1], xr[2], xr[3], ln_pre, XN + (size_t)mr[0] * DM, XN + (size_t)mr[1] * DM, XN + (size_t)mr[2] * DM, XN + (size_t)mr[3] * DM, lane);
        }
        for (int m = gw; m < MEMROWS; m += NGW) { const float* xr = (m < 2 * NMEM) ? mem_prompt + (size_t)m * DM : mem_sample + (size_t)(m - 2 * NMEM) * DM; rms_row_to_bf16(xr, ln_mem, MEMN + (size_t)m * DM, lane); }
        for (int i = bx * 512 + tid; i < T; i += G * 512) SS[i] = 0.f;
        if (bx == 0 && tid < 320) ((unsigned*)(ws + WS_CNT))[tid] = 0u;
    }
    grid.sync();

    { SchedP1 S{P, G, bx}; EpiStore E{pool_scale, k_norm, (LAS float*)(lds + 131072)}; pg8::gemm_phase(lds, S, E); }
#if DUP_MASK & 1
    __syncthreads();
    { SchedP1 S{P, G, bx}; EpiStore E{pool_scale, k_norm, (LAS float*)(lds + 131072)}; pg8::gemm_phase(lds, S, E); }
#endif
    xcd_barrier(xbar);

    {
        for (int it = gw; it < 4 * (T / 32); it += NGW) {
            const int g = (it + it / NGW) & 3, tok0 = ((it >> 2) * 4 + (lane >> 4)) * 8, col = g * 128 + (lane & 15) * 8;
            const int Lq = (tok0 < T_P) ? L_P : L_S; const int tl0 = (tok0 < T_P) ? (tok0 & (L_P - 1)) : ((tok0 - T_P) & (L_S - 1));
            const bf16_t* bp = ZA + (size_t)tok0 * 1024 + col;
            const f32x4 p0 = *(const f32x4*)(pool_scale + col), p1 = *(const f32x4*)(pool_scale + col + 4);
            u32x4 gt[4];
#pragma unroll
            for (int i = 0; i < 4; ++i) gt[i] = *(const u32x4*)(bp + (size_t)i * 1024 + 512);
#define UNP(V_, F_) { F_[0] = bflo((V_).x); F_[1] = bfhi((V_).x); F_[2] = bflo((V_).y); F_[3] = bfhi((V_).y); F_[4] = bflo((V_).z); F_[5] = bfhi((V_).z); F_[6] = bflo((V_).w); F_[7] = bfhi((V_).w); }
#define MK(j_) (((unsigned)(tl0 - W_ / 2 + (j_)) < (unsigned)Lq) ? 1.f : 0.f)
#define POOL_RUN(WW) { constexpr int W_ = WW; constexpr int NR = 8 + W_ - 1; u32x4 rw[NR]; \
                _Pragma("unroll") for (int j = 0; j < NR; ++j) { const bool ok = (unsigned)(tl0 - W_ / 2 + j) < (unsigned)Lq; rw[j] = *(const u32x4*)(bp + (ok ? (j - W_ / 2) : 0) * 1024); } \
                float sm[8] = {0.f, 0.f, 0.f, 0.f, 0.f, 0.f, 0.f, 0.f}; float cnt = 0.f; \
                _Pragma("unroll") for (int j = 0; j < W_; ++j) { float f[8]; UNP(rw[j], f); const float mk = MK(j); cnt += mk; _Pragma("unroll") for (int e = 0; e < 8; ++e) sm[e] += mk * f[e]; } \
                _Pragma("unroll") for (int i = 0; i < 8; ++i) { \
                    const float ic = 1.0f / cnt; float c[8], gg[8]; UNP(rw[i + W_ / 2], c); UNP(gt[i & 3], gg); \
                    if (i == 3) { _Pragma("unroll") for (int q = 0; q < 4; ++q) gt[q] = *(const u32x4*)(bp + (size_t)(4 + q) * 1024 + 512); } \
                    u32x4 wv; wv.x = pk2((sm[0] * ic - c[0]) * p0.x * gg[0], (sm[1] * ic - c[1]) * p0.y * gg[1]); \
                    wv.y = pk2((sm[2] * ic - c[2]) * p0.z * gg[2], (sm[3] * ic - c[3]) * p0.w * gg[3]); \
                    wv.z = pk2((sm[4] * ic - c[4]) * p1.x * gg[4], (sm[5] * ic - c[5]) * p1.y * gg[5]); \
                    wv.w = pk2((sm[6] * ic - c[6]) * p1.z * gg[6], (sm[7] * ic - c[7]) * p1.w * gg[7]); \
                    *(u32x4*)(MIX + (size_t)(tok0 + i) * 1024 + col) = wv; \
                    if (i < 7) { float fa[8], fs[8]; UNP(rw[i + W_], fa); UNP(rw[i], fs); const float ma = MK(i + W_), ms = MK(i); cnt += ma - ms; \
                        _Pragma("unroll") for (int e = 0; e < 8; ++e) sm[e] += ma * fa[e] - ms * fs[e]; } } }
            if (g == 0) POOL_RUN(2) else if (g == 1) POOL_RUN(4) else if (g == 2) POOL_RUN(8) else POOL_RUN(16)
#undef POOL_RUN
#undef MK
#undef UNP
        }
        cross_attn_phase(ZC, MKV, lds, vcu, G);
    }

    {
        for (int L = vcu; L < 2560; L += G) {
            int row0, Lq, kvh, hq, qb;
            if (L < 2048) { const int grp = L >> 6, ui = L & 63; const int seq = grp >> 1; kvh = grp & 1; hq = ui >> 4; qb = ui & 15; row0 = T_P + seq * L_S; Lq = L_S; }
            else { const int p = L - 2048, grp = p >> 7, ui = p & 127; const int seq = grp >> 1; kvh = grp & 1; hq = ui >> 5; qb = ui & 31; row0 = seq * L_P; Lq = L_P; }
            const int h = kvh * 4 + hq;
            bf16_t* Qp = ZB + (size_t)(row0 + qb * 256) * 1024 + h * 64;
            const bf16_t* Kp = ZD + (size_t)row0 * 256 + kvh * 64;
#if DUP_MASK & 2
            attn_body::attn_unit<8>((const attn_body::bf16*)Qp, (const attn_body::bf16*)Kp, (const attn_body::bf16*)(Kp + 128), Lq / 64, (const attn_body::bf16*)(Qp + 512), (attn_body::bf16*)(ws + WS_SCR + (size_t)bx * SCR_PER_BLOCK), (char*)lds_raw, q_norm, qb * 256);
#endif
            attn_body::attn_unit<8>((const attn_body::bf16*)Qp, (const attn_body::bf16*)Kp, (const attn_body::bf16*)(Kp + 128), Lq / 64, (const attn_body::bf16*)(Qp + 512), (attn_body::bf16*)Qp, (char*)lds_raw, q_norm, qb * 256);
        }
    }
    xcd_barrier(xbar);

    { SchedMerge S{P, G, bx}; EpiGate E{b_merge, (char*)ws + WS_SCR + (size_t)bx * SCR_PER_BLOCK}; pg8::gemm_phase(lds, S, E); }
#if DUP_MASK & 4
    __syncthreads();
    { SchedMerge S{P, G, bx}; EpiGate E{b_merge, (char*)ws + WS_SCR + (size_t)bx * SCR_PER_BLOCK}; pg8::gemm_phase(lds, S, E); }
#endif
    xcd_barrier(xbar);

    { SchedOut S{P, G, bx}; EpiOut E{SS, (unsigned*)(ws + WS_CNT), x_prompt, x_sample, ln_post, args.out}; pg8::gemm_phase(lds, S, E); }
}

extern "C" void kernel_launch(void* const* d_in, const int* in_sizes, int n_in, void* d_out, int out_size, void* d_ws, size_t ws_size, hipStream_t stream) {
    static int grid_blocks = 0;
    if (grid_blocks == 0) {
        if (n_in != 16 || out_size != T * DM || ws_size < WS_END) { fprintf(stderr, "kernel_launch: unexpected shapes (n_in %d out %d ws %zu need %zu)\n", n_in, out_size, ws_size, (size_t)WS_END); grid_blocks = -1; return; }
        int dev = 0, cus = 0, per_cu = 0;
        hipGetDevice(&dev);
        hipDeviceGetAttribute(&cus, hipDeviceAttributeMultiprocessorCount, dev);
        if (hipFuncSetAttribute((const void*)fwd_megakernel, hipFuncAttributeMaxDynamicSharedMemorySize, LDS_BYTES) != hipSuccess) { fprintf(stderr, "kernel_launch: hipFuncSetAttribute failed\n"); grid_blocks = -1; return; }
        if (hipOccupancyMaxActiveBlocksPerMultiprocessor(&per_cu, (const void*)fwd_megakernel, 512, LDS_BYTES) != hipSuccess || per_cu < 1) { fprintf(stderr, "kernel_launch: occupancy query failed (%d)\n", per_cu); (void)hipGetLastError(); per_cu = 1; }
        grid_blocks = cus * 1;
        if (grid_blocks > 256) grid_blocks = 256;
    }
    if (grid_blocks < 0) return;
    if (hipMemsetAsync((char*)d_ws + WS_BAR, 0, XCD_BAR_WORDS * 4, stream) != hipSuccess) { fprintf(stderr, "kernel_launch: hipMemsetAsync failed\n"); return; }
    Args a{};
    for (int i = 0; i < 16; ++i) a.in[i] = (const float*)d_in[i];
    a.out = (float*)d_out; a.ws = (unsigned char*)d_ws;
    void* kargs[] = {&a};
    hipError_t e = hipLaunchCooperativeKernel((const void*)fwd_megakernel, dim3(grid_blocks), dim3(512), kargs, LDS_BYTES, stream);
    if (e != hipSuccess) fprintf(stderr, "cooperative launch failed: %s (grid %d)\n", hipGetErrorString(e), grid_blocks);
}
```

```cpp
#include <hip/hip_runtime.h>
#include <hip/hip_cooperative_groups.h>
#include <cstdio>
#include <cstdint>
#include <cmath>
#include <hip/hip_bf16.h>
namespace cg = cooperative_groups;
#ifndef DUP_MASK
#define DUP_MASK 0
#endif

#define LAS __attribute__((address_space(3)))
typedef unsigned short bf16_t;
typedef short bf16x8 __attribute__((ext_vector_type(8)));
typedef short s16x4 __attribute__((ext_vector_type(4)));
typedef float f32x4 __attribute__((ext_vector_type(4)));
typedef float f32x16 __attribute__((ext_vector_type(16)));
typedef unsigned u32x4 __attribute__((ext_vector_type(4)));
typedef unsigned u32x2 __attribute__((ext_vector_type(2)));
typedef float f32x2_t __attribute__((ext_vector_type(2)));
typedef __bf16 bf16x2_t __attribute__((ext_vector_type(2)));

constexpr int DM = 1024;
constexpr int T_P = 2 * 8192, T_S = 16 * 4096, T = T_P + T_S;
constexpr int L_P = 8192, L_S = 4096;
constexpr int NMEM = 256, MEMROWS = 18 * NMEM;
constexpr int IN_DIM = 6400, ZW = 3328;
constexpr float EPS = 1e-6f;
constexpr float LOG2E = 1.4426950408889634f;
constexpr float C2_SELF = 0.125f * LOG2E;
constexpr float C2_CROSS = 0.08838834764831845f * LOG2E;

constexpr size_t MiB = 1u << 20;
constexpr size_t TB = (size_t)T * 1024 * 2;
constexpr size_t WS_SS = 0;
constexpr size_t WS_CNT = 512 * 1024;
constexpr size_t WS_BAR = 768 * 1024;
constexpr size_t WS_WIN = 1 * MiB;
constexpr size_t WS_WMKV = 14 * MiB, WS_WOUT = 16 * MiB, WS_WB01 = 18 * MiB, WS_WB2P = 20 * MiB;
constexpr size_t WS_MEMN = 22 * MiB, WS_MKV = 31 * MiB;
constexpr size_t WS_XN = 40 * MiB;
constexpr size_t WS_ZA = WS_XN + TB, WS_ZB = WS_ZA + TB, WS_ZC = WS_ZB + TB;
constexpr size_t WS_ZD = WS_ZC + TB;
constexpr size_t WS_MIX = WS_ZD + (size_t)T * 256 * 2;
constexpr size_t WS_SCR = WS_MIX + TB;
constexpr size_t SCR_PER_BLOCK = 256 * 1024;
constexpr size_t WS_END = WS_SCR + 256 * SCR_PER_BLOCK;
static_assert(WS_END <= 1024 * MiB, "workspace map");

constexpr int LDS_BYTES = 139264;
constexpr int NWAVES = 8;

__device__ __forceinline__ unsigned f2bf(float f) { unsigned u = __builtin_bit_cast(unsigned, f); return (u + 0x7fffu + ((u >> 16) & 1u)) >> 16; }
__device__ __forceinline__ unsigned pk2(float lo, float hi) { f32x2_t v = {lo, hi}; bf16x2_t b = __builtin_convertvector(v, bf16x2_t); return __builtin_bit_cast(unsigned, b); }
__device__ __forceinline__ float bflo(unsigned w) { return __builtin_bit_cast(float, w << 16); }
__device__ __forceinline__ float bfhi(unsigned w) { return __builtin_bit_cast(float, w & 0xffff0000u); }
__device__ __forceinline__ float fast_rcp(float x) { return __builtin_amdgcn_rcpf(x); }
__device__ __forceinline__ float sigmoidf_(float x) { return fast_rcp(1.0f + __builtin_amdgcn_exp2f(-x * LOG2E)); }
__device__ __forceinline__ float siluf_(float x) { return x * sigmoidf_(x); }
__device__ __forceinline__ float wave_sum(float v) {
#pragma unroll
    for (int o = 1; o < 64; o <<= 1) v += __shfl_xor(v, o);
    return v;
}
__device__ __forceinline__ int crow(int r, int hi) { return (r & 3) + 8 * (r >> 2) + 4 * hi; }

namespace pg8 {
constexpr int BM = 256, BK = 64, HALF = 128, HTB = HALF * BK * 2, STAGE_BYTES = 8 * HTB, NXCD = 8, WGM = 8;
constexpr int KP = 1024;
__device__ __forceinline__ int lds_byte(int r, int c) { const int st = (r >> 4) * 2 + (c >> 5), rr = r & 15, cc = c & 31, ob = rr * 64 + cc * 2; return st * 1024 + (ob ^ (((ob >> 9) & 1) << 5)); }
__device__ __forceinline__ void stage_rc(int b, int& R, int& C) { const int st = b / 1024, sb = b % 1024, swz = sb ^ (((sb >> 9) & 1) << 5); R = (st >> 1) * 16 + swz / 64; C = (st & 1) * 32 + (swz % 64) / 2; }
__device__ __forceinline__ int perm32(int rho) { const int n = rho >> 4, i = rho & 15; return 8 * (i >> 2) + 4 * n + (i & 3); }

struct Unit { const char* A; const char* B; int nt; int kind; int r0; int c0; int aux; char* O; int ldc; float sc; };

__device__ __forceinline__ void tile_order(int L, int nM, int nN, int& pm, int& pn) {
    const int nwg = nM * nN; int wgid = L;
    { const int q = nwg / NXCD, r = nwg % NXCD, xcd = wgid % NXCD, off = wgid / NXCD; wgid = (xcd < r ? xcd * (q + 1) : r * (q + 1) + (xcd - r) * q) + off; }
    const int nig = WGM * nN, gid = wgid / nig, fm = gid * WGM, gsz = (nM - fm) < WGM ? (nM - fm) : WGM;
    pm = fm + ((wgid % nig) % gsz); pn = (wgid % nig) / gsz;
}

template <class Epi, class Sched>
__device__ __forceinline__ void gemm_phase(LAS unsigned char* lds, const Sched& S, const Epi& E) {
    constexpr bool ALIGN_EPI = true;
    int tid = threadIdx.x; asm volatile("" : "+v"(tid));
    const int wid = __builtin_amdgcn_readfirstlane(tid >> 6), lane = tid & 63, wr = wid >> 2, wc = wid & 3, fr = lane & 15, fq = lane >> 4;
    const int K = KP;
    unsigned voffA[2], voffB[2];
#pragma unroll
    for (int i = 0; i < 2; ++i) { int R, C; stage_rc(tid * 16 + i * 8192, R, C); const int Rb = (R & ~31) + perm32(R & 31);
        voffA[i] = (unsigned)(R * K + C) * 2u; voffB[i] = (unsigned)(Rb * K + C) * 2u; }
    const size_t kstep = (size_t)(BK * 2);
    const size_t hstep = (size_t)HALF * K * 2;
    const unsigned ldsw = (unsigned)wid * 1024u;
    const int aoff = lds_byte(wr * 64 + fr, fq * 8), boff = lds_byte(wc * 32 + fr, fq * 8);
#define PG8_SA(b, h) (((b) * 2 + (h)) * HTB)
#define PG8_SB(b, h) ((4 + (b) * 2 + (h)) * HTB)
#define PG8_STAGE(bufoff, gbase, voff) do { _Pragma("unroll") for (int _i = 0; _i < 2; ++_i) \
        __builtin_amdgcn_global_load_lds((const unsigned*)((const char*)(gbase) + (voff)[_i]), (LAS unsigned*)(lds + (bufoff) + ldsw + _i * 8192), 16, 0, 0); } while (0)
#define PG8_LDA(dst, b, h) do { _Pragma("unroll") for (int m = 0; m < 4; ++m) _Pragma("unroll") for (int k = 0; k < 2; ++k) dst[m][k] = *(const LAS bf16x8*)(lds + PG8_SA(b, h) + aoff + m * 2048 + k * 1024); } while (0)
#define PG8_LDB(dst, b, h) do { _Pragma("unroll") for (int n = 0; n < 2; ++n) _Pragma("unroll") for (int k = 0; k < 2; ++k) dst[n][k] = *(const LAS bf16x8*)(lds + PG8_SB(b, h) + boff + n * 2048 + k * 1024); } while (0)
#define PG8_MMA(ai, bj, At, Bt) do { __builtin_amdgcn_s_setprio(1); _Pragma("unroll") for (int m = 0; m < 4; ++m) _Pragma("unroll") for (int n = 0; n < 2; ++n) _Pragma("unroll") for (int k = 0; k < 2; ++k) \
        acc[ai][bj][m][n] = __builtin_amdgcn_mfma_f32_16x16x32_bf16(Bt[n][k], At[m][k], acc[ai][bj][m][n], 0, 0, 0); __builtin_amdgcn_s_setprio(0); } while (0)
#define PG8_WAIT_V(n) asm volatile("s_waitcnt vmcnt(" #n ")" ::: "memory")
#define PG8_WAIT_L(n) asm volatile("s_waitcnt lgkmcnt(" #n ")" ::: "memory")
#define PG8_BAR __builtin_amdgcn_s_barrier()
#define PG8_SCHED __builtin_amdgcn_sched_barrier(0)
    Unit cur, nxt; int ui = 0;
    if (!S.next(0, cur)) return;
    f32x4 acc[2][2][4][2];
#pragma unroll
    for (int a = 0; a < 2; ++a)
#pragma unroll
        for (int b = 0; b < 2; ++b)
#pragma unroll
            for (int m = 0; m < 4; ++m)
#pragma unroll
                for (int n = 0; n < 2; ++n) acc[a][b][m][n] = (f32x4){0.f, 0.f, 0.f, 0.f};
    bf16x8 At[4][2], B0[2][2], B1[2][2];
    const char* cA = cur.A; const char* cB = cur.B;
    PG8_STAGE(PG8_SB(0, 0), cB, voffB); PG8_STAGE(PG8_SB(0, 1), cB + hstep, voffB); PG8_STAGE(PG8_SA(0, 0), cA, voffA); PG8_STAGE(PG8_SA(0, 1), cA + hstep, voffA);
    if (wr == 1) PG8_BAR;
    PG8_WAIT_V(2); PG8_BAR;
    PG8_STAGE(PG8_SB(1, 0), cB + kstep, voffB); PG8_STAGE(PG8_SA(1, 0), cA + kstep, voffA); PG8_STAGE(PG8_SB(1, 1), cB + hstep + kstep, voffB);
    PG8_WAIT_V(6); PG8_BAR;
    for (;;) {
        const bool has_next = S.next(ui + 1, nxt);
        const char* nA = has_next ? nxt.A : cA; const char* nB = has_next ? nxt.B : cB;
        const int nt = cur.nt;
        for (int t = 0; t < nt; t += 2) {
            const bool last = (t == nt - 2);
            const char* a1 = cA + (size_t)(t + 1) * kstep;
            const char* a2 = last ? nA : cA + (size_t)(t + 2) * kstep; const char* b2 = last ? nB : cB + (size_t)(t + 2) * kstep;
            const char* a3 = a2 + kstep; const char* b3 = b2 + kstep;
            PG8_LDB(B0, 0, 0); PG8_LDB(B1, 0, 1); PG8_SCHED; PG8_LDA(At, 0, 0); PG8_STAGE(PG8_SA(1, 1), a1 + hstep, voffA);
            PG8_WAIT_V(8); PG8_WAIT_L(0); PG8_BAR; PG8_MMA(0, 0, At, B0); PG8_MMA(0, 1, At, B1); PG8_BAR; PG8_SCHED;
            PG8_LDA(At, 0, 1); PG8_STAGE(PG8_SB(0, 0), b2, voffB); PG8_STAGE(PG8_SB(0, 1), b2 + hstep, voffB); PG8_STAGE(PG8_SA(0, 0), a2, voffA);
            PG8_WAIT_V(8); PG8_WAIT_L(0); PG8_BAR; PG8_MMA(1, 0, At, B0); PG8_MMA(1, 1, At, B1); PG8_BAR; PG8_SCHED;
            PG8_LDB(B0, 1, 0); PG8_LDB(B1, 1, 1); PG8_SCHED; PG8_LDA(At, 1, 0); PG8_STAGE(PG8_SA(0, 1), a2 + hstep, voffA);
            PG8_WAIT_V(8); PG8_WAIT_L(0); PG8_BAR; PG8_MMA(0, 0, At, B0); PG8_MMA(0, 1, At, B1); PG8_BAR; PG8_SCHED;
            PG8_LDA(At, 1, 1); PG8_STAGE(PG8_SB(1, 0), b3, voffB); PG8_STAGE(PG8_SB(1, 1), b3 + hstep, voffB); PG8_STAGE(PG8_SA(1, 0), a3, voffA);
            PG8_WAIT_V(8); PG8_WAIT_L(0); PG8_BAR; PG8_MMA(1, 0, At, B0); PG8_MMA(1, 1, At, B1); PG8_BAR; PG8_SCHED;
        }
        if constexpr (ALIGN_EPI) { if (wr == 0) PG8_BAR; }
        E(acc, cur, wr, wc, fr, fq);
        if (!has_next) break;
#pragma unroll
        for (int a = 0; a < 2; ++a)
#pragma unroll
            for (int b = 0; b < 2; ++b)
#pragma unroll
                for (int m = 0; m < 4; ++m)
#pragma unroll
                    for (int n = 0; n < 2; ++n) acc[a][b][m][n] = (f32x4){0.f, 0.f, 0.f, 0.f};
        cur = nxt; cA = nA; cB = nB; ++ui;
        if constexpr (ALIGN_EPI) { if (wr == 1) PG8_BAR; }
    }
    PG8_WAIT_V(0);
    if constexpr (!ALIGN_EPI) { if (wr == 0) PG8_BAR; }
    PG8_BAR;
#undef PG8_SA
#undef PG8_SB
#undef PG8_STAGE
#undef PG8_LDA
#undef PG8_LDB
#undef PG8_MMA
#undef PG8_WAIT_V
#undef PG8_WAIT_L
#undef PG8_BAR
#undef PG8_SCHED
}
}

namespace attn_body {
using bf16=__hip_bfloat16;
using bf16x8=__attribute__((ext_vector_type(8)))short;
using s16x4=__attribute__((ext_vector_type(4)))short;
using f32x16=__attribute__((ext_vector_type(16)))float;
using u32x4=__attribute__((ext_vector_type(4)))unsigned;
constexpr int D=64,QP=1024,KVP=256;
constexpr int NW=8,QBLK=32,QB=QBLK*NW,KVBLK=64;
__device__ __forceinline__ int crow(int r,int hi){return (r&3)+8*(r>>2)+4*hi;}
#define SBAR() __builtin_amdgcn_sched_barrier(0)
__device__ __forceinline__ void cmask(f32x16&p0,f32x16&p1,int jb,int qrel,int hi){
  const float NEG=-INFINITY; int kb=64*jb+4*hi;
  #pragma unroll
  for(int r=0;r<16;++r){int kv=kb+(r&3)+8*(r>>2); if(kv>qrel)p0[r]=NEG; if(kv+32>qrel)p1[r]=NEG;}
}

constexpr int NSLOT=3, SLOTB=8192;
constexpr int LDS_K=0, LDS_V=NSLOT*SLOTB, LDS_WS=2*NSLOT*SLOTB, LDS_OST=LDS_WS+NW*64*4, LDS_BYTES=LDS_OST+NW*4096;
constexpr float C2=0.125f*1.4426950408889634f;
__device__ __forceinline__ void glds16(const void*gsrc,unsigned lds_dst){unsigned keep;
  asm volatile("s_mov_b32 %0, m0\n\ts_mov_b32 m0, %2\n\ts_nop 0\n\tglobal_load_lds_dwordx4 %1, off\n\ts_mov_b32 m0, %0":"=&s"(keep):"v"(gsrc),"s"(lds_dst):"memory");}
__device__ __forceinline__ float max3f(float a,float b,float c){float r;asm("v_max3_f32 %0, %1, %2, %3":"=v"(r):"v"(a),"v"(b),"v"(c));return r;}
__device__ __forceinline__ float max2f(float a,float b){float r;asm("v_max_f32_e32 %0, %1, %2":"=v"(r):"v"(a),"v"(b));return r;}
__device__ __forceinline__ float fadd_s(float a,float b){float r;asm("v_add_f32_e32 %0, %1, %2":"=v"(r):"v"(a),"v"(b));return r;}
__device__ __forceinline__ float fsub_s(float a,float b){float r;asm("v_sub_f32_e32 %0, %1, %2":"=v"(r):"v"(a),"v"(b));return r;}
typedef float f32x2_t __attribute__((ext_vector_type(2))); typedef __bf16 bf16x2_t __attribute__((ext_vector_type(2)));
__device__ __forceinline__ unsigned cvtpk_s(float lo,float hi){f32x2_t v={lo,hi};bf16x2_t b=__builtin_convertvector(v,bf16x2_t);return __builtin_bit_cast(unsigned,b);}
#define WAIT_BAR(N) asm volatile("s_waitcnt vmcnt(" #N ") lgkmcnt(0)\n\ts_barrier":::"memory")

__device__ __forceinline__ void qkt(f32x16&p0,f32x16&p1,const char*Kslot,const bf16x8*qr,const f32x16&negm,int r32,int hi){
  const char*kb=Kslot+hi*1024+r32*16;
  #pragma unroll
  for(int d0=0;d0<4;++d0){
    const bf16x8 b0=*reinterpret_cast<const bf16x8*>(kb+d0*2048);
    const bf16x8 b1=*reinterpret_cast<const bf16x8*>(kb+d0*2048+512);
    if(d0==0){p0=__builtin_amdgcn_mfma_f32_32x32x16_bf16(b0,qr[0],negm,0,0,0);p1=__builtin_amdgcn_mfma_f32_32x32x16_bf16(b1,qr[0],negm,0,0,0);}
    else{p0=__builtin_amdgcn_mfma_f32_32x32x16_bf16(b0,qr[d0],p0,0,0,0);p1=__builtin_amdgcn_mfma_f32_32x32x16_bf16(b1,qr[d0],p1,0,0,0);}}
}
typedef __attribute__((address_space(3))) const char* lds_cptr;
typedef short v4i16_t __attribute__((ext_vector_type(4)));
__device__ __forceinline__ void kload8(bf16x8*kf,lds_cptr kp){
  kf[0]=*(const __attribute__((address_space(3))) bf16x8*)(kp);      kf[1]=*(const __attribute__((address_space(3))) bf16x8*)(kp+512);
  kf[2]=*(const __attribute__((address_space(3))) bf16x8*)(kp+2048); kf[3]=*(const __attribute__((address_space(3))) bf16x8*)(kp+2560);
  kf[4]=*(const __attribute__((address_space(3))) bf16x8*)(kp+4096); kf[5]=*(const __attribute__((address_space(3))) bf16x8*)(kp+4608);
  kf[6]=*(const __attribute__((address_space(3))) bf16x8*)(kp+6144); kf[7]=*(const __attribute__((address_space(3))) bf16x8*)(kp+6656);
}
__device__ __forceinline__ void kload2(bf16x8*kf,lds_cptr kp,int j){ kf[2*j]=*(const __attribute__((address_space(3))) bf16x8*)(kp+j*2048); kf[2*j+1]=*(const __attribute__((address_space(3))) bf16x8*)(kp+j*2048+512); }
__device__ __forceinline__ s16x4 vtr(lds_cptr p){ return __builtin_bit_cast(s16x4,__builtin_amdgcn_ds_read_tr16_b64_v4i16((__attribute__((address_space(3))) v4i16_t*)p)); }
__device__ __forceinline__ float rowmax(const f32x16&p0,const f32x16&p1){
  float a=max3f(p0[0],p0[1],p1[0]),b=max3f(p0[2],p0[3],p1[1]);a=max3f(a,p1[2],p1[3]);
  #pragma unroll
  for(int r=4;r<16;r+=4){a=max3f(a,p0[r],p0[r+1]);b=max3f(b,p0[r+2],p0[r+3]);a=max3f(a,p1[r],p1[r+1]);b=max3f(b,p1[r+2],p1[r+3]);}
  const float m=max2f(a,b);
  auto rr=__builtin_amdgcn_permlane32_swap(__float_as_uint(m),__float_as_uint(m),false,false);
  return max2f(__uint_as_float(rr[0]),__uint_as_float(rr[1]));
}
__device__ __forceinline__ void pv(f32x16*o,int vb,bf16x8 pa0,bf16x8 pa1,bf16x8 pa2,bf16x8 pa3){
  #pragma unroll
  for(int d0=0;d0<2;++d0){s16x4 lo[4],hi[4];
    #pragma unroll
    for(int ks=0;ks<4;++ks){
      asm volatile("ds_read_b64_tr_b16 %0,%1 offset:%c2":"=&v"(lo[ks]):"v"(vb),"i"(d0*4096+ks*1024):"memory");
      asm volatile("ds_read_b64_tr_b16 %0,%1 offset:%c2":"=&v"(hi[ks]):"v"(vb),"i"(d0*4096+ks*1024+512):"memory");}
    asm volatile("s_waitcnt lgkmcnt(0)":::"memory");SBAR();
    #define PK(k) (bf16x8){lo[k][0],lo[k][1],lo[k][2],lo[k][3],hi[k][0],hi[k][1],hi[k][2],hi[k][3]}
    o[d0]=__builtin_amdgcn_mfma_f32_32x32x16_bf16(pa0,PK(0),o[d0],0,0,0);
    o[d0]=__builtin_amdgcn_mfma_f32_32x32x16_bf16(pa1,PK(1),o[d0],0,0,0);
    o[d0]=__builtin_amdgcn_mfma_f32_32x32x16_bf16(pa2,PK(2),o[d0],0,0,0);
    o[d0]=__builtin_amdgcn_mfma_f32_32x32x16_bf16(pa3,PK(3),o[d0],0,0,0);
    #undef PK
  }
}

#ifndef ATTN_STORE16
#define ATTN_STORE16(p,v) (*(u32x4*)(p)=(v))
#endif
template<int THRL> __device__ __forceinline__ void attn_unit(const bf16*Qb,const bf16*__restrict__ Kh,const bf16*__restrict__ Vh,const int NT,const bf16*Gb,bf16*Ob,char*shm,const float*qn,const int tl0){
  const int tid=threadIdx.x,lane=tid&63,r32=lane&31,hi=lane>>5; const int wid=__builtin_amdgcn_readfirstlane(tid>>6);
  const bf16*Qw=Qb+(long)(wid*QBLK)*QP;
  const unsigned lds0=(unsigned)(uintptr_t)shm;
  float*wsf=(float*)(shm+LDS_WS)+wid*64;
  const bf16*ksrc=Kh+(long)lane*KVP+wid*8;
  const bf16*vsrc=Vh+(long)(16*(wid&3)+(lane>>2))*KVP+(wid>>2)*32+(lane&3)*8;
  const unsigned kdst=lds0+LDS_K+wid*1024, vdst=lds0+LDS_V+wid*1024;
  #define DMA_K(t,slot) glds16(ksrc+(long)(t)*KVBLK*KVP,(unsigned)__builtin_amdgcn_readfirstlane(kdst+(slot)))
  #define DMA_V(t,slot) glds16(vsrc+(long)(t)*KVBLK*KVP,(unsigned)__builtin_amdgcn_readfirstlane(vdst+(slot)))
  const int vb0=(int)(lds0+LDS_V)+((lane>>4)&1)*32+(lane&3)*8+(4*hi+((lane&15)>>2))*64;
  const char*Kbase=shm+LDS_K; bf16x8 kf[8];
  const lds_cptr shm3=(lds_cptr)shm; const lds_cptr kp0=shm3+LDS_K+hi*1024+r32*16; const lds_cptr vp0=shm3+LDS_V+((lane>>4)&1)*32+(lane&3)*8+(4*hi+((lane&15)>>2))*64;
  DMA_K(0,0);DMA_V(0,0);DMA_K(1,SLOTB);
  bf16x8 qr[4];
  #pragma unroll
  for(int d0=0;d0<4;++d0)qr[d0]=*reinterpret_cast<const bf16x8*>(&Qw[(long)r32*QP+d0*16+hi*8]);
  { float qv[4][8]; float ssq=0.f;
    #pragma unroll
    for(int d0=0;d0<4;++d0){
      #pragma unroll
      for(int j=0;j<8;++j){qv[d0][j]=__uint_as_float(((unsigned)(unsigned short)qr[d0][j])<<16);ssq+=qv[d0][j]*qv[d0][j];}}
    {auto rr=__builtin_amdgcn_permlane32_swap(__float_as_uint(ssq),__float_as_uint(ssq),false,false);ssq=__uint_as_float(rr[0])+__uint_as_float(rr[1]);}
    const float rinv=1.0f/sqrtf(ssq*(1.f/64.f)+1e-6f);
    const int tl=tl0+wid*QBLK+r32;
    #pragma unroll
    for(int d0=0;d0<4;++d0){
      const float pos=(d0<2)?(float)(tl>>6):(float)(tl&63);
      const float*gp=qn+d0*16+hi*8;
      const float gq[8]={gp[0],gp[1],gp[2],gp[3],gp[4],gp[5],gp[6],gp[7]};
      u32x4 pk;
      #pragma unroll
      for(int jj=0;jj<4;++jj){
        const float inv=__builtin_amdgcn_exp2f(-(float)(2*(8*(d0&1)+4*hi+jj))*(13.287712379549449f/32.0f));
        const float rev=pos*inv*0.15915494309189535f;
        const float cs=__builtin_amdgcn_cosf(rev),sn=__builtin_amdgcn_sinf(rev);
        const float y0=qv[d0][2*jj]*rinv*gq[2*jj],y1=qv[d0][2*jj+1]*rinv*gq[2*jj+1];
        pk[jj]=cvtpk_s((y0*cs-y1*sn)*C2,(y0*sn+y1*cs)*C2);}
      qr[d0]=__builtin_bit_cast(bf16x8,pk);}
  }
  float mhat=0.f,l_reg=0.f;f32x16 o[2];o[0]=f32x16{};o[1]=f32x16{};f32x16 negm=f32x16{};asm volatile("":"+v"(negm));
  #define CMASK(P0,P1,t) do{}while(0)
  bool resc=false;
  #define START(P0,P1) do{ const float rm=rowmax(P0,P1); resc=false; \
    { const float dl=rm; mhat=fadd_s(mhat,dl); \
      _Pragma("unroll") for(int r=0;r<16;++r){P0[r]=fsub_s(P0[r],dl);P1[r]=fsub_s(P1[r],dl);} \
      _Pragma("unroll") for(int r=0;r<16;++r)negm[r]=-mhat; asm volatile("":"+v"(negm)); } \
    _Pragma("unroll") for(int r=0;r<16;++r)P0[r]=__builtin_amdgcn_exp2f(P0[r]); }while(0)
  #define RESC() do{ if(resc){ asm volatile("s_waitcnt lgkmcnt(0)":::"memory"); \
      _Pragma("unroll") for(int d_=0;d_<2;++d_) _Pragma("unroll") for(int r=0;r<16;++r)o[d_][r]*=wsf[crow(r,hi)]; } }while(0)
  f32x16 pA0,pA1,pB0,pB1;
  int sl_prev=0,sl_cur=0,sl_next=SLOTB;
  #define ROT() do{sl_prev=sl_cur;sl_cur=sl_next;sl_next=(sl_next==(NSLOT-1)*SLOTB)?0:sl_next+SLOTB;}while(0)
  DMA_K(2,2*SLOTB);
  WAIT_BAR(3);
  qkt(pA0,pA1,Kbase,qr,negm,r32,hi);asm volatile("s_nop 15\n\ts_nop 7":"+v"(pA0),"+v"(pA1));CMASK(pA0,pA1,0);
  START(pA0,pA1);
  _Pragma("unroll") for(int r=0;r<16;++r)pA1[r]=__builtin_amdgcn_exp2f(pA1[r]);
  WAIT_BAR(0);
  DMA_K(3,0);DMA_V(1,SLOTB);
  ROT();
  kload8(kf,kp0+sl_cur);
  WAIT_BAR(2);
  s16x4 vlo[8],vhi[8]; u32x4 pw0,pw1,pw2,pw3;
  #define PKW(P,B) cvtpk_s(P[B],P[B+1])
  #define PAF(k) __builtin_bit_cast(bf16x8,pw##k)
  #define VFR(i) (bf16x8){vlo[i][0],vlo[i][1],vlo[i][2],vlo[i][3],vhi[i][0],vhi[i][1],vhi[i][2],vhi[i][3]}
  #define PIN(x) asm volatile("":"+v"(x))
  #define MX3(a,b,c) __builtin_fmaxf(__builtin_fmaxf((a),(b)),(c))
  #define GAPA(MF,A0,A1,A2,A3,W0,W1,PW) do{ MF; sacc+=A0; sacc+=A1; sacc+=A2; sacc+=A3; PIN(sacc); W0; W1; PIN(PW); SBAR(); }while(0)
  #define EX(v) __builtin_amdgcn_exp2f(v)
  #define GAPB(MF,X,B) do{ MF; X[B]=EX(X[B]); X[B+1]=EX(X[B+1]); X[B+2]=EX(X[B+2]); X[B+3]=EX(X[B+3]); PIN(X); SBAR(); }while(0)
  #define VRD(i) do{ vlo[i]=vtr(vp_+(((i)>>2)*4096+((i)&3)*1024)); vhi[i]=vtr(vp_+(((i)>>2)*4096+((i)&3)*1024+512)); }while(0)
  #define KRD(G,j) do{ if(G){ kload2(kf,kp0+sl_next,j); SBAR(); } }while(0)
  #define STEP(C0,C1,P0,P1,t,GK,GV,GL) do{ SBAR(); \
    const lds_cptr vp_=vp0+sl_prev; \
    VRD(0); SBAR(); float sacc=(P0[0]+P0[1]); \
    GAPA(C0=__builtin_amdgcn_mfma_f32_32x32x16_bf16(kf[0],qr[0],negm,0,0,0), P0[2],P0[3],P0[4],P0[5],     pw0[0]=PKW(P0,0), pw0[1]=PKW(P0,2), pw0); \
    VRD(4); SBAR(); GAPA(C1=__builtin_amdgcn_mfma_f32_32x32x16_bf16(kf[1],qr[0],negm,0,0,0), P0[6],P0[7],P0[8],P0[9],     pw0[2]=PKW(P0,4), pw0[3]=PKW(P0,6), pw0); \
    VRD(1); SBAR(); GAPA(C0=__builtin_amdgcn_mfma_f32_32x32x16_bf16(kf[2],qr[1],C0,0,0,0),   P0[10],P0[11],P0[12],P0[13], pw1[0]=PKW(P0,8), pw1[1]=PKW(P0,10), pw1); \
    VRD(5); SBAR(); GAPA(C1=__builtin_amdgcn_mfma_f32_32x32x16_bf16(kf[3],qr[1],C1,0,0,0),   P0[14],P0[15],P1[0],P1[1],   pw1[2]=PKW(P0,12),pw1[3]=PKW(P0,14), pw1); \
    VRD(2); SBAR(); GAPA(C0=__builtin_amdgcn_mfma_f32_32x32x16_bf16(kf[4],qr[2],C0,0,0,0),   P1[2],P1[3],P1[4],P1[5],     pw2[0]=PKW(P1,0), pw2[1]=PKW(P1,2), pw2); \
    VRD(6); SBAR(); GAPA(C1=__builtin_amdgcn_mfma_f32_32x32x16_bf16(kf[5],qr[2],C1,0,0,0),   P1[6],P1[7],P1[8],P1[9],     pw2[2]=PKW(P1,4), pw2[3]=PKW(P1,6), pw2); \
    VRD(3); SBAR(); GAPA(C0=__builtin_amdgcn_mfma_f32_32x32x16_bf16(kf[6],qr[3],C0,0,0,0),   P1[10],P1[11],P1[12],P1[13], pw3[0]=PKW(P1,8), pw3[1]=PKW(P1,10), pw3); \
    VRD(7); SBAR(); GAPA(C1=__builtin_amdgcn_mfma_f32_32x32x16_bf16(kf[7],qr[3],C1,0,0,0),   P1[14],P1[15],0.f,0.f,       pw3[2]=PKW(P1,12),pw3[3]=PKW(P1,14), pw3); \
    l_reg+=sacc; \
    if(GK){DMA_K((t)+3,sl_cur);} if(GV){DMA_V((t)+1,sl_next);} \
    CMASK(C0,C1,t); \
    { float a=MX3(C0[0],C0[1],C1[0]),b=MX3(C0[2],C0[3],C1[1]); a=MX3(a,C1[2],C1[3]); \
      _Pragma("unroll") for(int r=4;r<16;r+=4){a=MX3(a,C0[r],C0[r+1]);b=MX3(b,C0[r+2],C0[r+3]);a=MX3(a,C1[r],C1[r+1]);b=MX3(b,C1[r+2],C1[r+3]);} \
      float rm=__builtin_fmaxf(a,b); { auto rr=__builtin_amdgcn_permlane32_swap(__float_as_uint(rm),__float_as_uint(rm),false,false); rm=__builtin_fmaxf(__uint_as_float(rr[0]),__uint_as_float(rr[1])); } \
      resc=false; \
      if(__builtin_expect(__any(rm>(float)THRL),0)){ const float dl=__builtin_fmaxf(rm,0.f); mhat+=dl; \
        _Pragma("unroll") for(int r=0;r<16;++r){C0[r]-=dl;C1[r]-=dl;} \
        _Pragma("unroll") for(int r=0;r<16;++r)negm[r]=-mhat; asm volatile("":"+v"(negm)); \
        const float f=__builtin_amdgcn_exp2f(-dl); l_reg*=f; if(hi==0)wsf[r32]=f; resc=true; } } \
    SBAR(); \
    GAPB(o[0]=__builtin_amdgcn_mfma_f32_32x32x16_bf16(PAF(0),VFR(0),o[0],0,0,0), C0,0); \
    GAPB(o[1]=__builtin_amdgcn_mfma_f32_32x32x16_bf16(PAF(0),VFR(4),o[1],0,0,0), C0,4); \
    KRD(GL,0); GAPB(o[0]=__builtin_amdgcn_mfma_f32_32x32x16_bf16(PAF(1),VFR(1),o[0],0,0,0), C0,8); \
    KRD(GL,1); GAPB(o[1]=__builtin_amdgcn_mfma_f32_32x32x16_bf16(PAF(1),VFR(5),o[1],0,0,0), C0,12); \
    KRD(GL,2); GAPB(o[0]=__builtin_amdgcn_mfma_f32_32x32x16_bf16(PAF(2),VFR(2),o[0],0,0,0), C1,0); \
    KRD(GL,3); GAPB(o[1]=__builtin_amdgcn_mfma_f32_32x32x16_bf16(PAF(2),VFR(6),o[1],0,0,0), C1,4); \
    GAPB(o[0]=__builtin_amdgcn_mfma_f32_32x32x16_bf16(PAF(3),VFR(3),o[0],0,0,0), C1,8); \
    GAPB(o[1]=__builtin_amdgcn_mfma_f32_32x32x16_bf16(PAF(3),VFR(7),o[1],0,0,0), C1,12); \
    }while(0)
  int t=1;
  #undef CMASK
  #define CMASK(P0,P1,t) do{}while(0)
  for(;t+5<NT;t+=2){
    STEP(pB0,pB1,pA0,pA1,t,true,true,true);     WAIT_BAR(2); RESC(); ROT();
    STEP(pA0,pA1,pB0,pB1,t+1,true,true,true);   WAIT_BAR(2); RESC(); ROT();
  }
  #undef CMASK
  #define CMASK(P0,P1,t) do{}while(0)
  #define ENDW(tt) do{ if((tt)+3<NT){WAIT_BAR(2);} else if((tt)+2<NT){WAIT_BAR(1);} else {WAIT_BAR(0);} }while(0)
  for(;t+1<NT;t+=2){
    STEP(pB0,pB1,pA0,pA1,t,(t+3<NT),(t+1<NT),(t+1<NT));       ENDW(t);   RESC(); ROT();
    STEP(pA0,pA1,pB0,pB1,t+1,(t+4<NT),(t+2<NT),(t+2<NT));     ENDW(t+1); RESC(); ROT();
  }
  STEP(pB0,pB1,pA0,pA1,NT-1,false,false,false); RESC();
  { float sacc=pB0[0]+pB0[1]; _Pragma("unroll") for(int r=2;r<16;++r)sacc+=pB0[r]; _Pragma("unroll") for(int r=0;r<16;++r)sacc+=pB1[r]; l_reg+=sacc;
    pw0=(u32x4){PKW(pB0,0),PKW(pB0,2),PKW(pB0,4),PKW(pB0,6)};pw1=(u32x4){PKW(pB0,8),PKW(pB0,10),PKW(pB0,12),PKW(pB0,14)};pw2=(u32x4){PKW(pB1,0),PKW(pB1,2),PKW(pB1,4),PKW(pB1,6)};pw3=(u32x4){PKW(pB1,8),PKW(pB1,10),PKW(pB1,12),PKW(pB1,14)};
    SBAR(); pv(o,vb0+sl_cur,PAF(0),PAF(1),PAF(2),PAF(3)); }
  #undef PKW
  #undef PAF
  #undef VFR
  #undef PIN
  #undef MX3
  #undef GAPA
  #undef GAPB
  #undef EX
  #undef VRD
  #undef KRD
  #undef STEP
  #undef ENDW
  u32x4 gpre[4];
  { const bf16*Gw0=Gb+(long)(wid*QBLK)*QP;
    #pragma unroll
    for(int i=0;i<4;++i)gpre[i]=*(const u32x4*)(Gw0+(long)(i*8+(lane>>3))*QP+(lane&7)*8); }
  {auto rr=__builtin_amdgcn_permlane32_swap(__float_as_uint(l_reg),__float_as_uint(l_reg),false,false);l_reg=__uint_as_float(rr[0])+__uint_as_float(rr[1]);}
  if(hi==0)wsf[32+r32]=l_reg;asm volatile("s_waitcnt lgkmcnt(0)":::"memory");
  float rli[16];
  #pragma unroll
  for(int r=0;r<16;++r)rli[r]=__builtin_amdgcn_rcpf(wsf[32+crow(r,hi)]);
  bf16*Ow=Ob+(long)(wid*QBLK)*QP; const bf16*Gw=Gb+(long)(wid*QBLK)*QP;
  { bf16*stg=(bf16*)(shm+LDS_OST)+wid*2048;
    #pragma unroll
    for(int r=0;r<16;++r){const int orow=crow(r,hi);
      #pragma unroll
      for(int d0=0;d0<2;++d0)stg[orow*64+d0*32+r32]=__float2bfloat16(o[d0][r]*rli[r]);}
    asm volatile("s_waitcnt lgkmcnt(0)":::"memory");
    #pragma unroll
    for(int i=0;i<4;++i){const int row=i*8+(lane>>3),ch=lane&7; const u32x4 v=*(const u32x4*)(stg+row*64+ch*8); const u32x4 g=gpre[i]; u32x4 w;
      #define GM(a,b) cvtpk_s(__uint_as_float((a)<<16)*__uint_as_float((b)<<16),__uint_as_float((a)&0xffff0000u)*__uint_as_float((b)&0xffff0000u))
      w.x=GM(v.x,g.x);w.y=GM(v.y,g.y);w.z=GM(v.z,g.z);w.w=GM(v.w,g.w);
      #undef GM
      ATTN_STORE16(Ow+(long)row*QP+ch*8,w);} }
  asm volatile("s_waitcnt lgkmcnt(0)\n\ts_barrier":::"memory");
  #undef DMA_K
  #undef DMA_V
  #undef CMASK
  #undef START
  #undef RESC
  #undef ROT
}
constexpr int ATTN_LDS_BYTES=LDS_BYTES;
#undef SBAR
#undef WAIT_BAR
}

__device__ __forceinline__ unsigned xb_ld(unsigned* p)              { return __hip_atomic_load(p, __ATOMIC_RELAXED, __HIP_MEMORY_SCOPE_AGENT); }
__device__ __forceinline__ unsigned xb_add(unsigned* p, unsigned v) { return __hip_atomic_fetch_add(p, v, __ATOMIC_RELAXED, __HIP_MEMORY_SCOPE_AGENT); }
#define XB_TMO      128
#define XB_XCNT(j)  (256  + 64 * (j))
#define XB_XSUB(j)  (1280 + 64 * (j))
#define XB_XGEN(j)  (2304 + 64 * (j))
#define XB_TOP      3328
#define XB_TOPGEN   3392
#define XCD_BAR_WORDS 3456
#define XB_SPIN_CAP (1u << 18)

__device__ __forceinline__ unsigned xb_xcc_id() { return (unsigned)__builtin_amdgcn_s_getreg((3 << 11) | 20) & 0xFu; }
#define XB_SPIN(cond, bar) do { unsigned _sp = 0; while (cond) { __builtin_amdgcn_s_sleep(1); \
    if ((++_sp & 255u) == 0u) { if (xb_ld(&(bar)[XB_TMO])) break; if (_sp > XB_SPIN_CAP) { atomicAdd(&(bar)[XB_TMO], 1u); break; } } } } while (0)

struct XcdBarrier {
    unsigned* bar; unsigned x;
    volatile LAS unsigned* st;
};

__device__ __forceinline__ XcdBarrier xcd_barrier_post(unsigned* bar, volatile LAS unsigned* st) {
    XcdBarrier b; b.bar = bar; b.x = xb_xcc_id(); b.st = st;
    if (threadIdx.x == 0) (void)xb_add(&bar[XB_XCNT(b.x)], 1u);
    return b;
}
__device__ __forceinline__ void xcd_barrier_complete(unsigned* bar, unsigned x, unsigned& nloc, unsigned& nx) {
    const unsigned G = gridDim.x * gridDim.y * gridDim.z;
    unsigned sum, cnt, mine, sp = 0u;
    for (;;) {
        sum = 0u; cnt = 0u; mine = 0u;
#pragma unroll
        for (unsigned j = 0; j < 16; ++j) { const unsigned c = xb_ld(&bar[XB_XCNT(j)]); sum += c; cnt += (c > 0u) ? 1u : 0u; mine = (j == x) ? c : mine; }
        if (sum == G) break;
        __builtin_amdgcn_s_sleep(1);
        if ((++sp & 255u) == 0u) { if (xb_ld(&bar[XB_TMO])) break; if (sp > XB_SPIN_CAP) { atomicAdd(&bar[XB_TMO], 1u); break; } }
    }
    nloc = mine > 0u ? mine : 1u; nx = cnt > 0u ? cnt : 1u;
}

__device__ __forceinline__ void xcd_barrier(const XcdBarrier& b) {
    asm volatile("s_waitcnt vmcnt(0)" ::: "memory");
    __syncthreads();
    if (threadIdx.x == 0) {
        unsigned* bar = b.bar;
        __builtin_amdgcn_s_waitcnt(0);
        unsigned nloc = b.st[0], nx = b.st[1];
        if (nloc == 0u) { xcd_barrier_complete(bar, b.x, nloc, nx); b.st[0] = nloc; b.st[1] = nx; }
        const unsigned old = xb_add(&bar[XB_XSUB(b.x)], 1u);
        const unsigned gen = old / nloc;
        if (old + 1u == (gen + 1u) * nloc) {
            __builtin_amdgcn_fence(__ATOMIC_RELEASE, "agent");
            asm volatile("s_waitcnt vmcnt(0)" ::: "memory");
            const unsigned og = xb_add(&bar[XB_TOP], 1u);
            const unsigned tg = og / nx;
            if (og + 1u == (tg + 1u) * nx) xb_add(&bar[XB_TOPGEN], 1u);
            else XB_SPIN(xb_ld(&bar[XB_TOPGEN]) == tg, bar);
            __builtin_amdgcn_fence(__ATOMIC_ACQUIRE, "agent");
            xb_add(&bar[XB_XGEN(b.x)], 1u);
            asm volatile("s_waitcnt vmcnt(0)" ::: "memory");
        } else {
            XB_SPIN(xb_ld(&bar[XB_XGEN(b.x)]) == gen, bar);
            __builtin_amdgcn_fence(__ATOMIC_ACQUIRE, "agent");
            asm volatile("s_waitcnt vmcnt(0)" ::: "memory");
        }
    }
    __syncthreads();
}

using pg8::Unit;
typedef f32x4 AccT[2][2][4][2];

struct EpiStore {
    const float* pscale; const float* kn; LAS float* xl;
    __device__ __forceinline__ void operator()(const AccT& acc, const Unit& u, int wr, int wc, int fr, int fq) const {
        asm volatile("" : "+v"(fr), "+v"(fq));
        bf16_t* base = (bf16_t*)u.O; const int ldc = u.ldc, kind = u.kind; const float sc = u.sc;
        if (kind == 5) {
            const int wid = wr * 4 + wc;
#pragma unroll
            for (int ai = 0; ai < 2; ++ai)
#pragma unroll
                for (int m = 0; m < 4; ++m) {
                    const f32x4 v0 = acc[ai][0][m][0], v1 = acc[ai][0][m][1];
                    float sq = (v0[0] * v0[0] + v0[1] * v0[1]) + (v0[2] * v0[2] + v0[3] * v0[3]) + (v1[0] * v1[0] + v1[1] * v1[1]) + (v1[2] * v1[2] + v1[3] * v1[3]);
                    sq += __shfl_xor(sq, 16); sq += __shfl_xor(sq, 32);
                    if (fq == 0) xl[((wid * 2 + ai) * 4 + m) * 16 + fr] = sq;
                }
            asm volatile("s_waitcnt lgkmcnt(0)" ::: "memory"); __builtin_amdgcn_s_barrier(); asm volatile("" ::: "memory");
            const float* gp = kn + 32 * (wc & 1) + 8 * fq;
            const f32x4 g0 = *(const f32x4*)gp, g1 = *(const f32x4*)(gp + 4);
            float inv[4];
#pragma unroll
            for (int jj = 0; jj < 4; ++jj) inv[jj] = __builtin_amdgcn_exp2f(-(float)(2 * (4 * fq + jj)) * (13.287712379549449f / 32.0f)) * 0.15915494309189535f;
#pragma unroll
            for (int ai = 0; ai < 2; ++ai)
#pragma unroll
                for (int m = 0; m < 4; ++m) {
                    const int row = ai * 128 + wr * 64 + m * 16 + fr, tok = u.r0 + row;
                    const int tl = (tok < T_P) ? (tok & (L_P - 1)) : ((tok - T_P) & (L_S - 1));
                    const float pos = (wc & 1) ? (float)(tl & 63) : (float)(tl >> 6);
                    const int xi = ((wid * 2 + ai) * 4 + m) * 16 + fr;
                    const float rinv = 1.0f / sqrtf((xl[xi] + xl[xi ^ 128]) * (1.f / 64.f) + EPS);
                    f32x4 v0 = acc[ai][0][m][0] * rinv * g0, v1 = acc[ai][0][m][1] * rinv * g1;
                    float c4[4], s4[4];
#pragma unroll
                    for (int jj = 0; jj < 4; ++jj) { const float rev = pos * inv[jj]; c4[jj] = __builtin_amdgcn_cosf(rev); s4[jj] = __builtin_amdgcn_sinf(rev); }
                    bf16_t* rowp = base + (size_t)row * 256 + wc * 32 + 8 * fq;
                    u32x4 w;
                    w.x = pk2(v0[0] * c4[0] - v0[1] * s4[0], v0[0] * s4[0] + v0[1] * c4[0]); w.y = pk2(v0[2] * c4[1] - v0[3] * s4[1], v0[2] * s4[1] + v0[3] * c4[1]);
                    w.z = pk2(v1[0] * c4[2] - v1[1] * s4[2], v1[0] * s4[2] + v1[1] * c4[2]); w.w = pk2(v1[2] * c4[3] - v1[3] * s4[3], v1[2] * s4[3] + v1[3] * c4[3]);
                    *(u32x4*)rowp = w;
                    const f32x4 a0 = acc[ai][1][m][0], a1 = acc[ai][1][m][1];
                    w.x = pk2(a0[0], a0[1]); w.y = pk2(a0[2], a0[3]); w.z = pk2(a1[0], a1[1]); w.w = pk2(a1[2], a1[3]);
                    *(u32x4*)(rowp + 128) = w;
                }
            return;
        }
#pragma unroll
        for (int ai = 0; ai < 2; ++ai)
#pragma unroll
            for (int m = 0; m < 4; ++m) {
                bf16_t* rowp = base + (size_t)(ai * 128 + wr * 64 + m * 16 + fr) * ldc + wc * 32 + 8 * fq;
#pragma unroll
                for (int bj = 0; bj < 2; ++bj) {
                    f32x4 v0 = acc[ai][bj][m][0], v1 = acc[ai][bj][m][1];
                    if (kind == 1) {
#pragma unroll
                        for (int e = 0; e < 4; ++e) { v0[e] = siluf_(v0[e]); v1[e] = siluf_(v1[e]); }
                    } else if (kind == 2) { v0 = v0 * sc; v1 = v1 * sc; }
                    u32x4 w; w.x = pk2(v0[0], v0[1]); w.y = pk2(v0[2], v0[3]); w.z = pk2(v1[0], v1[1]); w.w = pk2(v1[2], v1[3]);
                    *(u32x4*)(rowp + bj * 128) = w;
                }
            }
    }
};
struct EpiGate {
    const float* bmerge; char* scr;
    __device__ __forceinline__ void operator()(const AccT& acc, const Unit& u, int wr, int wc, int fr, int fq) const {
        asm volatile("" : "+v"(fr), "+v"(fq));
        int tid = threadIdx.x; const int n = u.aux; asm volatile("" : "+v"(tid));
        u32x4* gst = (u32x4*)scr;
        if (u.kind == 0) {
            const float* bp = bmerge + n * 1024 + u.c0 + wc * 32 + 8 * fq;
            f32x4 bb[2][2];
#pragma unroll
            for (int bj = 0; bj < 2; ++bj) { bb[bj][0] = *(const f32x4*)(bp + bj * 128); bb[bj][1] = *(const f32x4*)(bp + bj * 128 + 4); }
#pragma unroll
            for (int bj = 0; bj < 2; ++bj) {
#pragma unroll
                for (int ai = 0; ai < 2; ++ai)
#pragma unroll
                    for (int m = 0; m < 4; ++m) {
                        const f32x4 v0 = (acc[ai][bj][m][0] + bb[bj][0]) * (-LOG2E), v1 = (acc[ai][bj][m][1] + bb[bj][1]) * (-LOG2E);
                        u32x4 w; w.x = pk2(__builtin_amdgcn_exp2f(v0[0]), __builtin_amdgcn_exp2f(v0[1])); w.y = pk2(__builtin_amdgcn_exp2f(v0[2]), __builtin_amdgcn_exp2f(v0[3]));
                        w.z = pk2(__builtin_amdgcn_exp2f(v1[0]), __builtin_amdgcn_exp2f(v1[1])); w.w = pk2(__builtin_amdgcn_exp2f(v1[2]), __builtin_amdgcn_exp2f(v1[3]));
                        gst[((ai * 2 + bj) * 4 + m) * 512 + tid] = w;
                    }
                asm volatile("" ::: "memory");
            }
        } else {
            bf16_t* base = (bf16_t*)u.O;
            u32x4* mst = (u32x4*)(scr + 131072);
#pragma unroll
            for (int ai = 0; ai < 2; ++ai) {
                u32x4 g[8], pm[8];
#pragma unroll
                for (int e = 0; e < 8; ++e) { const int si = (ai * 2 + (e & 1)) * 4 + (e >> 1); g[e] = gst[si * 512 + tid]; if (n > 0) pm[e] = mst[si * 512 + tid]; }
#pragma unroll
                for (int e = 0; e < 8; ++e) {
                    const int bj = e & 1, m = e >> 1, si = (ai * 2 + bj) * 4 + m;
                    f32x4 v0 = acc[ai][bj][m][0], v1 = acc[ai][bj][m][1];
#define GSIG(x_) fast_rcp(1.0f + (x_))
                    v0[0] *= GSIG(bflo(g[e].x)); v0[1] *= GSIG(bfhi(g[e].x)); v0[2] *= GSIG(bflo(g[e].y)); v0[3] *= GSIG(bfhi(g[e].y));
                    v1[0] *= GSIG(bflo(g[e].z)); v1[1] *= GSIG(bfhi(g[e].z)); v1[2] *= GSIG(bflo(g[e].w)); v1[3] *= GSIG(bfhi(g[e].w));
#undef GSIG
                    if (n > 0) { v0[0] += bflo(pm[e].x); v0[1] += bfhi(pm[e].x); v0[2] += bflo(pm[e].y); v0[3] += bfhi(pm[e].y);
                                 v1[0] += bflo(pm[e].z); v1[1] += bfhi(pm[e].z); v1[2] += bflo(pm[e].w); v1[3] += bfhi(pm[e].w); }
                    u32x4 w; w.x = pk2(v0[0], v0[1]); w.y = pk2(v0[2], v0[3]); w.z = pk2(v1[0], v1[1]); w.w = pk2(v1[2], v1[3]);
                    if (n < 2) mst[si * 512 + tid] = w;
                    else *(u32x4*)(base + (size_t)(ai * 128 + wr * 64 + m * 16 + fr) * 1024 + wc * 32 + 8 * fq + bj * 128) = w;
                }
                asm volatile("" ::: "memory");
            }
        }
    }
};
struct EpiOut {
    float* ss; unsigned* cnt; const float* xp; const float* xs; const float* gpost; float* out;
    __device__ __forceinline__ void operator()(const AccT& acc, const Unit& u, int wr, int wc, int fr, int fq) const {
        asm volatile("" : "+v"(fr), "+v"(fq));
        const int pm = u.r0 >> 8;
        const float* xb = (u.r0 < T_P) ? xp + (size_t)u.r0 * DM : xs + (size_t)(u.r0 - T_P) * DM;
        float* ob = out + (size_t)u.r0 * DM;
        const int colb = u.c0 + wc * 32 + 8 * fq;
        f32x4 gg[2][2], xv[4][2][2];
#pragma unroll
        for (int bj = 0; bj < 2; ++bj) { gg[bj][0] = *(const f32x4*)(gpost + colb + bj * 128); gg[bj][1] = *(const f32x4*)(gpost + colb + bj * 128 + 4); }
#pragma unroll
        for (int m = 0; m < 4; ++m) { const int row = wr * 64 + m * 16 + fr;
#pragma unroll
            for (int bj = 0; bj < 2; ++bj) { const size_t off = (size_t)row * DM + colb + bj * 128; xv[m][bj][0] = *(const f32x4*)(xb + off); xv[m][bj][1] = *(const f32x4*)(xb + off + 4); } }
#pragma unroll
        for (int ai = 0; ai < 2; ++ai)
#pragma unroll
            for (int m = 0; m < 4; ++m) {
                float s = 0.f;
#pragma unroll
                for (int bj = 0; bj < 2; ++bj) {
                    const f32x4 v0 = acc[ai][bj][m][0], v1 = acc[ai][bj][m][1];
                    s += (v0[0] * v0[0] + v0[1] * v0[1]) + (v0[2] * v0[2] + v0[3] * v0[3]) + (v1[0] * v1[0] + v1[1] * v1[1]) + (v1[2] * v1[2] + v1[3] * v1[3]);
                }
                s += __shfl_xor(s, 16); s += __shfl_xor(s, 32);
                if (fq == 0) __hip_atomic_fetch_add(ss + u.r0 + ai * 128 + wr * 64 + m * 16 + fr, s, __ATOMIC_RELAXED, __HIP_MEMORY_SCOPE_AGENT);
            }
        asm volatile("s_waitcnt vmcnt(0)" ::: "memory");
        __builtin_amdgcn_s_barrier();
        if (threadIdx.x == 0) __hip_atomic_fetch_add(cnt + pm, 1u, __ATOMIC_RELAXED, __HIP_MEMORY_SCOPE_AGENT);
        { unsigned sp = 0;
          while ((unsigned)__builtin_amdgcn_readfirstlane(__hip_atomic_load(cnt + pm, __ATOMIC_RELAXED, __HIP_MEMORY_SCOPE_AGENT)) < 4u && sp < (1u << 22)) { __builtin_amdgcn_s_sleep(2); ++sp; } }
        asm volatile("" ::: "memory");
        float sv[2][4];
#pragma unroll
        for (int ai = 0; ai < 2; ++ai)
#pragma unroll
            for (int m = 0; m < 4; ++m) sv[ai][m] = __hip_atomic_load(ss + u.r0 + ai * 128 + wr * 64 + m * 16 + fr, __ATOMIC_RELAXED, __HIP_MEMORY_SCOPE_AGENT);
#pragma unroll
        for (int ai = 0; ai < 2; ++ai) {
            if (ai == 1) {
#pragma unroll
                for (int m = 0; m < 4; ++m) { const int row = 128 + wr * 64 + m * 16 + fr;
#pragma unroll
                    for (int bj = 0; bj < 2; ++bj) { const size_t off = (size_t)row * DM + colb + bj * 128; xv[m][bj][0] = *(const f32x4*)(xb + off); xv[m][bj][1] = *(const f32x4*)(xb + off + 4); } }
            }
#pragma unroll
            for (int m = 0; m < 4; ++m) { const int row = ai * 128 + wr * 64 + m * 16 + fr;
                const float rinv = 1.0f / sqrtf(sv[ai][m] * (1.f / 1024.f) + EPS);
#pragma unroll
                for (int bj = 0; bj < 2; ++bj) { const size_t off = (size_t)row * DM + colb + bj * 128;
                    *(f32x4*)(ob + off) = xv[m][bj][0] + acc[ai][bj][m][0] * rinv * gg[bj][0];
                    *(f32x4*)(ob + off + 4) = xv[m][bj][1] + acc[ai][bj][m][1] * rinv * gg[bj][1]; } }
            asm volatile("" ::: "memory");
        }
    }
};

struct Ptrs {
    unsigned char* ws;
    __device__ __forceinline__ char* at(size_t off) const { return (char*)ws + off; }
};
struct SchedP1 {
    Ptrs P; int G, c;
    __device__ __forceinline__ bool next(int i, Unit& u) const {
        const int L = i * G + c; constexpr int N1 = 320 * 13, N2 = 18 * 4;
        if (L >= N1 + N2) return false;
        u.nt = 16; u.aux = 0; u.sc = 1.f;
        if (L < N1) {
            int pm, pn; pg8::tile_order(L, 320, 13, pm, pn);
            u.A = P.at(WS_XN) + (size_t)pm * 256 * 2048; u.B = P.at(WS_WIN) + (size_t)pn * 256 * 2048; u.r0 = pm * 256;
            size_t dst; int col, ldc = 1024, kind = 0;
            if (pn < 2) { dst = WS_ZA; col = pn * 256; }
            else if (pn < 4) { dst = WS_ZA; col = 512 + (pn - 2) * 256; kind = 1; }
            else if (pn < 6) { dst = WS_ZB; col = (pn - 4) * 256; }
            else if (pn == 6) { dst = WS_ZD; col = 0; ldc = 256; kind = 5; }
            else if (pn < 9) { dst = WS_ZB; col = 512 + (pn - 7) * 256; kind = 1; }
            else if (pn < 11) { dst = WS_ZC; col = (pn - 9) * 256; kind = 2; u.sc = C2_CROSS; }
            else { dst = WS_ZC; col = 512 + (pn - 11) * 256; kind = 1; }
            u.kind = kind; u.ldc = ldc; u.c0 = col; u.O = P.at(dst) + ((size_t)pm * 256 * ldc + col) * 2;
        } else {
            const int l = L - N1, pm = l >> 2, pn = l & 3;
            u.A = P.at(WS_MEMN) + (size_t)pm * 256 * 2048; u.B = P.at(WS_WMKV) + (size_t)pn * 256 * 2048; u.r0 = pm * 256; u.c0 = pn * 256;
            u.kind = 0; u.ldc = 1024; u.O = P.at(WS_MKV) + ((size_t)pm * 256 * 1024 + pn * 256) * 2;
        }
        return true;
    }
};
struct SchedMerge {
    Ptrs P; int G, c;
    __device__ __forceinline__ bool next(int i, Unit& u) const {
        const int ti = i / 6, sub = i - ti * 6; const int L = ti * G + c; if (L >= 1280) return false;
        int pm, pn; pg8::tile_order(L, 320, 4, pm, pn);
        const int n = sub >> 1; u.aux = n; u.r0 = pm * 256; u.c0 = pn * 256; u.ldc = 1024; u.sc = 1.f;
        u.O = P.at(WS_ZA) + ((size_t)pm * 256 * 1024 + pn * 256) * 2;
        if ((sub & 1) == 0) { u.kind = 0; u.nt = 16; u.A = P.at(WS_XN) + (size_t)pm * 256 * 2048; u.B = P.at(WS_WIN) + (size_t)(ZW + n * 1024 + pn * 256) * 2048; }
        else { u.kind = 1; u.nt = 8;
            u.A = P.at(n == 0 ? WS_MIX : (n == 1 ? WS_ZB : WS_ZC)) + (size_t)pm * 256 * 2048;
            u.B = P.at(n < 2 ? WS_WB01 : WS_WB2P) + ((size_t)pn * 256 * 1024 + (n == 1 ? 512 : 0)) * 2; }
        return true;
    }
};
struct SchedOut {
    Ptrs P; int G, c;
    __device__ __forceinline__ bool next(int i, Unit& u) const {
        const int L = i * G + c; if (L >= 1280) return false;
        int pm, pn; pg8::tile_order(L, 320, 4, pm, pn);
        u.A = P.at(WS_ZA) + (size_t)pm * 256 * 2048; u.B = P.at(WS_WOUT) + (size_t)pn * 256 * 2048;
        u.nt = 16; u.kind = 0; u.r0 = pm * 256; u.c0 = pn * 256; u.aux = 0; u.ldc = 1024; u.sc = 1.f;
        u.O = P.at(WS_XN) + ((size_t)pm * 256 * 1024 + pn * 256) * 2;
        return true;
    }
};

__device__ __forceinline__ void cross_attn_phase(bf16_t* ZC, const bf16_t* MKV, LAS unsigned char* lds, int vcu, int G) {
    constexpr int D = 128, KPL = 136, VPL = 260;
    const int tid = threadIdx.x, lane = tid & 63, r32 = lane & 31, hi = lane >> 5; const int wid = __builtin_amdgcn_readfirstlane(tid >> 6);
    LAS bf16_t* Ks = (LAS bf16_t*)lds;
    LAS bf16_t* Vt = (LAS bf16_t*)(lds + 256 * KPL * 2);
    LAS float* wsf = (LAS float*)(lds + 256 * KPL * 2 + D * VPL * 2) + wid * 32;
    const int i_lo = (int)((long)vcu * 1280 / G), i_hi = (int)((long)(vcu + 1) * 1280 / G);
    int loaded = -1;
    for (int I = i_lo; I < i_hi; ++I) {
        int bh, qt, row0;
        if (I < 256) { bh = I >> 5; qt = I & 31; row0 = (bh >> 2) * L_P + qt * 256; }
        else { const int J = I - 256; bh = 8 + (J >> 4); qt = J & 15; row0 = T_P + ((bh >> 2) - 2) * L_S + qt * 256; }
        const int b = bh >> 2, h = bh & 3;
        if (bh != loaded) {
            __syncthreads();
            const bf16_t* Kg = MKV + (size_t)b * NMEM * 1024 + h * 128; const bf16_t* Vg = Kg + 512;
#pragma unroll
            for (int c = 0; c < 8; ++c) { const int idx = tid + c * 512, key = idx >> 4, ch = idx & 15;
                const u32x4 kv = *(const u32x4*)(Kg + (size_t)key * 1024 + ch * 8), vv = *(const u32x4*)(Vg + (size_t)key * 1024 + ch * 8);
                *(LAS u32x4*)(Ks + key * KPL + ch * 8) = kv;
                const unsigned w[4] = {vv.x, vv.y, vv.z, vv.w};
#pragma unroll
                for (int j = 0; j < 4; ++j) { Vt[(ch * 8 + 2 * j) * VPL + key] = (bf16_t)(w[j] & 0xffffu); Vt[(ch * 8 + 2 * j + 1) * VPL + key] = (bf16_t)(w[j] >> 16); } }
            __syncthreads();
            loaded = bh;
        }
        bf16_t* Q = ZC + (size_t)(row0 + wid * 32) * 1024 + h * 128;
        bf16x8 qf[D / 16];
#pragma unroll
        for (int d0 = 0; d0 < D / 16; ++d0) qf[d0] = *(const bf16x8*)(Q + (size_t)r32 * 1024 + d0 * 16 + hi * 8);
        f32x16 o[D / 32];
#pragma unroll
        for (int dt = 0; dt < D / 32; ++dt)
#pragma unroll
            for (int r = 0; r < 16; ++r) o[dt][r] = 0.f;
        float m_run = -1e30f, l_run = 0.f;
#pragma unroll 1
        for (int kt = 0; kt < 4; ++kt) {
            f32x16 s0, s1;
#pragma unroll
            for (int r = 0; r < 16; ++r) { s0[r] = 0.f; s1[r] = 0.f; }
#pragma unroll
            for (int d0 = 0; d0 < D / 16; ++d0) {
                const bf16x8 a0 = *(const LAS bf16x8*)(Ks + (kt * 64 + r32) * KPL + d0 * 16 + hi * 8);
                const bf16x8 a1 = *(const LAS bf16x8*)(Ks + (kt * 64 + 32 + r32) * KPL + d0 * 16 + hi * 8);
                s0 = __builtin_amdgcn_mfma_f32_32x32x16_bf16(a0, qf[d0], s0, 0, 0, 0);
                s1 = __builtin_amdgcn_mfma_f32_32x32x16_bf16(a1, qf[d0], s1, 0, 0, 0);
            }
            float mx = s0[0];
#pragma unroll
            for (int r = 0; r < 16; ++r) { mx = fmaxf(mx, s0[r]); mx = fmaxf(mx, s1[r]); }
            mx = fmaxf(mx, __shfl_xor(mx, 32));
            const float m_new = fmaxf(m_run, mx);
            const float alpha = __builtin_amdgcn_exp2f(m_run - m_new);
            m_run = m_new;
            float rs = 0.f;
#pragma unroll
            for (int r = 0; r < 16; ++r) { s0[r] = __builtin_amdgcn_exp2f(s0[r] - m_new); s1[r] = __builtin_amdgcn_exp2f(s1[r] - m_new); rs += s0[r] + s1[r]; }
            l_run = l_run * alpha + rs;
            if (kt > 0) {
                __builtin_amdgcn_wave_barrier();
                if (hi == 0) wsf[r32] = alpha;
                __builtin_amdgcn_fence(__ATOMIC_RELEASE, "wavefront"); __builtin_amdgcn_wave_barrier(); __builtin_amdgcn_fence(__ATOMIC_ACQUIRE, "wavefront");
#pragma unroll
                for (int r = 0; r < 16; ++r) { const float a = wsf[crow(r, hi)];
#pragma unroll
                    for (int dt = 0; dt < D / 32; ++dt) o[dt][r] *= a; }
            }
            bf16x8 pw[4];
            { u32x4 p;
              p.x = pk2(s0[0], s0[1]); p.y = pk2(s0[2], s0[3]); p.z = pk2(s0[4], s0[5]); p.w = pk2(s0[6], s0[7]); pw[0] = __builtin_bit_cast(bf16x8, p);
              p.x = pk2(s0[8], s0[9]); p.y = pk2(s0[10], s0[11]); p.z = pk2(s0[12], s0[13]); p.w = pk2(s0[14], s0[15]); pw[1] = __builtin_bit_cast(bf16x8, p);
              p.x = pk2(s1[0], s1[1]); p.y = pk2(s1[2], s1[3]); p.z = pk2(s1[4], s1[5]); p.w = pk2(s1[6], s1[7]); pw[2] = __builtin_bit_cast(bf16x8, p);
              p.x = pk2(s1[8], s1[9]); p.y = pk2(s1[10], s1[11]); p.z = pk2(s1[12], s1[13]); p.w = pk2(s1[14], s1[15]); pw[3] = __builtin_bit_cast(bf16x8, p); }
#pragma unroll
            for (int dt = 0; dt < D / 32; ++dt)
#pragma unroll
                for (int ks = 0; ks < 4; ++ks) {
                    const LAS bf16_t* vp = Vt + (dt * 32 + r32) * VPL + kt * 64 + 16 * ks + 4 * hi;
                    const s16x4 lo = *(const LAS s16x4*)vp, hh = *(const LAS s16x4*)(vp + 8);
                    const bf16x8 bb = __builtin_shufflevector(lo, hh, 0, 1, 2, 3, 4, 5, 6, 7);
                    o[dt] = __builtin_amdgcn_mfma_f32_32x32x16_bf16(pw[ks], bb, o[dt], 0, 0, 0);
                }
        }
        l_run += __shfl_xor(l_run, 32);
        __builtin_amdgcn_wave_barrier();
        if (hi == 0) wsf[r32] = fast_rcp(l_run);
        __builtin_amdgcn_fence(__ATOMIC_RELEASE, "wavefront"); __builtin_amdgcn_wave_barrier(); __builtin_amdgcn_fence(__ATOMIC_ACQUIRE, "wavefront");
#pragma unroll
        for (int r = 0; r < 16; ++r) {
            const int row = crow(r, hi); const float inv = wsf[row];
#pragma unroll
            for (int dt = 0; dt < D / 32; ++dt) {
                const int col = dt * 32 + r32;
                const float g = __builtin_bit_cast(float, (unsigned)Q[(size_t)row * 1024 + 512 + col] << 16);
                Q[(size_t)row * 1024 + col] = (bf16_t)f2bf(o[dt][r] * inv * g);
            }
        }
        __builtin_amdgcn_wave_barrier();
    }
    __syncthreads();
}

__device__ __forceinline__ void transpose_item(const float* W, int ldw, int nblk, bf16_t* WT, LAS float* scr, int item, int lane) {
    const int kb = item / nblk, nb = item % nblk, k0 = 64 * kb, n0 = 32 * nb;
#pragma unroll 8
    for (int i = 0; i < 32; ++i) { const int kk = 2 * i + (lane >> 5); scr[kk * 33 + (lane & 31)] = W[(size_t)(k0 + kk) * ldw + n0 + (lane & 31)]; }
    asm volatile("s_waitcnt lgkmcnt(0)" ::: "memory");
    const int c = lane & 7;
#pragma unroll
    for (int j = 0; j < 4; ++j) { const int n = (lane >> 3) + 8 * j; const LAS float* s = scr + (8 * c) * 33 + n;
        u32x4 o; o.x = pk2(s[0 * 33], s[1 * 33]); o.y = pk2(s[2 * 33], s[3 * 33]); o.z = pk2(s[4 * 33], s[5 * 33]); o.w = pk2(s[6 * 33], s[7 * 33]);
        *(u32x4*)(WT + (size_t)(n0 + n) * 1024 + k0 + 8 * c) = o; }
    asm volatile("s_waitcnt lgkmcnt(0)" ::: "memory");
}
__device__ __forceinline__ void rms_row_to_bf16(const float* xrow, const float* g, bf16_t* orow, int lane) {
    const f32x4* xr = (const f32x4*)xrow + lane; const f32x4* gr = (const f32x4*)g + lane;
    f32x4 v[4]; float s = 0.f;
#pragma unroll
    for (int j = 0; j < 4; ++j) { v[j] = xr[64 * j]; s += (v[j].x * v[j].x + v[j].y * v[j].y) + (v[j].z * v[j].z + v[j].w * v[j].w); }
    const float rinv = 1.0f / sqrtf(wave_sum(s) * (1.f / 1024.f) + EPS);
    u32x2* o8 = (u32x2*)orow + lane;
#pragma unroll
    for (int j = 0; j < 4; ++j) { const f32x4 gg = gr[64 * j]; u32x2 w; w.x = pk2(v[j].x * rinv * gg.x, v[j].y * rinv * gg.y); w.y = pk2(v[j].z * rinv * gg.z, v[j].w * rinv * gg.w); o8[64 * j] = w; }
}

__device__ __forceinline__ void rms_row2_to_bf16(const float* xa, const float* xb, const float* g, bf16_t* oa, bf16_t* ob, int lane) {
    const f32x4* ra = (const f32x4*)xa + lane; const f32x4* rb = (const f32x4*)xb + lane; const f32x4* gr = (const f32x4*)g + lane;
    f32x4 va[4], vb[4]; float sa = 0.f, sb = 0.f;
#pragma unroll
    for (int j = 0; j < 4; ++j) { va[j] = ra[64 * j]; vb[j] = rb[64 * j]; }
#pragma unroll
    for (int j = 0; j < 4; ++j) { sa += (va[j].x * va[j].x + va[j].y * va[j].y) + (va[j].z * va[j].z + va[j].w * va[j].w); sb += (vb[j].x * vb[j].x + vb[j].y * vb[j].y) + (vb[j].z * vb[j].z + vb[j].w * vb[j].w); }
#pragma unroll
    for (int o = 1; o < 64; o <<= 1) { sa += __shfl_xor(sa, o); sb += __shfl_xor(sb, o); }
    const float ia = 1.0f / sqrtf(sa * (1.f / 1024.f) + EPS), ib = 1.0f / sqrtf(sb * (1.f / 1024.f) + EPS);
    u32x2* pa = (u32x2*)oa + lane; u32x2* pb = (u32x2*)ob + lane;
#pragma unroll
    for (int j = 0; j < 4; ++j) { const f32x4 gg = gr[64 * j]; u32x2 w;
        w.x = pk2(va[j].x * ia * gg.x, va[j].y * ia * gg.y); w.y = pk2(va[j].z * ia * gg.z, va[j].w * ia * gg.w); pa[64 * j] = w;
        w.x = pk2(vb[j].x * ib * gg.x, vb[j].y * ib * gg.y); w.y = pk2(vb[j].z * ib * gg.z, vb[j].w * ib * gg.w); pb[64 * j] = w; }
}

__device__ __forceinline__ void rms_row4_to_bf16(const float* x0, const float* x1, const float* x2, const float* x3, const float* g, bf16_t* o0, bf16_t* o1, bf16_t* o2, bf16_t* o3, int lane) {
    const f32x4* r[4] = {(const f32x4*)x0 + lane, (const f32x4*)x1 + lane, (const f32x4*)x2 + lane, (const f32x4*)x3 + lane}; const f32x4* gr = (const f32x4*)g + lane;
    u32x2* po[4] = {(u32x2*)o0 + lane, (u32x2*)o1 + lane, (u32x2*)o2 + lane, (u32x2*)o3 + lane};
    f32x4 v[4][4]; float sq[4] = {0.f, 0.f, 0.f, 0.f};
#pragma unroll
    for (int q = 0; q < 4; ++q)
#pragma unroll
        for (int j = 0; j < 4; ++j) v[q][j] = __builtin_nontemporal_load(r[q] + 64 * j);
#pragma unroll
    for (int q = 0; q < 4; ++q)
#pragma unroll
        for (int j = 0; j < 4; ++j) sq[q] += (v[q][j].x * v[q][j].x + v[q][j].y * v[q][j].y) + (v[q][j].z * v[q][j].z + v[q][j].w * v[q][j].w);
#pragma unroll
    for (int o = 1; o < 64; o <<= 1) { sq[0] += __shfl_xor(sq[0], o); sq[1] += __shfl_xor(sq[1], o); sq[2] += __shfl_xor(sq[2], o); sq[3] += __shfl_xor(sq[3], o); }
#pragma unroll
    for (int j = 0; j < 4; ++j) { const f32x4 gg = gr[64 * j];
#pragma unroll
        for (int q = 0; q < 4; ++q) { const float iv = 1.0f / sqrtf(sq[q] * (1.f / 1024.f) + EPS); u32x2 w;
            w.x = pk2(v[q][j].x * iv * gg.x, v[q][j].y * iv * gg.y); w.y = pk2(v[q][j].z * iv * gg.z, v[q][j].w * iv * gg.w); po[q][64 * j] = w; } }
}

struct Args { const float* in[16]; float* out; unsigned char* ws; };

__global__ void __launch_bounds__(512) fwd_megakernel(Args args) {
    extern __shared__ __attribute__((aligned(16))) unsigned char lds_raw[];
    LAS unsigned char* lds = (LAS unsigned char*)lds_raw;
    cg::grid_group grid = cg::this_grid();
    volatile LAS unsigned* xb_st = (volatile LAS unsigned*)(lds + LDS_BYTES - 16);
    if (threadIdx.x == 0) { xb_st[0] = 0u; xb_st[1] = 0u; }
    __syncthreads();
    const XcdBarrier xbar = xcd_barrier_post((unsigned*)(args.ws + WS_BAR), xb_st);
    const int tid = threadIdx.x, lane = tid & 63; const int wave = __builtin_amdgcn_readfirstlane(tid >> 6);
    const int G = gridDim.x, bx = blockIdx.x;
    const int vcu = (G % 8 == 0) ? (bx % 8) * (G / 8) + bx / 8 : bx;
    const int gw = vcu * NWAVES + wave, NGW = G * NWAVES;
    unsigned char* ws = args.ws; Ptrs P{ws};
    const float* x_prompt = args.in[0]; const float* x_sample = args.in[1]; const float* mem_prompt = args.in[2]; const float* mem_sample = args.in[3];
    const float* ln_pre = args.in[4]; const float* ln_post = args.in[5]; const float* ln_mem = args.in[6]; const float* w_in = args.in[7];
    const float* b_merge = args.in[8]; const float* q_norm = args.in[9]; const float* k_norm = args.in[10]; const float* w_pool = args.in[11];
    const float* pool_scale = args.in[12]; const float* w_mem_kv = args.in[13]; const float* w_branch = args.in[14]; const float* w_out = args.in[15];
    bf16_t* XN = (bf16_t*)(ws + WS_XN); bf16_t* ZA = (bf16_t*)(ws + WS_ZA); bf16_t* ZB = (bf16_t*)(ws + WS_ZB); bf16_t* ZC = (bf16_t*)(ws + WS_ZC);
    bf16_t* ZD = (bf16_t*)(ws + WS_ZD); bf16_t* MIX = (bf16_t*)(ws + WS_MIX); bf16_t* MEMN = (bf16_t*)(ws + WS_MEMN); bf16_t* MKV = (bf16_t*)(ws + WS_MKV);
    float* SS = (float*)(ws + WS_SS);

    {
        LAS float* scr = (LAS float*)(lds + wave * 16384);
        constexpr int I_IN = 16 * 184, I_SQ = 16 * 32, I_BR = 8 * 32;
        constexpr int NITEMS = I_IN + 2 * I_SQ + 3 * I_BR;
        for (int it = gw; it < NITEMS; it += NGW) {
            int r = it;
            if (r < I_IN) { transpose_item(w_in + 512, IN_DIM, 184, (bf16_t*)(ws + WS_WIN) + (size_t)512 * 1024, scr, r, lane); continue; } r -= I_IN;
            if (r < I_SQ) { transpose_item(w_mem_kv, 1024, 32, (bf16_t*)(ws + WS_WMKV), scr, r, lane); continue; } r -= I_SQ;
            if (r < I_SQ) { transpose_item(w_out, 1024, 32, (bf16_t*)(ws + WS_WOUT), scr, r, lane); continue; } r -= I_SQ;
            if (r < 3 * I_BR) { const int n = r / I_BR; r -= n * I_BR;
                transpose_item(w_branch + (size_t)n * 512 * 1024, 1024, 32, (bf16_t*)(ws + (n < 2 ? WS_WB01 : WS_WB2P)) + (n == 1 ? 512 : 0), scr, r, lane); continue; }
        }
        for (int it = NGW - 1 - gw; it < 128 * 4 * 2; it += NGW) {
            const int kb = it >> 3, g = (it >> 1) & 3, dh = it & 1, d = dh * 64 + lane;
            const float* wi = w_in + (size_t)(kb * 8) * IN_DIM + g * 128; const float* wp = w_pool + (size_t)g * 128 * 128 + d;
            float a8[8] = {0.f, 0.f, 0.f, 0.f, 0.f, 0.f, 0.f, 0.f};
#pragma unroll 4
            for (int c = 0; c < 128; ++c) { const float b = wp[(size_t)c * 128];
#pragma unroll
                for (int kk = 0; kk < 8; ++kk) a8[kk] += wi[(size_t)kk * IN_DIM + c] * b; }
            u32x4 o; o.x = pk2(a8[0], a8[1]); o.y = pk2(a8[2], a8[3]); o.z = pk2(a8[4], a8[5]); o.w = pk2(a8[6], a8[7]);
            *(u32x4*)((bf16_t*)(ws + WS_WIN) + (size_t)(g * 128 + d) * 1024 + kb * 8) = o;
        }
        for (int m = gw; m < T; m += 4 * NGW) {
            const float* xr[4]; int mr[4];
#pragma unroll
            for (int q = 0; q < 4; ++q) { const int mq = m + q * NGW; mr[q] = (mq < T) ? mq : m; xr[q] = (mr[q] < T_P) ? x_prompt + (size_t)mr[q] * DM : x_sample + (size_t)(mr[q] - T_P) * DM; }
            rms_row4_to_bf16(xr[0], xr[1], xr[2], xr[3], ln_pre, XN + (size_t)mr[0] * DM, XN + (size_t)mr[1] * DM, XN + (size_t)mr[2] * DM, XN + (size_t)mr[3] * DM, lane);
        }
        for (int m = gw; m < MEMROWS; m += NGW) { const float* xr = (m < 2 * NMEM) ? mem_prompt + (size_t)m * DM : mem_sample + (size_t)(m - 2 * NMEM) * DM; rms_row_to_bf16(xr, ln_mem, MEMN + (size_t)m * DM, lane); }
        for (int i = bx * 512 + tid; i < T; i += G * 512) SS[i] = 0.f;
        if (bx == 0 && tid < 320) ((unsigned*)(ws + WS_CNT))[tid] = 0u;
        if (bx == 0 && tid < 64) ((unsigned*)(ws + WS_CNT + 4096))[tid] = 0u;
    }
    grid.sync();

    { SchedP1 S{P, G, bx}; EpiStore E{pool_scale, k_norm, (LAS float*)(lds + 131072)}; pg8::gemm_phase(lds, S, E); }
#if DUP_MASK & 1
    __syncthreads();
    { SchedP1 S{P, G, bx}; EpiStore E{pool_scale, k_norm, (LAS float*)(lds + 131072)}; pg8::gemm_phase(lds, S, E); }
#endif
    xcd_barrier(xbar);

    {
        for (int it = gw; it < 4 * (T / 32); it += NGW) {
            const int g = (it + it / NGW) & 3, tok0 = ((it >> 2) * 4 + (lane >> 4)) * 8, col = g * 128 + (lane & 15) * 8;
            const int Lq = (tok0 < T_P) ? L_P : L_S; const int tl0 = (tok0 < T_P) ? (tok0 & (L_P - 1)) : ((tok0 - T_P) & (L_S - 1));
            const bf16_t* bp = ZA + (size_t)tok0 * 1024 + col;
            const f32x4 p0 = *(const f32x4*)(pool_scale + col), p1 = *(const f32x4*)(pool_scale + col + 4);
            u32x4 gt[4];
#pragma unroll
            for (int i = 0; i < 4; ++i) gt[i] = *(const u32x4*)(bp + (size_t)i * 1024 + 512);
#define UNP(V_, F_) { F_[0] = bflo((V_).x); F_[1] = bfhi((V_).x); F_[2] = bflo((V_).y); F_[3] = bfhi((V_).y); F_[4] = bflo((V_).z); F_[5] = bfhi((V_).z); F_[6] = bflo((V_).w); F_[7] = bfhi((V_).w); }
#define MK(j_) (((unsigned)(tl0 - W_ / 2 + (j_)) < (unsigned)Lq) ? 1.f : 0.f)
#define POOL_RUN(WW) { constexpr int W_ = WW; constexpr int NR = 8 + W_ - 1; u32x4 rw[NR]; \
                _Pragma("unroll") for (int j = 0; j < NR; ++j) { const bool ok = (unsigned)(tl0 - W_ / 2 + j) < (unsigned)Lq; rw[j] = *(const u32x4*)(bp + (ok ? (j - W_ / 2) : 0) * 1024); } \
                float sm[8] = {0.f, 0.f, 0.f, 0.f, 0.f, 0.f, 0.f, 0.f}; float cnt = 0.f; \
                _Pragma("unroll") for (int j = 0; j < W_; ++j) { float f[8]; UNP(rw[j], f); const float mk = MK(j); cnt += mk; _Pragma("unroll") for (int e = 0; e < 8; ++e) sm[e] += mk * f[e]; } \
                _Pragma("unroll") for (int i = 0; i < 8; ++i) { \
                    const float ic = 1.0f / cnt; float c[8], gg[8]; UNP(rw[i + W_ / 2], c); UNP(gt[i & 3], gg); \
                    if (i == 3) { _Pragma("unroll") for (int q = 0; q < 4; ++q) gt[q] = *(const u32x4*)(bp + (size_t)(4 + q) * 1024 + 512); } \
                    u32x4 wv; wv.x = pk2((sm[0] * ic - c[0]) * p0.x * gg[0], (sm[1] * ic - c[1]) * p0.y * gg[1]); \
                    wv.y = pk2((sm[2] * ic - c[2]) * p0.z * gg[2], (sm[3] * ic - c[3]) * p0.w * gg[3]); \
                    wv.z = pk2((sm[4] * ic - c[4]) * p1.x * gg[4], (sm[5] * ic - c[5]) * p1.y * gg[5]); \
                    wv.w = pk2((sm[6] * ic - c[6]) * p1.z * gg[6], (sm[7] * ic - c[7]) * p1.w * gg[7]); \
                    *(u32x4*)(MIX + (size_t)(tok0 + i) * 1024 + col) = wv; \
                    if (i < 7) { float fa[8], fs[8]; UNP(rw[i + W_], fa); UNP(rw[i], fs); const float ma = MK(i + W_), ms = MK(i); cnt += ma - ms; \
                        _Pragma("unroll") for (int e = 0; e < 8; ++e) sm[e] += ma * fa[e] - ms * fs[e]; } } }
            if (g == 0) POOL_RUN(2) else if (g == 1) POOL_RUN(4) else if (g == 2) POOL_RUN(8) else POOL_RUN(16)
#undef POOL_RUN
#undef MK
#undef UNP
        }
        cross_attn_phase(ZC, MKV, lds, vcu, G);
    }

    {
        for (int L = vcu; L < 2560; L += G) {
            int row0, Lq, kvh, hq, qb;
            if (L < 2048) { const int grp = L >> 6, ui = L & 63; const int seq = grp >> 1; kvh = grp & 1; hq = ui >> 4; qb = ui & 15; row0 = T_P + seq * L_S; Lq = L_S; }
            else { const int p = L - 2048, grp = p >> 7, ui = p & 127; const int seq = grp >> 1; kvh = grp & 1; hq = ui >> 5; qb = ui & 31; row0 = seq * L_P; Lq = L_P; }
            const int h = kvh * 4 + hq;
            bf16_t* Qp = ZB + (size_t)(row0 + qb * 256) * 1024 + h * 64;
            const bf16_t* Kp = ZD + (size_t)row0 * 256 + kvh * 64;
#if DUP_MASK & 2
            attn_body::attn_unit<8>((const attn_body::bf16*)Qp, (const attn_body::bf16*)Kp, (const attn_body::bf16*)(Kp + 128), Lq / 64, (const attn_body::bf16*)(Qp + 512), (attn_body::bf16*)(ws + WS_SCR + (size_t)bx * SCR_PER_BLOCK), (char*)lds_raw, q_norm, qb * 256);
#endif
            attn_body::attn_unit<8>((const attn_body::bf16*)Qp, (const attn_body::bf16*)Kp, (const attn_body::bf16*)(Kp + 128), Lq / 64, (const attn_body::bf16*)(Qp + 512), (attn_body::bf16*)Qp, (char*)lds_raw, q_norm, qb * 256);
        }
    }
    xcd_barrier(xbar);

    { SchedMerge S{P, G, bx}; EpiGate E{b_merge, (char*)ws + WS_SCR + (size_t)bx * SCR_PER_BLOCK}; pg8::gemm_phase(lds, S, E); }
#if DUP_MASK & 4
    __syncthreads();
    { SchedMerge S{P, G, bx}; EpiGate E{b_merge, (char*)ws + WS_SCR + (size_t)bx * SCR_PER_BLOCK}; pg8::gemm_phase(lds, S, E); }
#endif
    if (G == 256) {
        asm volatile("s_waitcnt vmcnt(0)" ::: "memory");
        __syncthreads();
        if (threadIdx.x == 0) {
            unsigned* w = (unsigned*)(ws + WS_CNT + 4096) + (bx & 63);
            __builtin_amdgcn_fence(__ATOMIC_RELEASE, "agent"); asm volatile("s_waitcnt vmcnt(0)" ::: "memory");
            __hip_atomic_fetch_add(w, 1u, __ATOMIC_RELAXED, __HIP_MEMORY_SCOPE_AGENT);
            unsigned sp = 0;
            while (__hip_atomic_load(w, __ATOMIC_RELAXED, __HIP_MEMORY_SCOPE_AGENT) < 4u && sp < (1u << 22)) { __builtin_amdgcn_s_sleep(2); ++sp; }
            __builtin_amdgcn_fence(__ATOMIC_ACQUIRE, "agent"); asm volatile("s_waitcnt vmcnt(0)" ::: "memory");
        }
        __syncthreads();
    } else xcd_barrier(xbar);

    { SchedOut S{P, G, bx}; EpiOut E{SS, (unsigned*)(ws + WS_CNT), x_prompt, x_sample, ln_post, args.out}; pg8::gemm_phase(lds, S, E); }
}

extern "C" void kernel_launch(void* const* d_in, const int* in_sizes, int n_in, void* d_out, int out_size, void* d_ws, size_t ws_size, hipStream_t stream) {
    static int grid_blocks = 0;
    if (grid_blocks == 0) {
        if (n_in != 16 || out_size != T * DM || ws_size < WS_END) { fprintf(stderr, "kernel_launch: unexpected shapes (n_in %d out %d ws %zu need %zu)\n", n_in, out_size, ws_size, (size_t)WS_END); grid_blocks = -1; return; }
        int dev = 0, cus = 0, per_cu = 0;
        hipGetDevice(&dev);
        hipDeviceGetAttribute(&cus, hipDeviceAttributeMultiprocessorCount, dev);
        if (hipFuncSetAttribute((const void*)fwd_megakernel, hipFuncAttributeMaxDynamicSharedMemorySize, LDS_BYTES) != hipSuccess) { fprintf(stderr, "kernel_launch: hipFuncSetAttribute failed\n"); grid_blocks = -1; return; }
        if (hipOccupancyMaxActiveBlocksPerMultiprocessor(&per_cu, (const void*)fwd_megakernel, 512, LDS_BYTES) != hipSuccess || per_cu < 1) { fprintf(stderr, "kernel_launch: occupancy query failed (%d)\n", per_cu); (void)hipGetLastError(); per_cu = 1; }
        grid_blocks = cus * 1;
        if (grid_blocks > 256) grid_blocks = 256;
    }
    if (grid_blocks < 0) return;
    if (hipMemsetAsync((char*)d_ws + WS_BAR, 0, XCD_BAR_WORDS * 4, stream) != hipSuccess) { fprintf(stderr, "kernel_launch: hipMemsetAsync failed\n"); return; }
    Args a{};
    for (int i = 0; i < 16; ++i) a.in[i] = (const float*)d_in[i];
    a.out = (float*)d_out; a.ws = (unsigned char*)d_ws;
    void* kargs[] = {&a};
    hipError_t e = hipLaunchCooperativeKernel((const void*)fwd_megakernel, dim3(grid_blocks), dim3(512), kargs, LDS_BYTES, stream);
    if (e != hipSuccess) fprintf(stderr, "cooperative launch failed: %s (grid %d)\n", hipGetErrorString(e), grid_blocks);
}
```

```cpp
#include <hip/hip_runtime.h>
#include <hip/hip_cooperative_groups.h>
#include <cstdio>
#include <cstdint>
#include <cmath>
#include <hip/hip_bf16.h>
namespace cg = cooperative_groups;
#ifndef DUP_MASK
#define DUP_MASK 0
#endif

#define LAS __attribute__((address_space(3)))
typedef unsigned short bf16_t;
typedef short bf16x8 __attribute__((ext_vector_type(8)));
typedef short s16x4 __attribute__((ext_vector_type(4)));
typedef float f32x4 __attribute__((ext_vector_type(4)));
typedef float f32x16 __attribute__((ext_vector_type(16)));
typedef unsigned u32x4 __attribute__((ext_vector_type(4)));
typedef unsigned u32x2 __attribute__((ext_vector_type(2)));
typedef float f32x2_t __attribute__((ext_vector_type(2)));
typedef __bf16 bf16x2_t __attribute__((ext_vector_type(2)));

constexpr int DM = 1024;
constexpr int T_P = 2 * 8192, T_S = 16 * 4096, T = T_P + T_S;
constexpr int L_P = 8192, L_S = 4096;
constexpr int NMEM = 256, MEMROWS = 18 * NMEM;
constexpr int IN_DIM = 6400, ZW = 3328;
constexpr float EPS = 1e-6f;
constexpr float LOG2E = 1.4426950408889634f;
constexpr float C2_SELF = 0.125f * LOG2E;
constexpr float C2_CROSS = 0.08838834764831845f * LOG2E;

constexpr size_t MiB = 1u << 20;
constexpr size_t TB = (size_t)T * 1024 * 2;
constexpr size_t WS_SS = 0;
constexpr size_t WS_CNT = 512 * 1024;
constexpr size_t WS_BAR = 768 * 1024;
constexpr size_t WS_WIN = 1 * MiB;
constexpr size_t WS_WMKV = 14 * MiB, WS_WOUT = 16 * MiB, WS_WB01 = 18 * MiB, WS_WB2P = 20 * MiB;
constexpr size_t WS_MEMN = 22 * MiB, WS_MKV = 31 * MiB;
constexpr size_t WS_XN = 40 * MiB;
constexpr size_t WS_ZA = WS_XN + TB, WS_ZB = WS_ZA + TB, WS_ZC = WS_ZB + TB;
constexpr size_t WS_ZD = WS_ZC + TB;
constexpr size_t WS_MIX = WS_ZD + (size_t)T * 256 * 2;
constexpr size_t WS_SCR = WS_MIX + TB;
constexpr size_t SCR_PER_BLOCK = 256 * 1024;
constexpr size_t WS_END = WS_SCR + 256 * SCR_PER_BLOCK;
static_assert(WS_END <= 1024 * MiB, "workspace map");

constexpr int LDS_BYTES = 139264;
constexpr int NWAVES = 8;

__device__ __forceinline__ unsigned f2bf(float f) { unsigned u = __builtin_bit_cast(unsigned, f); return (u + 0x7fffu + ((u >> 16) & 1u)) >> 16; }
__device__ __forceinline__ unsigned pk2(float lo, float hi) { f32x2_t v = {lo, hi}; bf16x2_t b = __builtin_convertvector(v, bf16x2_t); return __builtin_bit_cast(unsigned, b); }
__device__ __forceinline__ float bflo(unsigned w) { return __builtin_bit_cast(float, w << 16); }
__device__ __forceinline__ float bfhi(unsigned w) { return __builtin_bit_cast(float, w & 0xffff0000u); }
__device__ __forceinline__ float fast_rcp(float x) { return __builtin_amdgcn_rcpf(x); }
__device__ __forceinline__ float sigmoidf_(float x) { return fast_rcp(1.0f + __builtin_amdgcn_exp2f(-x * LOG2E)); }
__device__ __forceinline__ float siluf_(float x) { return x * sigmoidf_(x); }
__device__ __forceinline__ float wave_sum(float v) {
#pragma unroll
    for (int o = 1; o < 64; o <<= 1) v += __shfl_xor(v, o);
    return v;
}
__device__ __forceinline__ int crow(int r, int hi) { return (r & 3) + 8 * (r >> 2) + 4 * hi; }

namespace pg8 {
constexpr int BM = 256, BK = 64, HALF = 128, HTB = HALF * BK * 2, STAGE_BYTES = 8 * HTB, NXCD = 8, WGM = 8;
constexpr int KP = 1024;
__device__ __forceinline__ int lds_byte(int r, int c) { const int st = (r >> 4) * 2 + (c >> 5), rr = r & 15, cc = c & 31, ob = rr * 64 + cc * 2; return st * 1024 + (ob ^ (((ob >> 9) & 1) << 5)); }
__device__ __forceinline__ void stage_rc(int b, int& R, int& C) { const int st = b / 1024, sb = b % 1024, swz = sb ^ (((sb >> 9) & 1) << 5); R = (st >> 1) * 16 + swz / 64; C = (st & 1) * 32 + (swz % 64) / 2; }
__device__ __forceinline__ int perm32(int rho) { const int n = rho >> 4, i = rho & 15; return 8 * (i >> 2) + 4 * n + (i & 3); }

struct Unit { const char* A; const char* B; int nt; int kind; int r0; int c0; int aux; char* O; int ldc; float sc; };

__device__ __forceinline__ void tile_order(int L, int nM, int nN, int& pm, int& pn) {
    const int nwg = nM * nN; int wgid = L;
    { const int q = nwg / NXCD, r = nwg % NXCD, xcd = wgid % NXCD, off = wgid / NXCD; wgid = (xcd < r ? xcd * (q + 1) : r * (q + 1) + (xcd - r) * q) + off; }
    const int nig = WGM * nN, gid = wgid / nig, fm = gid * WGM, gsz = (nM - fm) < WGM ? (nM - fm) : WGM;
    pm = fm + ((wgid % nig) % gsz); pn = (wgid % nig) / gsz;
}

template <class Epi, class Sched>
__device__ __forceinline__ void gemm_phase(LAS unsigned char* lds, const Sched& S, const Epi& E) {
    constexpr bool ALIGN_EPI = true;
    int tid = threadIdx.x; asm volatile("" : "+v"(tid));
    const int wid = __builtin_amdgcn_readfirstlane(tid >> 6), lane = tid & 63, wr = wid >> 2, wc = wid & 3, fr = lane & 15, fq = lane >> 4;
    const int K = KP;
    unsigned voffA[2], voffB[2];
#pragma unroll
    for (int i = 0; i < 2; ++i) { int R, C; stage_rc(tid * 16 + i * 8192, R, C); const int Rb = (R & ~31) + perm32(R & 31);
        voffA[i] = (unsigned)(R * K + C) * 2u; voffB[i] = (unsigned)(Rb * K + C) * 2u; }
    const size_t kstep = (size_t)(BK * 2);
    const size_t hstep = (size_t)HALF * K * 2;
    const unsigned ldsw = (unsigned)wid * 1024u;
    const int aoff = lds_byte(wr * 64 + fr, fq * 8), boff = lds_byte(wc * 32 + fr, fq * 8);
#define PG8_SA(b, h) (((b) * 2 + (h)) * HTB)
#define PG8_SB(b, h) ((4 + (b) * 2 + (h)) * HTB)
#define PG8_STAGE(bufoff, gbase, voff) do { _Pragma("unroll") for (int _i = 0; _i < 2; ++_i) \
        __builtin_amdgcn_global_load_lds((const unsigned*)((const char*)(gbase) + (voff)[_i]), (LAS unsigned*)(lds + (bufoff) + ldsw + _i * 8192), 16, 0, 0); } while (0)
#define PG8_LDA(dst, b, h) do { _Pragma("unroll") for (int m = 0; m < 4; ++m) _Pragma("unroll") for (int k = 0; k < 2; ++k) dst[m][k] = *(const LAS bf16x8*)(lds + PG8_SA(b, h) + aoff + m * 2048 + k * 1024); } while (0)
#define PG8_LDB(dst, b, h) do { _Pragma("unroll") for (int n = 0; n < 2; ++n) _Pragma("unroll") for (int k = 0; k < 2; ++k) dst[n][k] = *(const LAS bf16x8*)(lds + PG8_SB(b, h) + boff + n * 2048 + k * 1024); } while (0)
#define PG8_MMA(ai, bj, At, Bt) do { __builtin_amdgcn_s_setprio(1); _Pragma("unroll") for (int m = 0; m < 4; ++m) _Pragma("unroll") for (int n = 0; n < 2; ++n) _Pragma("unroll") for (int k = 0; k < 2; ++k) \
        acc[ai][bj][m][n] = __builtin_amdgcn_mfma_f32_16x16x32_bf16(Bt[n][k], At[m][k], acc[ai][bj][m][n], 0, 0, 0); __builtin_amdgcn_s_setprio(0); } while (0)
#define PG8_WAIT_V(n) asm volatile("s_waitcnt vmcnt(" #n ")" ::: "memory")
#define PG8_WAIT_L(n) asm volatile("s_waitcnt lgkmcnt(" #n ")" ::: "memory")
#define PG8_BAR __builtin_amdgcn_s_barrier()
#define PG8_SCHED __builtin_amdgcn_sched_barrier(0)
    Unit cur, nxt; int ui = 0;
    if (!S.next(0, cur)) return;
    f32x4 acc[2][2][4][2];
#pragma unroll
    for (int a = 0; a < 2; ++a)
#pragma unroll
        for (int b = 0; b < 2; ++b)
#pragma unroll
            for (int m = 0; m < 4; ++m)
#pragma unroll
                for (int n = 0; n < 2; ++n) acc[a][b][m][n] = (f32x4){0.f, 0.f, 0.f, 0.f};
    bf16x8 At[4][2], B0[2][2], B1[2][2];
    const char* cA = cur.A; const char* cB = cur.B;
    PG8_STAGE(PG8_SB(0, 0), cB, voffB); PG8_STAGE(PG8_SB(0, 1), cB + hstep, voffB); PG8_STAGE(PG8_SA(0, 0), cA, voffA); PG8_STAGE(PG8_SA(0, 1), cA + hstep, voffA);
    if (wr == 1) PG8_BAR;
    PG8_WAIT_V(2); PG8_BAR;
    PG8_STAGE(PG8_SB(1, 0), cB + kstep, voffB); PG8_STAGE(PG8_SA(1, 0), cA + kstep, voffA); PG8_STAGE(PG8_SB(1, 1), cB + hstep + kstep, voffB);
    PG8_WAIT_V(6); PG8_BAR;
    for (;;) {
        const bool has_next = S.next(ui + 1, nxt);
        const char* nA = has_next ? nxt.A : cA; const char* nB = has_next ? nxt.B : cB;
        const int nt = cur.nt;
        for (int t = 0; t < nt; t += 2) {
            const bool last = (t == nt - 2);
            const char* a1 = cA + (size_t)(t + 1) * kstep;
            const char* a2 = last ? nA : cA + (size_t)(t + 2) * kstep; const char* b2 = last ? nB : cB + (size_t)(t + 2) * kstep;
            const char* a3 = a2 + kstep; const char* b3 = b2 + kstep;
            PG8_LDB(B0, 0, 0); PG8_LDB(B1, 0, 1); PG8_SCHED; PG8_LDA(At, 0, 0); PG8_STAGE(PG8_SA(1, 1), a1 + hstep, voffA);
            PG8_WAIT_V(8); PG8_WAIT_L(0); PG8_BAR; PG8_MMA(0, 0, At, B0); PG8_MMA(0, 1, At, B1); PG8_BAR; PG8_SCHED;
            PG8_LDA(At, 0, 1); PG8_STAGE(PG8_SB(0, 0), b2, voffB); PG8_STAGE(PG8_SB(0, 1), b2 + hstep, voffB); PG8_STAGE(PG8_SA(0, 0), a2, voffA);
            PG8_WAIT_V(8); PG8_WAIT_L(0); PG8_BAR; PG8_MMA(1, 0, At, B0); PG8_MMA(1, 1, At, B1); PG8_BAR; PG8_SCHED;
            PG8_LDB(B0, 1, 0); PG8_LDB(B1, 1, 1); PG8_SCHED; PG8_LDA(At, 1, 0); PG8_STAGE(PG8_SA(0, 1), a2 + hstep, voffA);
            PG8_WAIT_V(8); PG8_WAIT_L(0); PG8_BAR; PG8_MMA(0, 0, At, B0); PG8_MMA(0, 1, At, B1); PG8_BAR; PG8_SCHED;
            PG8_LDA(At, 1, 1); PG8_STAGE(PG8_SB(1, 0), b3, voffB); PG8_STAGE(PG8_SB(1, 1), b3 + hstep, voffB); PG8_STAGE(PG8_SA(1, 0), a3, voffA);
            PG8_WAIT_V(8); PG8_WAIT_L(0); PG8_BAR; PG8_MMA(1, 0, At, B0); PG8_MMA(1, 1, At, B1); PG8_BAR; PG8_SCHED;
        }
        if constexpr (ALIGN_EPI) { if (wr == 0) PG8_BAR; }
        E(acc, cur, wr, wc, fr, fq);
        if (!has_next) break;
#pragma unroll
        for (int a = 0; a < 2; ++a)
#pragma unroll
            for (int b = 0; b < 2; ++b)
#pragma unroll
                for (int m = 0; m < 4; ++m)
#pragma unroll
                    for (int n = 0; n < 2; ++n) acc[a][b][m][n] = (f32x4){0.f, 0.f, 0.f, 0.f};
        cur = nxt; cA = nA; cB = nB; ++ui;
        if constexpr (ALIGN_EPI) { if (wr == 1) PG8_BAR; }
    }
    PG8_WAIT_V(0);
    if constexpr (!ALIGN_EPI) { if (wr == 0) PG8_BAR; }
    PG8_BAR;
#undef PG8_SA
#undef PG8_SB
#undef PG8_STAGE
#undef PG8_LDA
#undef PG8_LDB
#undef PG8_MMA
#undef PG8_WAIT_V
#undef PG8_WAIT_L
#undef PG8_BAR
#undef PG8_SCHED
}
}

namespace attn_body {
using bf16=__hip_bfloat16;
using bf16x8=__attribute__((ext_vector_type(8)))short;
using s16x4=__attribute__((ext_vector_type(4)))short;
using f32x16=__attribute__((ext_vector_type(16)))float;
using u32x4=__attribute__((ext_vector_type(4)))unsigned;
constexpr int D=64,QP=1024,KVP=256;
constexpr int NW=8,QBLK=32,QB=QBLK*NW,KVBLK=64;
__device__ __forceinline__ int crow(int r,int hi){return (r&3)+8*(r>>2)+4*hi;}
#define SBAR() __builtin_amdgcn_sched_barrier(0)
__device__ __forceinline__ void cmask(f32x16&p0,f32x16&p1,int jb,int qrel,int hi){
  const float NEG=-INFINITY; int kb=64*jb+4*hi;
  #pragma unroll
  for(int r=0;r<16;++r){int kv=kb+(r&3)+8*(r>>2); if(kv>qrel)p0[r]=NEG; if(kv+32>qrel)p1[r]=NEG;}
}

constexpr int NSLOT=3, SLOTB=8192;
constexpr int LDS_K=0, LDS_V=NSLOT*SLOTB, LDS_WS=2*NSLOT*SLOTB, LDS_OST=LDS_WS+NW*64*4, LDS_BYTES=LDS_OST+NW*4096;
constexpr float C2=0.125f*1.4426950408889634f;
__device__ __forceinline__ void glds16(const void*gsrc,unsigned lds_dst){unsigned keep;
  asm volatile("s_mov_b32 %0, m0\n\ts_mov_b32 m0, %2\n\ts_nop 0\n\tglobal_load_lds_dwordx4 %1, off\n\ts_mov_b32 m0, %0":"=&s"(keep):"v"(gsrc),"s"(lds_dst):"memory");}
__device__ __forceinline__ float max3f(float a,float b,float c){float r;asm("v_max3_f32 %0, %1, %2, %3":"=v"(r):"v"(a),"v"(b),"v"(c));return r;}
__device__ __forceinline__ float max2f(float a,float b){float r;asm("v_max_f32_e32 %0, %1, %2":"=v"(r):"v"(a),"v"(b));return r;}
__device__ __forceinline__ float fadd_s(float a,float b){float r;asm("v_add_f32_e32 %0, %1, %2":"=v"(r):"v"(a),"v"(b));return r;}
__device__ __forceinline__ float fsub_s(float a,float b){float r;asm("v_sub_f32_e32 %0, %1, %2":"=v"(r):"v"(a),"v"(b));return r;}
typedef float f32x2_t __attribute__((ext_vector_type(2))); typedef __bf16 bf16x2_t __attribute__((ext_vector_type(2)));
__device__ __forceinline__ unsigned cvtpk_s(float lo,float hi){f32x2_t v={lo,hi};bf16x2_t b=__builtin_convertvector(v,bf16x2_t);return __builtin_bit_cast(unsigned,b);}
#define WAIT_BAR(N) asm volatile("s_waitcnt vmcnt(" #N ") lgkmcnt(0)\n\ts_barrier":::"memory")

__device__ __forceinline__ void qkt(f32x16&p0,f32x16&p1,const char*Kslot,const bf16x8*qr,const f32x16&negm,int r32,int hi){
  const char*kb=Kslot+hi*1024+r32*16;
  #pragma unroll
  for(int d0=0;d0<4;++d0){
    const bf16x8 b0=*reinterpret_cast<const bf16x8*>(kb+d0*2048);
    const bf16x8 b1=*reinterpret_cast<const bf16x8*>(kb+d0*2048+512);
    if(d0==0){p0=__builtin_amdgcn_mfma_f32_32x32x16_bf16(b0,qr[0],negm,0,0,0);p1=__builtin_amdgcn_mfma_f32_32x32x16_bf16(b1,qr[0],negm,0,0,0);}
    else{p0=__builtin_amdgcn_mfma_f32_32x32x16_bf16(b0,qr[d0],p0,0,0,0);p1=__builtin_amdgcn_mfma_f32_32x32x16_bf16(b1,qr[d0],p1,0,0,0);}}
}
typedef __attribute__((address_space(3))) const char* lds_cptr;
typedef short v4i16_t __attribute__((ext_vector_type(4)));
__device__ __forceinline__ void kload8(bf16x8*kf,lds_cptr kp){
  kf[0]=*(const __attribute__((address_space(3))) bf16x8*)(kp);      kf[1]=*(const __attribute__((address_space(3))) bf16x8*)(kp+512);
  kf[2]=*(const __attribute__((address_space(3))) bf16x8*)(kp+2048); kf[3]=*(const __attribute__((address_space(3))) bf16x8*)(kp+2560);
  kf[4]=*(const __attribute__((address_space(3))) bf16x8*)(kp+4096); kf[5]=*(const __attribute__((address_space(3))) bf16x8*)(kp+4608);
  kf[6]=*(const __attribute__((address_space(3))) bf16x8*)(kp+6144); kf[7]=*(const __attribute__((address_space(3))) bf16x8*)(kp+6656);
}
__device__ __forceinline__ void kload2(bf16x8*kf,lds_cptr kp,int j){ kf[2*j]=*(const __attribute__((address_space(3))) bf16x8*)(kp+j*2048); kf[2*j+1]=*(const __attribute__((address_space(3))) bf16x8*)(kp+j*2048+512); }
__device__ __forceinline__ s16x4 vtr(lds_cptr p){ return __builtin_bit_cast(s16x4,__builtin_amdgcn_ds_read_tr16_b64_v4i16((__attribute__((address_space(3))) v4i16_t*)p)); }
__device__ __forceinline__ float rowmax(const f32x16&p0,const f32x16&p1){
  float a=max3f(p0[0],p0[1],p1[0]),b=max3f(p0[2],p0[3],p1[1]);a=max3f(a,p1[2],p1[3]);
  #pragma unroll
  for(int r=4;r<16;r+=4){a=max3f(a,p0[r],p0[r+1]);b=max3f(b,p0[r+2],p0[r+3]);a=max3f(a,p1[r],p1[r+1]);b=max3f(b,p1[r+2],p1[r+3]);}
  const float m=max2f(a,b);
  auto rr=__builtin_amdgcn_permlane32_swap(__float_as_uint(m),__float_as_uint(m),false,false);
  return max2f(__uint_as_float(rr[0]),__uint_as_float(rr[1]));
}
__device__ __forceinline__ void pv(f32x16*o,int vb,bf16x8 pa0,bf16x8 pa1,bf16x8 pa2,bf16x8 pa3){
  #pragma unroll
  for(int d0=0;d0<2;++d0){s16x4 lo[4],hi[4];
    #pragma unroll
    for(int ks=0;ks<4;++ks){
      asm volatile("ds_read_b64_tr_b16 %0,%1 offset:%c2":"=&v"(lo[ks]):"v"(vb),"i"(d0*4096+ks*1024):"memory");
      asm volatile("ds_read_b64_tr_b16 %0,%1 offset:%c2":"=&v"(hi[ks]):"v"(vb),"i"(d0*4096+ks*1024+512):"memory");}
    asm volatile("s_waitcnt lgkmcnt(0)":::"memory");SBAR();
    #define PK(k) (bf16x8){lo[k][0],lo[k][1],lo[k][2],lo[k][3],hi[k][0],hi[k][1],hi[k][2],hi[k][3]}
    o[d0]=__builtin_amdgcn_mfma_f32_32x32x16_bf16(pa0,PK(0),o[d0],0,0,0);
    o[d0]=__builtin_amdgcn_mfma_f32_32x32x16_bf16(pa1,PK(1),o[d0],0,0,0);
    o[d0]=__builtin_amdgcn_mfma_f32_32x32x16_bf16(pa2,PK(2),o[d0],0,0,0);
    o[d0]=__builtin_amdgcn_mfma_f32_32x32x16_bf16(pa3,PK(3),o[d0],0,0,0);
    #undef PK
  }
}

#ifndef ATTN_STORE16
#define ATTN_STORE16(p,v) (*(u32x4*)(p)=(v))
#endif
template<int THRL> __device__ __forceinline__ void attn_unit(const bf16*Qb,const bf16*__restrict__ Kh,const bf16*__restrict__ Vh,const int NT,const bf16*Gb,bf16*Ob,char*shm,const float*qn,const int tl0){
  const int tid=threadIdx.x,lane=tid&63,r32=lane&31,hi=lane>>5; const int wid=__builtin_amdgcn_readfirstlane(tid>>6);
  const bf16*Qw=Qb+(long)(wid*QBLK)*QP;
  const unsigned lds0=(unsigned)(uintptr_t)shm;
  float*wsf=(float*)(shm+LDS_WS)+wid*64;
  const bf16*ksrc=Kh+(long)lane*KVP+wid*8;
  const bf16*vsrc=Vh+(long)(16*(wid&3)+(lane>>2))*KVP+(wid>>2)*32+(lane&3)*8;
  const unsigned kdst=lds0+LDS_K+wid*1024, vdst=lds0+LDS_V+wid*1024;
  #define DMA_K(t,slot) glds16(ksrc+(long)(t)*KVBLK*KVP,(unsigned)__builtin_amdgcn_readfirstlane(kdst+(slot)))
  #define DMA_V(t,slot) glds16(vsrc+(long)(t)*KVBLK*KVP,(unsigned)__builtin_amdgcn_readfirstlane(vdst+(slot)))
  const int vb0=(int)(lds0+LDS_V)+((lane>>4)&1)*32+(lane&3)*8+(4*hi+((lane&15)>>2))*64;
  const char*Kbase=shm+LDS_K; bf16x8 kf[8];
  const lds_cptr shm3=(lds_cptr)shm; const lds_cptr kp0=shm3+LDS_K+hi*1024+r32*16; const lds_cptr vp0=shm3+LDS_V+((lane>>4)&1)*32+(lane&3)*8+(4*hi+((lane&15)>>2))*64;
  DMA_K(0,0);DMA_V(0,0);DMA_K(1,SLOTB);
  bf16x8 qr[4];
  #pragma unroll
  for(int d0=0;d0<4;++d0)qr[d0]=*reinterpret_cast<const bf16x8*>(&Qw[(long)r32*QP+d0*16+hi*8]);
  { float qv[4][8]; float ssq=0.f;
    #pragma unroll
    for(int d0=0;d0<4;++d0){
      #pragma unroll
      for(int j=0;j<8;++j){qv[d0][j]=__uint_as_float(((unsigned)(unsigned short)qr[d0][j])<<16);ssq+=qv[d0][j]*qv[d0][j];}}
    {auto rr=__builtin_amdgcn_permlane32_swap(__float_as_uint(ssq),__float_as_uint(ssq),false,false);ssq=__uint_as_float(rr[0])+__uint_as_float(rr[1]);}
    const float rinv=1.0f/sqrtf(ssq*(1.f/64.f)+1e-6f);
    const int tl=tl0+wid*QBLK+r32;
    #pragma unroll
    for(int d0=0;d0<4;++d0){
      const float pos=(d0<2)?(float)(tl>>6):(float)(tl&63);
      const float*gp=qn+d0*16+hi*8;
      const float gq[8]={gp[0],gp[1],gp[2],gp[3],gp[4],gp[5],gp[6],gp[7]};
      u32x4 pk;
      #pragma unroll
      for(int jj=0;jj<4;++jj){
        const float inv=__builtin_amdgcn_exp2f(-(float)(2*(8*(d0&1)+4*hi+jj))*(13.287712379549449f/32.0f));
        const float rev=pos*inv*0.15915494309189535f;
        const float cs=__builtin_amdgcn_cosf(rev),sn=__builtin_amdgcn_sinf(rev);
        const float y0=qv[d0][2*jj]*rinv*gq[2*jj],y1=qv[d0][2*jj+1]*rinv*gq[2*jj+1];
        pk[jj]=cvtpk_s((y0*cs-y1*sn)*C2,(y0*sn+y1*cs)*C2);}
      qr[d0]=__builtin_bit_cast(bf16x8,pk);}
  }
  float mhat=0.f,l_reg=0.f;f32x16 o[2];o[0]=f32x16{};o[1]=f32x16{};f32x16 negm=f32x16{};asm volatile("":"+v"(negm));
  #define CMASK(P0,P1,t) do{}while(0)
  bool resc=false;
  #define START(P0,P1) do{ const float rm=rowmax(P0,P1); resc=false; \
    { const float dl=rm; mhat=fadd_s(mhat,dl); \
      _Pragma("unroll") for(int r=0;r<16;++r){P0[r]=fsub_s(P0[r],dl);P1[r]=fsub_s(P1[r],dl);} \
      _Pragma("unroll") for(int r=0;r<16;++r)negm[r]=-mhat; asm volatile("":"+v"(negm)); } \
    _Pragma("unroll") for(int r=0;r<16;++r)P0[r]=__builtin_amdgcn_exp2f(P0[r]); }while(0)
  #define RESC() do{ if(resc){ asm volatile("s_waitcnt lgkmcnt(0)":::"memory"); \
      _Pragma("unroll") for(int d_=0;d_<2;++d_) _Pragma("unroll") for(int r=0;r<16;++r)o[d_][r]*=wsf[crow(r,hi)]; } }while(0)
  f32x16 pA0,pA1,pB0,pB1;
  int sl_prev=0,sl_cur=0,sl_next=SLOTB;
  #define ROT() do{sl_prev=sl_cur;sl_cur=sl_next;sl_next=(sl_next==(NSLOT-1)*SLOTB)?0:sl_next+SLOTB;}while(0)
  DMA_K(2,2*SLOTB);
  WAIT_BAR(3);
  qkt(pA0,pA1,Kbase,qr,negm,r32,hi);asm volatile("s_nop 15\n\ts_nop 7":"+v"(pA0),"+v"(pA1));CMASK(pA0,pA1,0);
  START(pA0,pA1);
  _Pragma("unroll") for(int r=0;r<16;++r)pA1[r]=__builtin_amdgcn_exp2f(pA1[r]);
  WAIT_BAR(0);
  DMA_K(3,0);DMA_V(1,SLOTB);
  ROT();
  kload8(kf,kp0+sl_cur);
  WAIT_BAR(2);
  s16x4 vlo[8],vhi[8]; u32x4 pw0,pw1,pw2,pw3;
  #define PKW(P,B) cvtpk_s(P[B],P[B+1])
  #define PAF(k) __builtin_bit_cast(bf16x8,pw##k)
  #define VFR(i) (bf16x8){vlo[i][0],vlo[i][1],vlo[i][2],vlo[i][3],vhi[i][0],vhi[i][1],vhi[i][2],vhi[i][3]}
  #define PIN(x) asm volatile("":"+v"(x))
  #define MX3(a,b,c) __builtin_fmaxf(__builtin_fmaxf((a),(b)),(c))
  #define GAPA(MF,A0,A1,A2,A3,W0,W1,PW) do{ MF; sacc+=A0; sacc+=A1; sacc+=A2; sacc+=A3; PIN(sacc); W0; W1; PIN(PW); SBAR(); }while(0)
  #define EX(v) __builtin_amdgcn_exp2f(v)
  #define GAPB(MF,X,B) do{ MF; X[B]=EX(X[B]); X[B+1]=EX(X[B+1]); X[B+2]=EX(X[B+2]); X[B+3]=EX(X[B+3]); PIN(X); SBAR(); }while(0)
  #define VRD(i) do{ vlo[i]=vtr(vp_+(((i)>>2)*4096+((i)&3)*1024)); vhi[i]=vtr(vp_+(((i)>>2)*4096+((i)&3)*1024+512)); }while(0)
  #define KRD(G,j) do{ if(G){ kload2(kf,kp0+sl_next,j); SBAR(); } }while(0)
  #define STEP(C0,C1,P0,P1,t,GK,GV,GL) do{ SBAR(); \
    const lds_cptr vp_=vp0+sl_prev; \
    VRD(0); SBAR(); float sacc=(P0[0]+P0[1]); \
    GAPA(C0=__builtin_amdgcn_mfma_f32_32x32x16_bf16(kf[0],qr[0],negm,0,0,0), P0[2],P0[3],P0[4],P0[5],     pw0[0]=PKW(P0,0), pw0[1]=PKW(P0,2), pw0); \
    VRD(4); SBAR(); GAPA(C1=__builtin_amdgcn_mfma_f32_32x32x16_bf16(kf[1],qr[0],negm,0,0,0), P0[6],P0[7],P0[8],P0[9],     pw0[2]=PKW(P0,4), pw0[3]=PKW(P0,6), pw0); \
    VRD(1); SBAR(); GAPA(C0=__builtin_amdgcn_mfma_f32_32x32x16_bf16(kf[2],qr[1],C0,0,0,0),   P0[10],P0[11],P0[12],P0[13], pw1[0]=PKW(P0,8), pw1[1]=PKW(P0,10), pw1); \
    VRD(5); SBAR(); GAPA(C1=__builtin_amdgcn_mfma_f32_32x32x16_bf16(kf[3],qr[1],C1,0,0,0),   P0[14],P0[15],P1[0],P1[1],   pw1[2]=PKW(P0,12),pw1[3]=PKW(P0,14), pw1); \
    VRD(2); SBAR(); GAPA(C0=__builtin_amdgcn_mfma_f32_32x32x16_bf16(kf[4],qr[2],C0,0,0,0),   P1[2],P1[3],P1[4],P1[5],     pw2[0]=PKW(P1,0), pw2[1]=PKW(P1,2), pw2); \
    VRD(6); SBAR(); GAPA(C1=__builtin_amdgcn_mfma_f32_32x32x16_bf16(kf[5],qr[2],C1,0,0,0),   P1[6],P1[7],P1[8],P1[9],     pw2[2]=PKW(P1,4), pw2[3]=PKW(P1,6), pw2); \
    VRD(3); SBAR(); GAPA(C0=__builtin_amdgcn_mfma_f32_32x32x16_bf16(kf[6],qr[3],C0,0,0,0),   P1[10],P1[11],P1[12],P1[13], pw3[0]=PKW(P1,8), pw3[1]=PKW(P1,10), pw3); \
    VRD(7); SBAR(); GAPA(C1=__builtin_amdgcn_mfma_f32_32x32x16_bf16(kf[7],qr[3],C1,0,0,0),   P1[14],P1[15],0.f,0.f,       pw3[2]=PKW(P1,12),pw3[3]=PKW(P1,14), pw3); \
    l_reg+=sacc; \
    if(GK){DMA_K((t)+3,sl_cur);} if(GV){DMA_V((t)+1,sl_next);} \
    CMASK(C0,C1,t); \
    { float a=MX3(C0[0],C0[1],C1[0]),b=MX3(C0[2],C0[3],C1[1]); a=MX3(a,C1[2],C1[3]); \
      _Pragma("unroll") for(int r=4;r<16;r+=4){a=MX3(a,C0[r],C0[r+1]);b=MX3(b,C0[r+2],C0[r+3]);a=MX3(a,C1[r],C1[r+1]);b=MX3(b,C1[r+2],C1[r+3]);} \
      float rm=__builtin_fmaxf(a,b); { auto rr=__builtin_amdgcn_permlane32_swap(__float_as_uint(rm),__float_as_uint(rm),false,false); rm=__builtin_fmaxf(__uint_as_float(rr[0]),__uint_as_float(rr[1])); } \
      resc=false; \
      if(__builtin_expect(__any(rm>(float)THRL),0)){ const float dl=__builtin_fmaxf(rm,0.f); mhat+=dl; \
        _Pragma("unroll") for(int r=0;r<16;++r){C0[r]-=dl;C1[r]-=dl;} \
        _Pragma("unroll") for(int r=0;r<16;++r)negm[r]=-mhat; asm volatile("":"+v"(negm)); \
        const float f=__builtin_amdgcn_exp2f(-dl); l_reg*=f; if(hi==0)wsf[r32]=f; resc=true; } } \
    SBAR(); \
    GAPB(o[0]=__builtin_amdgcn_mfma_f32_32x32x16_bf16(PAF(0),VFR(0),o[0],0,0,0), C0,0); \
    GAPB(o[1]=__builtin_amdgcn_mfma_f32_32x32x16_bf16(PAF(0),VFR(4),o[1],0,0,0), C0,4); \
    KRD(GL,0); GAPB(o[0]=__builtin_amdgcn_mfma_f32_32x32x16_bf16(PAF(1),VFR(1),o[0],0,0,0), C0,8); \
    KRD(GL,1); GAPB(o[1]=__builtin_amdgcn_mfma_f32_32x32x16_bf16(PAF(1),VFR(5),o[1],0,0,0), C0,12); \
    KRD(GL,2); GAPB(o[0]=__builtin_amdgcn_mfma_f32_32x32x16_bf16(PAF(2),VFR(2),o[0],0,0,0), C1,0); \
    KRD(GL,3); GAPB(o[1]=__builtin_amdgcn_mfma_f32_32x32x16_bf16(PAF(2),VFR(6),o[1],0,0,0), C1,4); \
    GAPB(o[0]=__builtin_amdgcn_mfma_f32_32x32x16_bf16(PAF(3),VFR(3),o[0],0,0,0), C1,8); \
    GAPB(o[1]=__builtin_amdgcn_mfma_f32_32x32x16_bf16(PAF(3),VFR(7),o[1],0,0,0), C1,12); \
    }while(0)
  int t=1;
  #undef CMASK
  #define CMASK(P0,P1,t) do{}while(0)
  for(;t+5<NT;t+=2){
    STEP(pB0,pB1,pA0,pA1,t,true,true,true);     WAIT_BAR(2); RESC(); ROT();
    STEP(pA0,pA1,pB0,pB1,t+1,true,true,true);   WAIT_BAR(2); RESC(); ROT();
  }
  #undef CMASK
  #define CMASK(P0,P1,t) do{}while(0)
  #define ENDW(tt) do{ if((tt)+3<NT){WAIT_BAR(2);} else if((tt)+2<NT){WAIT_BAR(1);} else {WAIT_BAR(0);} }while(0)
  for(;t+1<NT;t+=2){
    STEP(pB0,pB1,pA0,pA1,t,(t+3<NT),(t+1<NT),(t+1<NT));       ENDW(t);   RESC(); ROT();
    STEP(pA0,pA1,pB0,pB1,t+1,(t+4<NT),(t+2<NT),(t+2<NT));     ENDW(t+1); RESC(); ROT();
  }
  STEP(pB0,pB1,pA0,pA1,NT-1,false,false,false); RESC();
  { float sacc=pB0[0]+pB0[1]; _Pragma("unroll") for(int r=2;r<16;++r)sacc+=pB0[r]; _Pragma("unroll") for(int r=0;r<16;++r)sacc+=pB1[r]; l_reg+=sacc;
    pw0=(u32x4){PKW(pB0,0),PKW(pB0,2),PKW(pB0,4),PKW(pB0,6)};pw1=(u32x4){PKW(pB0,8),PKW(pB0,10),PKW(pB0,12),PKW(pB0,14)};pw2=(u32x4){PKW(pB1,0),PKW(pB1,2),PKW(pB1,4),PKW(pB1,6)};pw3=(u32x4){PKW(pB1,8),PKW(pB1,10),PKW(pB1,12),PKW(pB1,14)};
    SBAR(); pv(o,vb0+sl_cur,PAF(0),PAF(1),PAF(2),PAF(3)); }
  #undef PKW
  #undef PAF
  #undef VFR
  #undef PIN
  #undef MX3
  #undef GAPA
  #undef GAPB
  #undef EX
  #undef VRD
  #undef KRD
  #undef STEP
  #undef ENDW
  u32x4 gpre[4];
  { const bf16*Gw0=Gb+(long)(wid*QBLK)*QP;
    #pragma unroll
    for(int i=0;i<4;++i)gpre[i]=*(const u32x4*)(Gw0+(long)(i*8+(lane>>3))*QP+(lane&7)*8); }
  {auto rr=__builtin_amdgcn_permlane32_swap(__float_as_uint(l_reg),__float_as_uint(l_reg),false,false);l_reg=__uint_as_float(rr[0])+__uint_as_float(rr[1]);}
  if(hi==0)wsf[32+r32]=l_reg;asm volatile("s_waitcnt lgkmcnt(0)":::"memory");
  float rli[16];
  #pragma unroll
  for(int r=0;r<16;++r)rli[r]=__builtin_amdgcn_rcpf(wsf[32+crow(r,hi)]);
  bf16*Ow=Ob+(long)(wid*QBLK)*QP; const bf16*Gw=Gb+(long)(wid*QBLK)*QP;
  { bf16*stg=(bf16*)(shm+LDS_OST)+wid*2048;
    #pragma unroll
    for(int r=0;r<16;++r){const int orow=crow(r,hi);
      #pragma unroll
      for(int d0=0;d0<2;++d0)stg[orow*64+d0*32+r32]=__float2bfloat16(o[d0][r]*rli[r]);}
    asm volatile("s_waitcnt lgkmcnt(0)":::"memory");
    #pragma unroll
    for(int i=0;i<4;++i){const int row=i*8+(lane>>3),ch=lane&7; const u32x4 v=*(const u32x4*)(stg+row*64+ch*8); const u32x4 g=gpre[i]; u32x4 w;
      #define GM(a,b) cvtpk_s(__uint_as_float((a)<<16)*__uint_as_float((b)<<16),__uint_as_float((a)&0xffff0000u)*__uint_as_float((b)&0xffff0000u))
      w.x=GM(v.x,g.x);w.y=GM(v.y,g.y);w.z=GM(v.z,g.z);w.w=GM(v.w,g.w);
      #undef GM
      ATTN_STORE16(Ow+(long)row*QP+ch*8,w);} }
  asm volatile("s_waitcnt lgkmcnt(0)\n\ts_barrier":::"memory");
  #undef DMA_K
  #undef DMA_V
  #undef CMASK
  #undef START
  #undef RESC
  #undef ROT
}
constexpr int ATTN_LDS_BYTES=LDS_BYTES;
#undef SBAR
#undef WAIT_BAR
}

__device__ __forceinline__ unsigned xb_ld(unsigned* p)              { return __hip_atomic_load(p, __ATOMIC_RELAXED, __HIP_MEMORY_SCOPE_AGENT); }
__device__ __forceinline__ unsigned xb_add(unsigned* p, unsigned v) { return __hip_atomic_fetch_add(p, v, __ATOMIC_RELAXED, __HIP_MEMORY_SCOPE_AGENT); }
#define XB_TMO      128
#define XB_XCNT(j)  (256  + 64 * (j))
#define XB_XSUB(j)  (1280 + 64 * (j))
#define XB_XGEN(j)  (2304 + 64 * (j))
#define XB_TOP      3328
#define XB_TOPGEN   3392
#define XCD_BAR_WORDS 3456
#define XB_SPIN_CAP (1u << 18)

__device__ __forceinline__ unsigned xb_xcc_id() { return (unsigned)__builtin_amdgcn_s_getreg((3 << 11) | 20) & 0xFu; }
#define XB_SPIN(cond, bar) do { unsigned _sp = 0; while (cond) { __builtin_amdgcn_s_sleep(1); \
    if ((++_sp & 255u) == 0u) { if (xb_ld(&(bar)[XB_TMO])) break; if (_sp > XB_SPIN_CAP) { atomicAdd(&(bar)[XB_TMO], 1u); break; } } } } while (0)

struct XcdBarrier {
    unsigned* bar; unsigned x;
    volatile LAS unsigned* st;
};

__device__ __forceinline__ XcdBarrier xcd_barrier_post(unsigned* bar, volatile LAS unsigned* st) {
    XcdBarrier b; b.bar = bar; b.x = xb_xcc_id(); b.st = st;
    if (threadIdx.x == 0) (void)xb_add(&bar[XB_XCNT(b.x)], 1u);
    return b;
}
__device__ __forceinline__ void xcd_barrier_complete(unsigned* bar, unsigned x, unsigned& nloc, unsigned& nx) {
    const unsigned G = gridDim.x * gridDim.y * gridDim.z;
    unsigned sum, cnt, mine, sp = 0u;
    for (;;) {
        sum = 0u; cnt = 0u; mine = 0u;
#pragma unroll
        for (unsigned j = 0; j < 16; ++j) { const unsigned c = xb_ld(&bar[XB_XCNT(j)]); sum += c; cnt += (c > 0u) ? 1u : 0u; mine = (j == x) ? c : mine; }
        if (sum == G) break;
        __builtin_amdgcn_s_sleep(1);
        if ((++sp & 255u) == 0u) { if (xb_ld(&bar[XB_TMO])) break; if (sp > XB_SPIN_CAP) { atomicAdd(&bar[XB_TMO], 1u); break; } }
    }
    nloc = mine > 0u ? mine : 1u; nx = cnt > 0u ? cnt : 1u;
}

__device__ __forceinline__ void xcd_barrier(const XcdBarrier& b) {
    asm volatile("s_waitcnt vmcnt(0)" ::: "memory");
    __syncthreads();
    if (threadIdx.x == 0) {
        unsigned* bar = b.bar;
        __builtin_amdgcn_s_waitcnt(0);
        unsigned nloc = b.st[0], nx = b.st[1];
        if (nloc == 0u) { xcd_barrier_complete(bar, b.x, nloc, nx); b.st[0] = nloc; b.st[1] = nx; }
        const unsigned old = xb_add(&bar[XB_XSUB(b.x)], 1u);
        const unsigned gen = old / nloc;
        if (old + 1u == (gen + 1u) * nloc) {
            __builtin_amdgcn_fence(__ATOMIC_RELEASE, "agent");
            asm volatile("s_waitcnt vmcnt(0)" ::: "memory");
            const unsigned og = xb_add(&bar[XB_TOP], 1u);
            const unsigned tg = og / nx;
            if (og + 1u == (tg + 1u) * nx) xb_add(&bar[XB_TOPGEN], 1u);
            else XB_SPIN(xb_ld(&bar[XB_TOPGEN]) == tg, bar);
            __builtin_amdgcn_fence(__ATOMIC_ACQUIRE, "agent");
            xb_add(&bar[XB_XGEN(b.x)], 1u);
            asm volatile("s_waitcnt vmcnt(0)" ::: "memory");
        } else {
            XB_SPIN(xb_ld(&bar[XB_XGEN(b.x)]) == gen, bar);
            __builtin_amdgcn_fence(__ATOMIC_ACQUIRE, "agent");
            asm volatile("s_waitcnt vmcnt(0)" ::: "memory");
        }
    }
    __syncthreads();
}

using pg8::Unit;
typedef f32x4 AccT[2][2][4][2];

struct EpiStore {
    const float* pscale; const float* kn; LAS float* xl;
    __device__ __forceinline__ void operator()(const AccT& acc, const Unit& u, int wr, int wc, int fr, int fq) const {
        asm volatile("" : "+v"(fr), "+v"(fq));
        bf16_t* base = (bf16_t*)u.O; const int ldc = u.ldc, kind = u.kind; const float sc = u.sc;
        if (kind == 5) {
            const int wid = wr * 4 + wc;
#pragma unroll
            for (int ai = 0; ai < 2; ++ai)
#pragma unroll
                for (int m = 0; m < 4; ++m) {
                    const f32x4 v0 = acc[ai][0][m][0], v1 = acc[ai][0][m][1];
                    float sq = (v0[0] * v0[0] + v0[1] * v0[1]) + (v0[2] * v0[2] + v0[3] * v0[3]) + (v1[0] * v1[0] + v1[1] * v1[1]) + (v1[2] * v1[2] + v1[3] * v1[3]);
                    sq += __shfl_xor(sq, 16); sq += __shfl_xor(sq, 32);
                    if (fq == 0) xl[((wid * 2 + ai) * 4 + m) * 16 + fr] = sq;
                }
            asm volatile("s_waitcnt lgkmcnt(0)" ::: "memory"); __builtin_amdgcn_s_barrier(); asm volatile("" ::: "memory");
            const float* gp = kn + 32 * (wc & 1) + 8 * fq;
            const f32x4 g0 = *(const f32x4*)gp, g1 = *(const f32x4*)(gp + 4);
            float inv[4];
#pragma unroll
            for (int jj = 0; jj < 4; ++jj) inv[jj] = __builtin_amdgcn_exp2f(-(float)(2 * (4 * fq + jj)) * (13.287712379549449f / 32.0f)) * 0.15915494309189535f;
#pragma unroll
            for (int ai = 0; ai < 2; ++ai)
#pragma unroll
                for (int m = 0; m < 4; ++m) {
                    const int row = ai * 128 + wr * 64 + m * 16 + fr, tok = u.r0 + row;
                    const int tl = (tok < T_P) ? (tok & (L_P - 1)) : ((tok - T_P) & (L_S - 1));
                    const float pos = (wc & 1) ? (float)(tl & 63) : (float)(tl >> 6);
                    const int xi = ((wid * 2 + ai) * 4 + m) * 16 + fr;
                    const float rinv = 1.0f / sqrtf((xl[xi] + xl[xi ^ 128]) * (1.f / 64.f) + EPS);
                    f32x4 v0 = acc[ai][0][m][0] * rinv * g0, v1 = acc[ai][0][m][1] * rinv * g1;
                    float c4[4], s4[4];
#pragma unroll
                    for (int jj = 0; jj < 4; ++jj) { const float rev = pos * inv[jj]; c4[jj] = __builtin_amdgcn_cosf(rev); s4[jj] = __builtin_amdgcn_sinf(rev); }
                    bf16_t* rowp = base + (size_t)row * 256 + wc * 32 + 8 * fq;
                    u32x4 w;
                    w.x = pk2(v0[0] * c4[0] - v0[1] * s4[0], v0[0] * s4[0] + v0[1] * c4[0]); w.y = pk2(v0[2] * c4[1] - v0[3] * s4[1], v0[2] * s4[1] + v0[3] * c4[1]);
                    w.z = pk2(v1[0] * c4[2] - v1[1] * s4[2], v1[0] * s4[2] + v1[1] * c4[2]); w.w = pk2(v1[2] * c4[3] - v1[3] * s4[3], v1[2] * s4[3] + v1[3] * c4[3]);
                    *(u32x4*)rowp = w;
                    const f32x4 a0 = acc[ai][1][m][0], a1 = acc[ai][1][m][1];
                    w.x = pk2(a0[0], a0[1]); w.y = pk2(a0[2], a0[3]); w.z = pk2(a1[0], a1[1]); w.w = pk2(a1[2], a1[3]);
                    *(u32x4*)(rowp + 128) = w;
                }
            return;
        }
#pragma unroll
        for (int ai = 0; ai < 2; ++ai)
#pragma unroll
            for (int m = 0; m < 4; ++m) {
                bf16_t* rowp = base + (size_t)(ai * 128 + wr * 64 + m * 16 + fr) * ldc + wc * 32 + 8 * fq;
#pragma unroll
                for (int bj = 0; bj < 2; ++bj) {
                    f32x4 v0 = acc[ai][bj][m][0], v1 = acc[ai][bj][m][1];
                    if (kind == 1) {
#pragma unroll
                        for (int e = 0; e < 4; ++e) { v0[e] = siluf_(v0[e]); v1[e] = siluf_(v1[e]); }
                    } else if (kind == 2) { v0 = v0 * sc; v1 = v1 * sc; }
                    u32x4 w; w.x = pk2(v0[0], v0[1]); w.y = pk2(v0[2], v0[3]); w.z = pk2(v1[0], v1[1]); w.w = pk2(v1[2], v1[3]);
                    *(u32x4*)(rowp + bj * 128) = w;
                }
            }
    }
};
struct EpiGate {
    const float* bmerge; char* scr;
    __device__ __forceinline__ void operator()(const AccT& acc, const Unit& u, int wr, int wc, int fr, int fq) const {
        asm volatile("" : "+v"(fr), "+v"(fq));
        int tid = threadIdx.x; const int n = u.aux; asm volatile("" : "+v"(tid));
        u32x4* gst = (u32x4*)scr;
        if (u.kind == 0) {
            const float* bp = bmerge + n * 1024 + u.c0 + wc * 32 + 8 * fq;
            f32x4 bb[2][2];
#pragma unroll
            for (int bj = 0; bj < 2; ++bj) { bb[bj][0] = *(const f32x4*)(bp + bj * 128); bb[bj][1] = *(const f32x4*)(bp + bj * 128 + 4); }
#pragma unroll
            for (int bj = 0; bj < 2; ++bj) {
#pragma unroll
                for (int ai = 0; ai < 2; ++ai)
#pragma unroll
                    for (int m = 0; m < 4; ++m) {
                        const f32x4 v0 = (acc[ai][bj][m][0] + bb[bj][0]) * (-LOG2E), v1 = (acc[ai][bj][m][1] + bb[bj][1]) * (-LOG2E);
                        u32x4 w; w.x = pk2(__builtin_amdgcn_exp2f(v0[0]), __builtin_amdgcn_exp2f(v0[1])); w.y = pk2(__builtin_amdgcn_exp2f(v0[2]), __builtin_amdgcn_exp2f(v0[3]));
                        w.z = pk2(__builtin_amdgcn_exp2f(v1[0]), __builtin_amdgcn_exp2f(v1[1])); w.w = pk2(__builtin_amdgcn_exp2f(v1[2]), __builtin_amdgcn_exp2f(v1[3]));
                        gst[((ai * 2 + bj) * 4 + m) * 512 + tid] = w;
                    }
                asm volatile("" ::: "memory");
            }
        } else {
            bf16_t* base = (bf16_t*)u.O;
            u32x4* mst = (u32x4*)(scr + 131072);
#pragma unroll
            for (int ai = 0; ai < 2; ++ai) {
                u32x4 g[8], pm[8];
#pragma unroll
                for (int e = 0; e < 8; ++e) { const int si = (ai * 2 + (e & 1)) * 4 + (e >> 1); g[e] = gst[si * 512 + tid]; if (n > 0) pm[e] = mst[si * 512 + tid]; }
#pragma unroll
                for (int e = 0; e < 8; ++e) {
                    const int bj = e & 1, m = e >> 1, si = (ai * 2 + bj) * 4 + m;
                    f32x4 v0 = acc[ai][bj][m][0], v1 = acc[ai][bj][m][1];
#define GSIG(x_) fast_rcp(1.0f + (x_))
                    v0[0] *= GSIG(bflo(g[e].x)); v0[1] *= GSIG(bfhi(g[e].x)); v0[2] *= GSIG(bflo(g[e].y)); v0[3] *= GSIG(bfhi(g[e].y));
                    v1[0] *= GSIG(bflo(g[e].z)); v1[1] *= GSIG(bfhi(g[e].z)); v1[2] *= GSIG(bflo(g[e].w)); v1[3] *= GSIG(bfhi(g[e].w));
#undef GSIG
                    if (n > 0) { v0[0] += bflo(pm[e].x); v0[1] += bfhi(pm[e].x); v0[2] += bflo(pm[e].y); v0[3] += bfhi(pm[e].y);
                                 v1[0] += bflo(pm[e].z); v1[1] += bfhi(pm[e].z); v1[2] += bflo(pm[e].w); v1[3] += bfhi(pm[e].w); }
                    u32x4 w; w.x = pk2(v0[0], v0[1]); w.y = pk2(v0[2], v0[3]); w.z = pk2(v1[0], v1[1]); w.w = pk2(v1[2], v1[3]);
                    if (n < 2) mst[si * 512 + tid] = w;
                    else *(u32x4*)(base + (size_t)(ai * 128 + wr * 64 + m * 16 + fr) * 1024 + wc * 32 + 8 * fq + bj * 128) = w;
                }
                asm volatile("" ::: "memory");
            }
        }
    }
};
struct EpiOut {
    float* ss; unsigned* cnt; const float* xp; const float* xs; const float* gpost; float* out;
    __device__ __forceinline__ void operator()(const AccT& acc, const Unit& u, int wr, int wc, int fr, int fq) const {
        asm volatile("" : "+v"(fr), "+v"(fq));
        const int pm = u.r0 >> 8;
        const float* xb = (u.r0 < T_P) ? xp + (size_t)u.r0 * DM : xs + (size_t)(u.r0 - T_P) * DM;
        float* ob = out + (size_t)u.r0 * DM;
        const int colb = u.c0 + wc * 32 + 8 * fq;
        f32x4 gg[2][2], xv[4][2][2];
#pragma unroll
        for (int bj = 0; bj < 2; ++bj) { gg[bj][0] = *(const f32x4*)(gpost + colb + bj * 128); gg[bj][1] = *(const f32x4*)(gpost + colb + bj * 128 + 4); }
#pragma unroll
        for (int m = 0; m < 4; ++m) { const int row = wr * 64 + m * 16 + fr;
#pragma unroll
            for (int bj = 0; bj < 2; ++bj) { const size_t off = (size_t)row * DM + colb + bj * 128; xv[m][bj][0] = *(const f32x4*)(xb + off); xv[m][bj][1] = *(const f32x4*)(xb + off + 4); } }
#pragma unroll
        for (int ai = 0; ai < 2; ++ai)
#pragma unroll
            for (int m = 0; m < 4; ++m) {
                float s = 0.f;
#pragma unroll
                for (int bj = 0; bj < 2; ++bj) {
                    const f32x4 v0 = acc[ai][bj][m][0], v1 = acc[ai][bj][m][1];
                    s += (v0[0] * v0[0] + v0[1] * v0[1]) + (v0[2] * v0[2] + v0[3] * v0[3]) + (v1[0] * v1[0] + v1[1] * v1[1]) + (v1[2] * v1[2] + v1[3] * v1[3]);
                }
                s += __shfl_xor(s, 16); s += __shfl_xor(s, 32);
                if (fq == 0) __hip_atomic_fetch_add(ss + u.r0 + ai * 128 + wr * 64 + m * 16 + fr, s, __ATOMIC_RELAXED, __HIP_MEMORY_SCOPE_AGENT);
            }
        asm volatile("s_waitcnt vmcnt(0)" ::: "memory");
        __builtin_amdgcn_s_barrier();
        if (threadIdx.x == 0) __hip_atomic_fetch_add(cnt + pm, 1u, __ATOMIC_RELAXED, __HIP_MEMORY_SCOPE_AGENT);
        { unsigned sp = 0;
          while ((unsigned)__builtin_amdgcn_readfirstlane(__hip_atomic_load(cnt + pm, __ATOMIC_RELAXED, __HIP_MEMORY_SCOPE_AGENT)) < 4u && sp < (1u << 22)) { __builtin_amdgcn_s_sleep(2); ++sp; } }
        asm volatile("" ::: "memory");
        float sv[2][4];
#pragma unroll
        for (int ai = 0; ai < 2; ++ai)
#pragma unroll
            for (int m = 0; m < 4; ++m) sv[ai][m] = __hip_atomic_load(ss + u.r0 + ai * 128 + wr * 64 + m * 16 + fr, __ATOMIC_RELAXED, __HIP_MEMORY_SCOPE_AGENT);
#pragma unroll
        for (int ai = 0; ai < 2; ++ai) {
            if (ai == 1) {
#pragma unroll
                for (int m = 0; m < 4; ++m) { const int row = 128 + wr * 64 + m * 16 + fr;
#pragma unroll
                    for (int bj = 0; bj < 2; ++bj) { const size_t off = (size_t)row * DM + colb + bj * 128; xv[m][bj][0] = *(const f32x4*)(xb + off); xv[m][bj][1] = *(const f32x4*)(xb + off + 4); } }
            }
#pragma unroll
            for (int m = 0; m < 4; ++m) { const int row = ai * 128 + wr * 64 + m * 16 + fr;
                const float rinv = 1.0f / sqrtf(sv[ai][m] * (1.f / 1024.f) + EPS);
#pragma unroll
                for (int bj = 0; bj < 2; ++bj) { const size_t off = (size_t)row * DM + colb + bj * 128;
                    *(f32x4*)(ob + off) = xv[m][bj][0] + acc[ai][bj][m][0] * rinv * gg[bj][0];
                    *(f32x4*)(ob + off + 4) = xv[m][bj][1] + acc[ai][bj][m][1] * rinv * gg[bj][1]; } }
            asm volatile("" ::: "memory");
        }
    }
};

struct Ptrs {
    unsigned char* ws;
    __device__ __forceinline__ char* at(size_t off) const { return (char*)ws + off; }
};
struct SchedP1 {
    Ptrs P; int G, c;
    __device__ __forceinline__ bool next(int i, Unit& u) const {
        const int L = i * G + c; constexpr int N1 = 320 * 13, N2 = 18 * 4;
        if (L >= N1 + N2) return false;
        u.nt = 16; u.aux = 0; u.sc = 1.f;
        if (L < N1) {
            int pm, pn; pg8::tile_order(L, 320, 13, pm, pn);
            pn = (pn == 12) ? 0 : ((pn == 0) ? 12 : pn);
            u.A = P.at(WS_XN) + (size_t)pm * 256 * 2048; u.B = P.at(WS_WIN) + (size_t)pn * 256 * 2048; u.r0 = pm * 256;
            size_t dst; int col, ldc = 1024, kind = 0;
            if (pn < 2) { dst = WS_ZA; col = pn * 256; }
            else if (pn < 4) { dst = WS_ZA; col = 512 + (pn - 2) * 256; kind = 1; }
            else if (pn < 6) { dst = WS_ZB; col = (pn - 4) * 256; }
            else if (pn == 6) { dst = WS_ZD; col = 0; ldc = 256; kind = 5; }
            else if (pn < 9) { dst = WS_ZB; col = 512 + (pn - 7) * 256; kind = 1; }
            else if (pn < 11) { dst = WS_ZC; col = (pn - 9) * 256; kind = 2; u.sc = C2_CROSS; }
            else { dst = WS_ZC; col = 512 + (pn - 11) * 256; kind = 1; }
            u.kind = kind; u.ldc = ldc; u.c0 = col; u.O = P.at(dst) + ((size_t)pm * 256 * ldc + col) * 2;
        } else {
            const int l = L - N1, pm = l >> 2, pn = l & 3;
            u.A = P.at(WS_MEMN) + (size_t)pm * 256 * 2048; u.B = P.at(WS_WMKV) + (size_t)pn * 256 * 2048; u.r0 = pm * 256; u.c0 = pn * 256;
            u.kind = 0; u.ldc = 1024; u.O = P.at(WS_MKV) + ((size_t)pm * 256 * 1024 + pn * 256) * 2;
        }
        return true;
    }
};
struct SchedMerge {
    Ptrs P; int G, c;
    __device__ __forceinline__ bool next(int i, Unit& u) const {
        const int ti = i / 6, sub = i - ti * 6; const int L = ti * G + c; if (L >= 1280) return false;
        int pm, pn; pg8::tile_order(L, 320, 4, pm, pn);
        const int n = sub >> 1; u.aux = n; u.r0 = pm * 256; u.c0 = pn * 256; u.ldc = 1024; u.sc = 1.f;
        u.O = P.at(WS_ZA) + ((size_t)pm * 256 * 1024 + pn * 256) * 2;
        if ((sub & 1) == 0) { u.kind = 0; u.nt = 16; u.A = P.at(WS_XN) + (size_t)pm * 256 * 2048; u.B = P.at(WS_WIN) + (size_t)(ZW + n * 1024 + pn * 256) * 2048; }
        else { u.kind = 1; u.nt = 8;
            u.A = P.at(n == 0 ? WS_MIX : (n == 1 ? WS_ZB : WS_ZC)) + (size_t)pm * 256 * 2048;
            u.B = P.at(n < 2 ? WS_WB01 : WS_WB2P) + ((size_t)pn * 256 * 1024 + (n == 1 ? 512 : 0)) * 2; }
        return true;
    }
};
struct SchedOut {
    Ptrs P; int G, c;
    __device__ __forceinline__ bool next(int i, Unit& u) const {
        const int L = i * G + c; if (L >= 1280) return false;
        int pm, pn; pg8::tile_order(L, 320, 4, pm, pn);
        u.A = P.at(WS_ZA) + (size_t)pm * 256 * 2048; u.B = P.at(WS_WOUT) + (size_t)pn * 256 * 2048;
        u.nt = 16; u.kind = 0; u.r0 = pm * 256; u.c0 = pn * 256; u.aux = 0; u.ldc = 1024; u.sc = 1.f;
        u.O = P.at(WS_XN) + ((size_t)pm * 256 * 1024 + pn * 256) * 2;
        return true;
    }
};

__device__ __forceinline__ void cross_attn_phase(bf16_t* ZC, const bf16_t* MKV, LAS unsigned char* lds, int vcu, int G) {
    constexpr int D = 128, KPL = 136, VPL = 260;
    const int tid = threadIdx.x, lane = tid & 63, r32 = lane & 31, hi = lane >> 5; const int wid = __builtin_amdgcn_readfirstlane(tid >> 6);
    LAS bf16_t* Ks = (LAS bf16_t*)lds;
    LAS bf16_t* Vt = (LAS bf16_t*)(lds + 256 * KPL * 2);
    LAS float* wsf = (LAS float*)(lds + 256 * KPL * 2 + D * VPL * 2) + wid * 32;
    const int i_lo = (int)((long)vcu * 1280 / G), i_hi = (int)((long)(vcu + 1) * 1280 / G);
    int loaded = -1;
    for (int I = i_lo; I < i_hi; ++I) {
        int bh, qt, row0;
        if (I < 256) { bh = I >> 5; qt = I & 31; row0 = (bh >> 2) * L_P + qt * 256; }
        else { const int J = I - 256; bh = 8 + (J >> 4); qt = J & 15; row0 = T_P + ((bh >> 2) - 2) * L_S + qt * 256; }
        const int b = bh >> 2, h = bh & 3;
        if (bh != loaded) {
            __syncthreads();
            const bf16_t* Kg = MKV + (size_t)b * NMEM * 1024 + h * 128; const bf16_t* Vg = Kg + 512;
#pragma unroll
            for (int c = 0; c < 8; ++c) { const int idx = tid + c * 512, key = idx >> 4, ch = idx & 15;
                const u32x4 kv = *(const u32x4*)(Kg + (size_t)key * 1024 + ch * 8), vv = *(const u32x4*)(Vg + (size_t)key * 1024 + ch * 8);
                *(LAS u32x4*)(Ks + key * KPL + ch * 8) = kv;
                const unsigned w[4] = {vv.x, vv.y, vv.z, vv.w};
#pragma unroll
                for (int j = 0; j < 4; ++j) { Vt[(ch * 8 + 2 * j) * VPL + key] = (bf16_t)(w[j] & 0xffffu); Vt[(ch * 8 + 2 * j + 1) * VPL + key] = (bf16_t)(w[j] >> 16); } }
            __syncthreads();
            loaded = bh;
        }
        bf16_t* Q = ZC + (size_t)(row0 + wid * 32) * 1024 + h * 128;
        bf16x8 qf[D / 16];
#pragma unroll
        for (int d0 = 0; d0 < D / 16; ++d0) qf[d0] = *(const bf16x8*)(Q + (size_t)r32 * 1024 + d0 * 16 + hi * 8);
        f32x16 o[D / 32];
#pragma unroll
        for (int dt = 0; dt < D / 32; ++dt)
#pragma unroll
            for (int r = 0; r < 16; ++r) o[dt][r] = 0.f;
        float m_run = -1e30f, l_run = 0.f;
#pragma unroll 1
        for (int kt = 0; kt < 4; ++kt) {
            f32x16 s0, s1;
#pragma unroll
            for (int r = 0; r < 16; ++r) { s0[r] = 0.f; s1[r] = 0.f; }
#pragma unroll
            for (int d0 = 0; d0 < D / 16; ++d0) {
                const bf16x8 a0 = *(const LAS bf16x8*)(Ks + (kt * 64 + r32) * KPL + d0 * 16 + hi * 8);
                const bf16x8 a1 = *(const LAS bf16x8*)(Ks + (kt * 64 + 32 + r32) * KPL + d0 * 16 + hi * 8);
                s0 = __builtin_amdgcn_mfma_f32_32x32x16_bf16(a0, qf[d0], s0, 0, 0, 0);
                s1 = __builtin_amdgcn_mfma_f32_32x32x16_bf16(a1, qf[d0], s1, 0, 0, 0);
            }
            float mx = s0[0];
#pragma unroll
            for (int r = 0; r < 16; ++r) { mx = fmaxf(mx, s0[r]); mx = fmaxf(mx, s1[r]); }
            mx = fmaxf(mx, __shfl_xor(mx, 32));
            const float m_new = fmaxf(m_run, mx);
            const float alpha = __builtin_amdgcn_exp2f(m_run - m_new);
            m_run = m_new;
            float rs = 0.f;
#pragma unroll
            for (int r = 0; r < 16; ++r) { s0[r] = __builtin_amdgcn_exp2f(s0[r] - m_new); s1[r] = __builtin_amdgcn_exp2f(s1[r] - m_new); rs += s0[r] + s1[r]; }
            l_run = l_run * alpha + rs;
            if (kt > 0) {
                __builtin_amdgcn_wave_barrier();
                if (hi == 0) wsf[r32] = alpha;
                __builtin_amdgcn_fence(__ATOMIC_RELEASE, "wavefront"); __builtin_amdgcn_wave_barrier(); __builtin_amdgcn_fence(__ATOMIC_ACQUIRE, "wavefront");
#pragma unroll
                for (int r = 0; r < 16; ++r) { const float a = wsf[crow(r, hi)];
#pragma unroll
                    for (int dt = 0; dt < D / 32; ++dt) o[dt][r] *= a; }
            }
            bf16x8 pw[4];
            { u32x4 p;
              p.x = pk2(s0[0], s0[1]); p.y = pk2(s0[2], s0[3]); p.z = pk2(s0[4], s0[5]); p.w = pk2(s0[6], s0[7]); pw[0] = __builtin_bit_cast(bf16x8, p);
              p.x = pk2(s0[8], s0[9]); p.y = pk2(s0[10], s0[11]); p.z = pk2(s0[12], s0[13]); p.w = pk2(s0[14], s0[15]); pw[1] = __builtin_bit_cast(bf16x8, p);
              p.x = pk2(s1[0], s1[1]); p.y = pk2(s1[2], s1[3]); p.z = pk2(s1[4], s1[5]); p.w = pk2(s1[6], s1[7]); pw[2] = __builtin_bit_cast(bf16x8, p);
              p.x = pk2(s1[8], s1[9]); p.y = pk2(s1[10], s1[11]); p.z = pk2(s1[12], s1[13]); p.w = pk2(s1[14], s1[15]); pw[3] = __builtin_bit_cast(bf16x8, p); }
#pragma unroll
            for (int dt = 0; dt < D / 32; ++dt)
#pragma unroll
                for (int ks = 0; ks < 4; ++ks) {
                    const LAS bf16_t* vp = Vt + (dt * 32 + r32) * VPL + kt * 64 + 16 * ks + 4 * hi;
                    const s16x4 lo = *(const LAS s16x4*)vp, hh = *(const LAS s16x4*)(vp + 8);
                    const bf16x8 bb = __builtin_shufflevector(lo, hh, 0, 1, 2, 3, 4, 5, 6, 7);
                    o[dt] = __builtin_amdgcn_mfma_f32_32x32x16_bf16(pw[ks], bb, o[dt], 0, 0, 0);
                }
        }
        l_run += __shfl_xor(l_run, 32);
        __builtin_amdgcn_wave_barrier();
        if (hi == 0) wsf[r32] = fast_rcp(l_run);
        __builtin_amdgcn_fence(__ATOMIC_RELEASE, "wavefront"); __builtin_amdgcn_wave_barrier(); __builtin_amdgcn_fence(__ATOMIC_ACQUIRE, "wavefront");
#pragma unroll
        for (int r = 0; r < 16; ++r) {
            const int row = crow(r, hi); const float inv = wsf[row];
#pragma unroll
            for (int dt = 0; dt < D / 32; ++dt) {
                const int col = dt * 32 + r32;
                const float g = __builtin_bit_cast(float, (unsigned)Q[(size_t)row * 1024 + 512 + col] << 16);
                Q[(size_t)row * 1024 + col] = (bf16_t)f2bf(o[dt][r] * inv * g);
            }
        }
        __builtin_amdgcn_wave_barrier();
    }
    __syncthreads();
}

__device__ __forceinline__ void transpose_item(const float* W, int ldw, int nblk, bf16_t* WT, LAS float* scr, int item, int lane) {
    const int kb = item / nblk, nb = item % nblk, k0 = 64 * kb, n0 = 32 * nb;
#pragma unroll 8
    for (int i = 0; i < 32; ++i) { const int kk = 2 * i + (lane >> 5); scr[kk * 33 + (lane & 31)] = W[(size_t)(k0 + kk) * ldw + n0 + (lane & 31)]; }
    asm volatile("s_waitcnt lgkmcnt(0)" ::: "memory");
    const int c = lane & 7;
#pragma unroll
    for (int j = 0; j < 4; ++j) { const int n = (lane >> 3) + 8 * j; const LAS float* s = scr + (8 * c) * 33 + n;
        u32x4 o; o.x = pk2(s[0 * 33], s[1 * 33]); o.y = pk2(s[2 * 33], s[3 * 33]); o.z = pk2(s[4 * 33], s[5 * 33]); o.w = pk2(s[6 * 33], s[7 * 33]);
        *(u32x4*)(WT + (size_t)(n0 + n) * 1024 + k0 + 8 * c) = o; }
    asm volatile("s_waitcnt lgkmcnt(0)" ::: "memory");
}
__device__ __forceinline__ void rms_row_to_bf16(const float* xrow, const float* g, bf16_t* orow, int lane) {
    const f32x4* xr = (const f32x4*)xrow + lane; const f32x4* gr = (const f32x4*)g + lane;
    f32x4 v[4]; float s = 0.f;
#pragma unroll
    for (int j = 0; j < 4; ++j) { v[j] = xr[64 * j]; s += (v[j].x * v[j].x + v[j].y * v[j].y) + (v[j].z * v[j].z + v[j].w * v[j].w); }
    const float rinv = 1.0f / sqrtf(wave_sum(s) * (1.f / 1024.f) + EPS);
    u32x2* o8 = (u32x2*)orow + lane;
#pragma unroll
    for (int j = 0; j < 4; ++j) { const f32x4 gg = gr[64 * j]; u32x2 w; w.x = pk2(v[j].x * rinv * gg.x, v[j].y * rinv * gg.y); w.y = pk2(v[j].z * rinv * gg.z, v[j].w * rinv * gg.w); o8[64 * j] = w; }
}

__device__ __forceinline__ void rms_row2_to_bf16(const float* xa, const float* xb, const float* g, bf16_t* oa, bf16_t* ob, int lane) {
    const f32x4* ra = (const f32x4*)xa + lane; const f32x4* rb = (const f32x4*)xb + lane; const f32x4* gr = (const f32x4*)g + lane;
    f32x4 va[4], vb[4]; float sa = 0.f, sb = 0.f;
#pragma unroll
    for (int j = 0; j < 4; ++j) { va[j] = ra[64 * j]; vb[j] = rb[64 * j]; }
#pragma unroll
    for (int j = 0; j < 4; ++j) { sa += (va[j].x * va[j].x + va[j].y * va[j].y) + (va[j].z * va[j].z + va[j].w * va[j].w); sb += (vb[j].x * vb[j].x + vb[j].y * vb[j].y) + (vb[j].z * vb[j].z + vb[j].w * vb[j].w); }
#pragma unroll
    for (int o = 1; o < 64; o <<= 1) { sa += __shfl_xor(sa, o); sb += __shfl_xor(sb, o); }
    const float ia = 1.0f / sqrtf(sa * (1.f / 1024.f) + EPS), ib = 1.0f / sqrtf(sb * (1.f / 1024.f) + EPS);
    u32x2* pa = (u32x2*)oa + lane; u32x2* pb = (u32x2*)ob + lane;
#pragma unroll
    for (int j = 0; j < 4; ++j) { const f32x4 gg = gr[64 * j]; u32x2 w;
        w.x = pk2(va[j].x * ia * gg.x, va[j].y * ia * gg.y); w.y = pk2(va[j].z * ia * gg.z, va[j].w * ia * gg.w); pa[64 * j] = w;
        w.x = pk2(vb[j].x * ib * gg.x, vb[j].y * ib * gg.y); w.y = pk2(vb[j].z * ib * gg.z, vb[j].w * ib * gg.w); pb[64 * j] = w; }
}

__device__ __forceinline__ void rms_row4_to_bf16(const float* x0, const float* x1, const float* x2, const float* x3, const float* g, bf16_t* o0, bf16_t* o1, bf16_t* o2, bf16_t* o3, int lane) {
    const f32x4* r[4] = {(const f32x4*)x0 + lane, (const f32x4*)x1 + lane, (const f32x4*)x2 + lane, (const f32x4*)x3 + lane}; const f32x4* gr = (const f32x4*)g + lane;
    u32x2* po[4] = {(u32x2*)o0 + lane, (u32x2*)o1 + lane, (u32x2*)o2 + lane, (u32x2*)o3 + lane};
    f32x4 v[4][4]; float sq[4] = {0.f, 0.f, 0.f, 0.f};
#pragma unroll
    for (int q = 0; q < 4; ++q)
#pragma unroll
        for (int j = 0; j < 4; ++j) v[q][j] = __builtin_nontemporal_load(r[q] + 64 * j);
#pragma unroll
    for (int q = 0; q < 4; ++q)
#pragma unroll
        for (int j = 0; j < 4; ++j) sq[q] += (v[q][j].x * v[q][j].x + v[q][j].y * v[q][j].y) + (v[q][j].z * v[q][j].z + v[q][j].w * v[q][j].w);
#pragma unroll
    for (int o = 1; o < 64; o <<= 1) { sq[0] += __shfl_xor(sq[0], o); sq[1] += __shfl_xor(sq[1], o); sq[2] += __shfl_xor(sq[2], o); sq[3] += __shfl_xor(sq[3], o); }
#pragma unroll
    for (int j = 0; j < 4; ++j) { const f32x4 gg = gr[64 * j];
#pragma unroll
        for (int q = 0; q < 4; ++q) { const float iv = 1.0f / sqrtf(sq[q] * (1.f / 1024.f) + EPS); u32x2 w;
            w.x = pk2(v[q][j].x * iv * gg.x, v[q][j].y * iv * gg.y); w.y = pk2(v[q][j].z * iv * gg.z, v[q][j].w * iv * gg.w); po[q][64 * j] = w; } }
}

struct Args { const float* in[16]; float* out; unsigned char* ws; };

__global__ void __launch_bounds__(512) fwd_megakernel(Args args) {
    extern __shared__ __attribute__((aligned(16))) unsigned char lds_raw[];
    LAS unsigned char* lds = (LAS unsigned char*)lds_raw;
    cg::grid_group grid = cg::this_grid();
    volatile LAS unsigned* xb_st = (volatile LAS unsigned*)(lds + LDS_BYTES - 16);
    if (threadIdx.x == 0) { xb_st[0] = 0u; xb_st[1] = 0u; }
    __syncthreads();
    const XcdBarrier xbar = xcd_barrier_post((unsigned*)(args.ws + WS_BAR), xb_st);
    const int tid = threadIdx.x, lane = tid & 63; const int wave = __builtin_amdgcn_readfirstlane(tid >> 6);
    const int G = gridDim.x, bx = blockIdx.x;
    const int vcu = (G % 8 == 0) ? (bx % 8) * (G / 8) + bx / 8 : bx;
    const int gw = vcu * NWAVES + wave, NGW = G * NWAVES;
    unsigned char* ws = args.ws; Ptrs P{ws};
    const float* x_prompt = args.in[0]; const float* x_sample = args.in[1]; const float* mem_prompt = args.in[2]; const float* mem_sample = args.in[3];
    const float* ln_pre = args.in[4]; const float* ln_post = args.in[5]; const float* ln_mem = args.in[6]; const float* w_in = args.in[7];
    const float* b_merge = args.in[8]; const float* q_norm = args.in[9]; const float* k_norm = args.in[10]; const float* w_pool = args.in[11];
    const float* pool_scale = args.in[12]; const float* w_mem_kv = args.in[13]; const float* w_branch = args.in[14]; const float* w_out = args.in[15];
    bf16_t* XN = (bf16_t*)(ws + WS_XN); bf16_t* ZA = (bf16_t*)(ws + WS_ZA); bf16_t* ZB = (bf16_t*)(ws + WS_ZB); bf16_t* ZC = (bf16_t*)(ws + WS_ZC);
    bf16_t* ZD = (bf16_t*)(ws + WS_ZD); bf16_t* MIX = (bf16_t*)(ws + WS_MIX); bf16_t* MEMN = (bf16_t*)(ws + WS_MEMN); bf16_t* MKV = (bf16_t*)(ws + WS_MKV);
    float* SS = (float*)(ws + WS_SS);

    {
        LAS float* scr = (LAS float*)(lds + wave * 16384);
        constexpr int I_IN = 16 * 184, I_SQ = 16 * 32, I_BR = 8 * 32;
        constexpr int NITEMS = I_IN + 2 * I_SQ + 3 * I_BR;
        for (int it = gw; it < NITEMS; it += NGW) {
            int r = it;
            if (r < I_IN) { transpose_item(w_in + 512, IN_DIM, 184, (bf16_t*)(ws + WS_WIN) + (size_t)512 * 1024, scr, r, lane); continue; } r -= I_IN;
            if (r < I_SQ) { transpose_item(w_mem_kv, 1024, 32, (bf16_t*)(ws + WS_WMKV), scr, r, lane); continue; } r -= I_SQ;
            if (r < I_SQ) { transpose_item(w_out, 1024, 32, (bf16_t*)(ws + WS_WOUT), scr, r, lane); continue; } r -= I_SQ;
            if (r < 3 * I_BR) { const int n = r / I_BR; r -= n * I_BR;
                transpose_item(w_branch + (size_t)n * 512 * 1024, 1024, 32, (bf16_t*)(ws + (n < 2 ? WS_WB01 : WS_WB2P)) + (n == 1 ? 512 : 0), scr, r, lane); continue; }
        }
        for (int it = NGW - 1 - gw; it < 128 * 4 * 2; it += NGW) {
            const int kb = it >> 3, g = (it >> 1) & 3, dh = it & 1, d = dh * 64 + lane;
            const float* wi = w_in + (size_t)(kb * 8) * IN_DIM + g * 128; const float* wp = w_pool + (size_t)g * 128 * 128 + d;
            float a8[8] = {0.f, 0.f, 0.f, 0.f, 0.f, 0.f, 0.f, 0.f};
#pragma unroll 4
            for (int c = 0; c < 128; ++c) { const float b = wp[(size_t)c * 128];
#pragma unroll
                for (int kk = 0; kk < 8; ++kk) a8[kk] += wi[(size_t)kk * IN_DIM + c] * b; }
            u32x4 o; o.x = pk2(a8[0], a8[1]); o.y = pk2(a8[2], a8[3]); o.z = pk2(a8[4], a8[5]); o.w = pk2(a8[6], a8[7]);
            *(u32x4*)((bf16_t*)(ws + WS_WIN) + (size_t)(g * 128 + d) * 1024 + kb * 8) = o;
        }
        for (int m = gw; m < T; m += 4 * NGW) {
            const float* xr[4]; int mr[4];
#pragma unroll
            for (int q = 0; q < 4; ++q) { const int mq = m + q * NGW; mr[q] = (mq < T) ? mq : m; xr[q] = (mr[q] < T_P) ? x_prompt + (size_t)mr[q] * DM : x_sample + (size_t)(mr[q] - T_P) * DM; }
            rms_row4_to_bf16(xr[0], xr[1], xr[2], xr[3], ln_pre, XN + (size_t)mr[0] * DM, XN + (size_t)mr[1] * DM, XN + (size_t)mr[2] * DM, XN + (size_t)mr[3] * DM, lane);
        }
        for (int m = gw; m < MEMROWS; m += NGW) { const float* xr = (m < 2 * NMEM) ? mem_prompt + (size_t)m * DM : mem_sample + (size_t)(m - 2 * NMEM) * DM; rms_row_to_bf16(xr, ln_mem, MEMN + (size_t)m * DM, lane); }
        for (int i = bx * 512 + tid; i < T; i += G * 512) SS[i] = 0.f;
        if (bx == 0 && tid < 320) ((unsigned*)(ws + WS_CNT))[tid] = 0u;
        if (bx == 0 && tid < 64) ((unsigned*)(ws + WS_CNT + 4096))[tid] = 0u;
    }
    grid.sync();

    { SchedP1 S{P, G, bx}; EpiStore E{pool_scale, k_norm, (LAS float*)(lds + 131072)}; pg8::gemm_phase(lds, S, E); }
#if DUP_MASK & 1
    __syncthreads();
    { SchedP1 S{P, G, bx}; EpiStore E{pool_scale, k_norm, (LAS float*)(lds + 131072)}; pg8::gemm_phase(lds, S, E); }
#endif
    xcd_barrier(xbar);

    {
        for (int it = gw; it < 4 * (T / 32); it += NGW) {
            const int g = (it + it / NGW) & 3, tok0 = ((it >> 2) * 4 + (lane >> 4)) * 8, col = g * 128 + (lane & 15) * 8;
            const int Lq = (tok0 < T_P) ? L_P : L_S; const int tl0 = (tok0 < T_P) ? (tok0 & (L_P - 1)) : ((tok0 - T_P) & (L_S - 1));
            const bf16_t* bp = ZA + (size_t)tok0 * 1024 + col;
            const f32x4 p0 = *(const f32x4*)(pool_scale + col), p1 = *(const f32x4*)(pool_scale + col + 4);
            u32x4 gt[4];
#pragma unroll
            for (int i = 0; i < 4; ++i) gt[i] = *(const u32x4*)(bp + (size_t)i * 1024 + 512);
#define UNP(V_, F_) { F_[0] = bflo((V_).x); F_[1] = bfhi((V_).x); F_[2] = bflo((V_).y); F_[3] = bfhi((V_).y); F_[4] = bflo((V_).z); F_[5] = bfhi((V_).z); F_[6] = bflo((V_).w); F_[7] = bfhi((V_).w); }
#define MK(j_) (((unsigned)(tl0 - W_ / 2 + (j_)) < (unsigned)Lq) ? 1.f : 0.f)
#define POOL_RUN(WW) { constexpr int W_ = WW; constexpr int NR = 8 + W_ - 1; u32x4 rw[NR]; \
                _Pragma("unroll") for (int j = 0; j < NR; ++j) { const bool ok = (unsigned)(tl0 - W_ / 2 + j) < (unsigned)Lq; rw[j] = *(const u32x4*)(bp + (ok ? (j - W_ / 2) : 0) * 1024); } \
                float sm[8] = {0.f, 0.f, 0.f, 0.f, 0.f, 0.f, 0.f, 0.f}; float cnt = 0.f; \
                _Pragma("unroll") for (int j = 0; j < W_; ++j) { float f[8]; UNP(rw[j], f); const float mk = MK(j); cnt += mk; _Pragma("unroll") for (int e = 0; e < 8; ++e) sm[e] += mk * f[e]; } \
                _Pragma("unroll") for (int i = 0; i < 8; ++i) { \
                    const float ic = 1.0f / cnt; float c[8], gg[8]; UNP(rw[i + W_ / 2], c); UNP(gt[i & 3], gg); \
                    if (i == 3) { _Pragma("unroll") for (int q = 0; q < 4; ++q) gt[q] = *(const u32x4*)(bp + (size_t)(4 + q) * 1024 + 512); } \
                    u32x4 wv; wv.x = pk2((sm[0] * ic - c[0]) * p0.x * gg[0], (sm[1] * ic - c[1]) * p0.y * gg[1]); \
                    wv.y = pk2((sm[2] * ic - c[2]) * p0.z * gg[2], (sm[3] * ic - c[3]) * p0.w * gg[3]); \
                    wv.z = pk2((sm[4] * ic - c[4]) * p1.x * gg[4], (sm[5] * ic - c[5]) * p1.y * gg[5]); \
                    wv.w = pk2((sm[6] * ic - c[6]) * p1.z * gg[6], (sm[7] * ic - c[7]) * p1.w * gg[7]); \
                    *(u32x4*)(MIX + (size_t)(tok0 + i) * 1024 + col) = wv; \
                    if (i < 7) { float fa[8], fs[8]; UNP(rw[i + W_], fa); UNP(rw[i], fs); const float ma = MK(i + W_), ms = MK(i); cnt += ma - ms; \
                        _Pragma("unroll") for (int e = 0; e < 8; ++e) sm[e] += ma * fa[e] - ms * fs[e]; } } }
            if (g == 0) POOL_RUN(2) else if (g == 1) POOL_RUN(4) else if (g == 2) POOL_RUN(8) else POOL_RUN(16)
#undef POOL_RUN
#undef MK
#undef UNP
        }
        cross_attn_phase(ZC, MKV, lds, vcu, G);
    }

    {
        for (int L = vcu; L < 2560; L += G) {
            int row0, Lq, kvh, hq, qb;
            if (L < 2048) { const int grp = L >> 6, ui = L & 63; const int seq = grp >> 1; kvh = grp & 1; hq = ui >> 4; qb = ui & 15; row0 = T_P + seq * L_S; Lq = L_S; }
            else { const int p = L - 2048, grp = p >> 7, ui = p & 127; const int seq = grp >> 1; kvh = grp & 1; hq = ui >> 5; qb = ui & 31; row0 = seq * L_P; Lq = L_P; }
            const int h = kvh * 4 + hq;
            bf16_t* Qp = ZB + (size_t)(row0 + qb * 256) * 1024 + h * 64;
            const bf16_t* Kp = ZD + (size_t)row0 * 256 + kvh * 64;
#if DUP_MASK & 2
            attn_body::attn_unit<8>((const attn_body::bf16*)Qp, (const attn_body::bf16*)Kp, (const attn_body::bf16*)(Kp + 128), Lq / 64, (const attn_body::bf16*)(Qp + 512), (attn_body::bf16*)(ws + WS_SCR + (size_t)bx * SCR_PER_BLOCK), (char*)lds_raw, q_norm, qb * 256);
#endif
            attn_body::attn_unit<8>((const attn_body::bf16*)Qp, (const attn_body::bf16*)Kp, (const attn_body::bf16*)(Kp + 128), Lq / 64, (const attn_body::bf16*)(Qp + 512), (attn_body::bf16*)Qp, (char*)lds_raw, q_norm, qb * 256);
        }
    }
    xcd_barrier(xbar);

    { SchedMerge S{P, G, bx}; EpiGate E{b_merge, (char*)ws + WS_SCR + (size_t)bx * SCR_PER_BLOCK}; pg8::gemm_phase(lds, S, E); }
#if DUP_MASK & 4
    __syncthreads();
    { SchedMerge S{P, G, bx}; EpiGate E{b_merge, (char*)ws + WS_SCR + (size_t)bx * SCR_PER_BLOCK}; pg8::gemm_phase(lds, S, E); }
#endif
    if (G == 256) {
        asm volatile("s_waitcnt vmcnt(0)" ::: "memory");
        __syncthreads();
        if (threadIdx.x == 0) {
            unsigned* w = (unsigned*)(ws + WS_CNT + 4096) + (bx & 63);
            __builtin_amdgcn_fence(__ATOMIC_RELEASE, "agent"); asm volatile("s_waitcnt vmcnt(0)" ::: "memory");
            __hip_atomic_fetch_add(w, 1u, __ATOMIC_RELAXED, __HIP_MEMORY_SCOPE_AGENT);
            unsigned sp = 0;
            while (__hip_atomic_load(w, __ATOMIC_RELAXED, __HIP_MEMORY_SCOPE_AGENT) < 4u && sp < (1u << 22)) { __builtin_amdgcn_s_sleep(2); ++sp; }
            __builtin_amdgcn_fence(__ATOMIC_ACQUIRE, "agent"); asm volatile("s_waitcnt vmcnt(0)" ::: "memory");
        }
        __syncthreads();
    } else xcd_barrier(xbar);

    { SchedOut S{P, G, bx}; EpiOut E{SS, (unsigned*)(ws + WS_CNT), x_prompt, x_sample, ln_post, args.out}; pg8::gemm_phase(lds, S, E); }
}

extern "C" void kernel_launch(void* const* d_in, const int* in_sizes, int n_in, void* d_out, int out_size, void* d_ws, size_t ws_size, hipStream_t stream) {
    static int grid_blocks = 0;
    if (grid_blocks == 0) {
        if (n_in != 16 || out_size != T * DM || ws_size < WS_END) { fprintf(stderr, "kernel_launch: unexpected shapes (n_in %d out %d ws %zu need %zu)\n", n_in, out_size, ws_size, (size_t)WS_END); grid_blocks = -1; return; }
        int dev = 0, cus = 0, per_cu = 0;
        hipGetDevice(&dev);
        hipDeviceGetAttribute(&cus, hipDeviceAttributeMultiprocessorCount, dev);
        if (hipFuncSetAttribute((const void*)fwd_megakernel, hipFuncAttributeMaxDynamicSharedMemorySize, LDS_BYTES) != hipSuccess) { fprintf(stderr, "kernel_launch: hipFuncSetAttribute failed\n"); grid_blocks = -1; return; }
        if (hipOccupancyMaxActiveBlocksPerMultiprocessor(&per_cu, (const void*)fwd_megakernel, 512, LDS_BYTES) != hipSuccess || per_cu < 1) { fprintf(stderr, "kernel_launch: occupancy query failed (%d)\n", per_cu); (void)hipGetLastError(); per_cu = 1; }
        grid_blocks = cus * 1;
        if (grid_blocks > 256) grid_blocks = 256;
    }
    if (grid_blocks < 0) return;
    if (hipMemsetAsync((char*)d_ws + WS_BAR, 0, XCD_BAR_WORDS * 4, stream) != hipSuccess) { fprintf(stderr, "kernel_launch: hipMemsetAsync failed\n"); return; }
    Args a{};
    for (int i = 0; i < 16; ++i) a.in[i] = (const float*)d_in[i];
    a.out = (float*)d_out; a.ws = (unsigned char*)d_ws;
    void* kargs[] = {&a};
    hipError_t e = hipLaunchCooperativeKernel((const void*)fwd_megakernel, dim3(grid_blocks), dim3(512), kargs, LDS_BYTES, stream);
    if (e != hipSuccess) fprintf(stderr, "cooperative launch failed: %s (grid %d)\n", hipGetErrorString(e), grid_blocks);
}
```
